# Optimizing an MI355X kernel written in HIP

```python
import math
import jax, jax.numpy as jnp
from jax import lax
import numpy as np

D_MODEL = 2048
BATCH = 1
SEQ = 8192
DEPTH = 4

CHUNK = 64
Q_BLOCK = 128
M_HEADS = 4
M_QK_DIM = 256
M_V_DIM = 512
M_QK = M_HEADS * M_QK_DIM
M_V = M_HEADS * M_V_DIM
M_CONV = 4
FGATE_BIAS_LO = 3.0
FGATE_BIAS_HI = 6.0
B_HEADS = 16
B_HEAD_DIM = 64
B_V_DIM = 2 * B_HEAD_DIM
B_QK = B_HEADS * 2 * B_HEAD_DIM
B_V = B_HEADS * B_V_DIM
ROPE_THETA = 500000.0
ROPE_DIM = B_HEAD_DIM // 4
D_FF = 5632
FFN_CONV = 3
IN_SIZES = (M_QK, M_QK, M_V, M_V, M_HEADS, M_HEADS, B_QK, B_QK, B_V, D_MODEL, D_MODEL)
N_IN = 2 * M_QK + 2 * M_V + 2 * M_HEADS + 2 * B_QK + B_V + 2 * D_MODEL
EPS = 1e-6

kernel_name = "hybrid_mlstm_diffattn_convffn_trunk"


def rmsnorm(x, g):
    xf = x.astype(jnp.float32)
    y = xf * lax.rsqrt(jnp.mean(xf * xf, axis=-1, keepdims=True) + EPS)
    return (y * g.astype(jnp.float32)).astype(x.dtype)


def causal_dwconv(x, w, b):
    K = w.shape[0]
    S = x.shape[1]
    xp = jnp.pad(x, ((0, 0), (K - 1, 0), (0, 0)))
    out = b
    for j in range(K):
        out = out + w[j] * xp[:, j:j + S]
    return out


def rope_tables(positions, dtype):
    half = ROPE_DIM // 2
    inv = jnp.power(ROPE_THETA, -(jnp.arange(half, dtype=jnp.float32) * 2.0 / ROPE_DIM))
    ang = positions.astype(jnp.float32)[..., None] * inv
    cos = jnp.cos(ang)[:, :, None, None, :].astype(dtype)
    sin = jnp.sin(ang)[:, :, None, None, :].astype(dtype)
    return cos, sin


def rope_partial(x, cos, sin):
    half = ROPE_DIM // 2
    x1 = x[..., :half]
    x2 = x[..., half:ROPE_DIM]
    rot = jnp.concatenate([x1 * cos - x2 * sin, x2 * cos + x1 * sin], axis=-1)
    return jnp.concatenate([rot, x[..., ROPE_DIM:]], axis=-1)


def mlstm(q, k, v, i_pre, f_pre):
    Bn, S, H, dqk = q.shape
    dv = v.shape[-1]
    NC = S // CHUNK
    q = q * (dqk ** -0.5)
    logf = jax.nn.log_sigmoid(f_pre)

    def chunks4(a):
        return a.reshape(Bn, NC, CHUNK, H, a.shape[-1]).transpose(1, 0, 3, 2, 4)

    def chunks3(a):
        return a.reshape(Bn, NC, CHUNK, H).transpose(1, 0, 3, 2)

    tril = jnp.tril(jnp.ones((CHUNK, CHUNK), dtype=bool))

    def step(carry, xs):
        C, n, m = carry
        qc, kc, vc, ic, lfc = xs
        b = jnp.cumsum(lfc, axis=-1)
        dmat = b[..., :, None] - b[..., None, :] + ic[..., None, :]
        dmat = jnp.where(tril, dmat, -jnp.inf)
        inter_log = b + m[..., None]
        m_t = jnp.maximum(inter_log, jnp.max(dmat, axis=-1))
        w_intra = jnp.exp(dmat - m_t[..., None])
        w_inter = jnp.exp(inter_log - m_t)
        s = jnp.einsum('bhtd,bhsd->bhts', qc, kc) * w_intra
        num = (w_inter[..., None] * jnp.einsum('bhvd,bhtd->bhtv', C, qc)
               + jnp.einsum('bhts,bhsv->bhtv', s, vc))
        den = w_inter * jnp.einsum('bhd,bhtd->bht', n, qc) + jnp.sum(s, axis=-1)
        h = num / jnp.maximum(jnp.abs(den), jnp.exp(-m_t))[..., None]
        bL = b[..., -1]
        log_s = bL[..., None] - b + ic
        m_new = jnp.maximum(bL + m, jnp.max(log_s, axis=-1))
        w_s = jnp.exp(log_s - m_new[..., None])
        decay = jnp.exp(bL + m - m_new)
        C_new = decay[..., None, None] * C + jnp.einsum('bhs,bhsv,bhsd->bhvd', w_s, vc, kc)
        n_new = decay[..., None] * n + jnp.einsum('bhs,bhsd->bhd', w_s, kc)
        return (C_new, n_new, m_new), h

    init = (jnp.zeros((Bn, H, dv, dqk), jnp.float32),
            jnp.zeros((Bn, H, dqk), jnp.float32),
            jnp.zeros((Bn, H), jnp.float32))
    xs = (chunks4(q), chunks4(k), chunks4(v), chunks3(i_pre), chunks3(logf))
    _, hs = lax.scan(step, init, xs)
    return hs.transpose(1, 0, 3, 2, 4).reshape(Bn, S, H, dv)


def diff_attention(q, k, v, lam):
    Bn, S, H, _, d = q.shape
    dv = v.shape[-1]
    NB = S // Q_BLOCK
    scale = d ** -0.5
    kh = k.transpose(0, 2, 3, 1, 4)
    vh = v.transpose(0, 2, 1, 3)
    qb = q.transpose(0, 2, 3, 1, 4).reshape(Bn, H, 2, NB, Q_BLOCK, d).transpose(3, 0, 1, 2, 4, 5)
    starts = jnp.arange(NB, dtype=jnp.int32) * Q_BLOCK
    key_chunk = jnp.arange(S, dtype=jnp.int32) // CHUNK

    def block(args):
        qblk, start = args
        s = jnp.einsum('bhcqd,bhckd->bhcqk', qblk, kh).astype(jnp.float32) * scale
        q_chunk = (start + jnp.arange(Q_BLOCK, dtype=jnp.int32)) // CHUNK
        mask = key_chunk[None, :] <= q_chunk[:, None]
        p = jax.nn.softmax(jnp.where(mask, s, -jnp.inf), axis=-1)
        a = p[:, :, 0] - lam * p[:, :, 1]
        return jnp.einsum('bhqk,bhkd->bhqd', a.astype(vh.dtype), vh)

    out = lax.map(block, (qb, starts))
    return out.transpose(1, 0, 3, 2, 4).reshape(Bn, S, H, dv)


def token_mixer(h, w_in, conv_qk_w, conv_qk_b, b_igate, b_fgate, g_mlstm, lambdas, g_diff,
                w_a, w_b, w_out, cos, sin, lam_init):
    Bn, S, _ = h.shape
    f32 = jnp.float32
    offsets = [int(o) for o in np.cumsum(IN_SIZES)[:-1]]
    proj = h @ w_in
    q_m, k_m, v_m, o_m, i_m, f_m, q_b, k_b, v_b, g_a, g_b = jnp.split(proj, offsets, axis=-1)

    qk_m = jax.nn.silu(causal_dwconv(jnp.concatenate([q_m, k_m], axis=-1), conv_qk_w, conv_qk_b))
    q_m, k_m = qk_m[..., :M_QK], qk_m[..., M_QK:]
    h_m = mlstm(q_m.reshape(Bn, S, M_HEADS, M_QK_DIM).astype(f32),
                k_m.reshape(Bn, S, M_HEADS, M_QK_DIM).astype(f32),
                v_m.reshape(Bn, S, M_HEADS, M_V_DIM).astype(f32),
                (i_m + b_igate).astype(f32),
                (f_m + b_fgate).astype(f32))
    h_m = rmsnorm(h_m, g_mlstm.reshape(M_HEADS, M_V_DIM)).astype(h.dtype).reshape(Bn, S, M_V)
    y_a = (jax.nn.sigmoid(o_m) * h_m) @ w_a

    qd = rope_partial(q_b.reshape(Bn, S, B_HEADS, 2, B_HEAD_DIM), cos, sin)
    kd = rope_partial(k_b.reshape(Bn, S, B_HEADS, 2, B_HEAD_DIM), cos, sin)
    vd = v_b.reshape(Bn, S, B_HEADS, B_V_DIM)
    lf = lambdas.astype(f32)
    lam = jnp.exp(jnp.sum(lf[0] * lf[1])) - jnp.exp(jnp.sum(lf[2] * lf[3])) + lam_init
    o_b = diff_attention(qd, kd, vd, lam)
    o_b = (rmsnorm(o_b, g_diff.reshape(B_HEADS, B_V_DIM)) * (1.0 - lam_init)).reshape(Bn, S, B_V)
    y_b = o_b @ w_b

    merged = jax.nn.sigmoid(g_a) * y_a + jax.nn.sigmoid(g_b) * y_b
    return merged @ w_out


def channel_mixer(h, w_gate, w_up, conv_w, conv_b, w_down):
    g = causal_dwconv(h @ w_gate, conv_w, conv_b)
    return (jax.nn.silu(g) * (h @ w_up)) @ w_down


def setup_inputs(seed: int = 0) -> dict:
    key = jax.random.key(seed)
    ks = jax.random.split(key, 24)
    nrm = jax.random.normal
    f32 = jnp.float32
    D = D_MODEL

    def gain(k, n):
        return 1.0 + 0.1 * nrm(k, (DEPTH, n), f32)

    x = nrm(ks[0], (BATCH, SEQ, D), f32)
    c = nrm(ks[1], (BATCH, D), f32)
    positions = jnp.broadcast_to(jnp.arange(SEQ, dtype=jnp.int32), (BATCH, SEQ))
    w_ada = nrm(ks[2], (DEPTH, D, 6 * D), f32) * (0.5 * D ** -0.5)
    b_ada = 0.01 * nrm(ks[3], (DEPTH, 6 * D), f32)
    g_pre_mix = gain(ks[4], D)
    g_post_mix = gain(ks[5], D)
    g_pre_ffn = gain(ks[6], D)
    g_post_ffn = gain(ks[7], D)
    w_in = nrm(ks[8], (DEPTH, D, N_IN), f32) * D ** -0.5
    conv_qk_w = nrm(ks[9], (DEPTH, M_CONV, 2 * M_QK), f32) * M_CONV ** -0.5
    conv_qk_b = 0.01 * nrm(ks[10], (DEPTH, 2 * M_QK), f32)
    b_igate = 0.1 * nrm(ks[11], (DEPTH, M_HEADS), f32)
    b_fgate = (jnp.linspace(FGATE_BIAS_LO, FGATE_BIAS_HI, M_HEADS, dtype=f32)[None, :]
               + 0.1 * nrm(ks[12], (DEPTH, M_HEADS), f32))
    g_mlstm = gain(ks[13], M_V)
    lambdas = 0.1 * nrm(ks[14], (DEPTH, 4, B_HEAD_DIM), f32)
    g_diff = gain(ks[15], B_V)
    w_a = nrm(ks[16], (DEPTH, M_V, D), f32) * M_V ** -0.5
    w_b = nrm(ks[17], (DEPTH, B_V, D), f32) * B_V ** -0.5
    w_out = nrm(ks[18], (DEPTH, D, D), f32) * D ** -0.5
    w_gate = nrm(ks[19], (DEPTH, D, D_FF), f32) * D ** -0.5
    w_up = nrm(ks[20], (DEPTH, D, D_FF), f32) * D ** -0.5
    conv_ffn_w = nrm(ks[21], (DEPTH, FFN_CONV, D_FF), f32) * FFN_CONV ** -0.5
    conv_ffn_b = 0.01 * nrm(ks[22], (DEPTH, D_FF), f32)
    w_down = nrm(ks[23], (DEPTH, D_FF, D), f32) * D_FF ** -0.5
    return {"x": x, "c": c, "positions": positions, "w_ada": w_ada, "b_ada": b_ada,
            "g_pre_mix": g_pre_mix, "g_post_mix": g_post_mix, "g_pre_ffn": g_pre_ffn,
            "g_post_ffn": g_post_ffn, "w_in": w_in, "conv_qk_w": conv_qk_w, "conv_qk_b": conv_qk_b,
            "b_igate": b_igate, "b_fgate": b_fgate, "g_mlstm": g_mlstm, "lambdas": lambdas,
            "g_diff": g_diff, "w_a": w_a, "w_b": w_b, "w_out": w_out, "w_gate": w_gate,
            "w_up": w_up, "conv_ffn_w": conv_ffn_w, "conv_ffn_b": conv_ffn_b, "w_down": w_down}


def reference(x, c, positions, w_ada, b_ada, g_pre_mix, g_post_mix, g_pre_ffn, g_post_ffn,
              w_in, conv_qk_w, conv_qk_b, b_igate, b_fgate, g_mlstm, lambdas, g_diff,
              w_a, w_b, w_out, w_gate, w_up, conv_ffn_w, conv_ffn_b, w_down):
    cos, sin = rope_tables(positions, x.dtype)
    c_act = jax.nn.silu(c)
    for l in range(DEPTH):
        lam_init = 0.8 - 0.6 * math.exp(-0.3 * l)
        mod = (c_act @ w_ada[l] + b_ada[l])[:, None, :]
        sh1, sc1, gt1, sh2, sc2, gt2 = jnp.split(mod, 6, axis=-1)
        h = rmsnorm(x, g_pre_mix[l]) * (1.0 + sc1) + sh1
        y = token_mixer(h, w_in[l], conv_qk_w[l], conv_qk_b[l], b_igate[l], b_fgate[l],
                        g_mlstm[l], lambdas[l], g_diff[l], w_a[l], w_b[l], w_out[l],
                        cos, sin, lam_init)
        x = x + gt1 * rmsnorm(y, g_post_mix[l])
        h = rmsnorm(x, g_pre_ffn[l]) * (1.0 + sc2) + sh2
        y = channel_mixer(h, w_gate[l], w_up[l], conv_ffn_w[l], conv_ffn_b[l], w_down[l])
        x = x + gt2 * rmsnorm(y, g_post_ffn[l])
    return x
```

```cpp
#include <hip/hip_runtime.h>
#include <hip/hip_bf16.h>
#include <cstdio>
#include <cstdint>
#include <cmath>
__device__ __forceinline__ int fresh_tid() { int t = threadIdx.x; asm volatile("" : "+v"(t)); return t; }
namespace pg8 {
#define PG8_LAS __attribute__((address_space(3)))
typedef unsigned short bf16_t;
typedef short bf16x8 __attribute__((ext_vector_type(8)));
typedef float f32x4 __attribute__((ext_vector_type(4)));
typedef unsigned u32x4 __attribute__((ext_vector_type(4)));
constexpr int BM = 256, BK = 64, HALF = 128, HTB = HALF * BK * 2  , STAGE_BYTES = 8 * HTB, NXCD = 8, WGM = 8;

__host__ __device__ __forceinline__ int lds_byte(int r, int c) { const int st = (r >> 4) * 2 + (c >> 5), rr = r & 15, cc = c & 31, ob = rr * 64 + cc * 2; return st * 1024 + (ob ^ (((ob >> 9) & 1) << 5)); }
__host__ __device__ __forceinline__ void stage_rc(int b, int& R, int& C) { const int st = b / 1024, sb = b % 1024, swz = sb ^ (((sb >> 9) & 1) << 5); R = (st >> 1) * 16 + swz / 64; C = (st & 1) * 32 + (swz % 64) / 2; }
__host__ __device__ __forceinline__ int perm32(int rho) { const int n = rho >> 4, i = rho & 15; return 8 * (i >> 2) + 4 * n + (i & 3); }

struct Unit { int pm, pn; };
struct Gemm { const bf16_t* A; const bf16_t* Bt; int M, N, K; };

struct StaticOrder {
    int nM, nN, nwg, G, c;
    __host__ __device__ void init(int M, int N, int G_, int c_) { nM = M / BM; nN = N / BM; nwg = nM * nN; G = G_; c = c_; }
    __host__ __device__ bool next(int i, Unit& u) const {
        const long L = (long)i * G + c; if (L >= nwg) return false;
        int wgid = (int)L; { const int q = nwg / NXCD, r = nwg % NXCD, xcd = wgid % NXCD, off = wgid / NXCD; wgid = (xcd < r ? xcd * (q + 1) : r * (q + 1) + (xcd - r) * q) + off; }
        const int nig = WGM * nN, gid = wgid / nig, fm = gid * WGM, gsz = (nM - fm) < WGM ? (nM - fm) : WGM;
        u.pm = fm + ((wgid % nig) % gsz); u.pn = (wgid % nig) / gsz; return true;
    }
    __device__ __forceinline__ void a_ready(const Unit&) const {}
    __device__ __forceinline__ void done(const Unit&) const {}
};

typedef float cvt_f32x2_t __attribute__((ext_vector_type(2))); typedef __bf16 cvt_bf16x2_t __attribute__((ext_vector_type(2)));
__device__ __forceinline__ unsigned cvt_pk_bf16(float lo, float hi) { cvt_f32x2_t v = {lo, hi}; cvt_bf16x2_t b = __builtin_convertvector(v, cvt_bf16x2_t); return __builtin_bit_cast(unsigned, b); }
typedef float f32x2 __attribute__((ext_vector_type(2)));
__device__ __forceinline__ float sigm(float x) { return __builtin_amdgcn_rcpf(1.0f + __expf(-x)); }
__device__ __forceinline__ float bf_lo(unsigned u) { return __builtin_bit_cast(float, u << 16); }
__device__ __forceinline__ float bf_hi(unsigned u) { return __builtin_bit_cast(float, u & 0xffff0000u); }
__device__ __forceinline__ void unpack8(const u32x4 w, float (&f)[8]) { f[0] = bf_lo(w.x); f[1] = bf_hi(w.x); f[2] = bf_lo(w.y); f[3] = bf_hi(w.y); f[4] = bf_lo(w.z); f[5] = bf_hi(w.z); f[6] = bf_lo(w.w); f[7] = bf_hi(w.w); }
__device__ __forceinline__ u32x4 pack8(const float (&f)[8]) { u32x4 w; w.x = cvt_pk_bf16(f[0], f[1]); w.y = cvt_pk_bf16(f[2], f[3]); w.z = cvt_pk_bf16(f[4], f[5]); w.w = cvt_pk_bf16(f[6], f[7]); return w; }

struct EpiIn {
    static constexpr bool PERM = true, AFTER_DRAIN = false;
    bf16_t* base; size_t split_stride; const float* ropeC; const float* ropeS; float qscale;
    __device__ __forceinline__ void operator()(const f32x4 (&acc)[2][2][4][2], const Unit& u, int wr, int wc, int fr, int fq) const {
        const int t = u.pn >> 3; bf16_t* O = base + (size_t)t * split_stride;
        const int row0 = u.pm * BM + wr * 64 + fr, col0 = (u.pn & 7) * BM + wc * 32 + 8 * fq;
        const bool sg = (t == 2) || (t >= 6), rope = (t == 3 || t == 4) && ((wc & 1) == 0) && (fq < 2);
        const float sc = (t == 3) ? qscale : 1.f;
#pragma unroll
        for (int ai = 0; ai < 2; ++ai)
#pragma unroll
            for (int m = 0; m < 4; ++m) { const int row = row0 + ai * HALF + m * 16; bf16_t* rowp = O + (size_t)row * 2048 + col0;
                f32x4 cs = (f32x4){1.f, 1.f, 1.f, 1.f}, sn = (f32x4){0.f, 0.f, 0.f, 0.f};
                if (rope) { cs = *(const f32x4*)(ropeC + (size_t)row * 8 + 4 * fq); sn = *(const f32x4*)(ropeS + (size_t)row * 8 + 4 * fq); }
#pragma unroll
                for (int bj = 0; bj < 2; ++bj) { f32x4 v0 = acc[ai][bj][m][0], v1 = acc[ai][bj][m][1];
                    if (sg) { v0 = (f32x4){sigm(v0[0]), sigm(v0[1]), sigm(v0[2]), sigm(v0[3])}; v1 = (f32x4){sigm(v1[0]), sigm(v1[1]), sigm(v1[2]), sigm(v1[3])}; }
                    if (rope) { const f32x4 a = v0, b = v1;
                        v0[0] = a[0] * cs[0] - a[1] * sn[0]; v0[1] = a[1] * cs[0] + a[0] * sn[0]; v0[2] = a[2] * cs[1] - a[3] * sn[1]; v0[3] = a[3] * cs[1] + a[2] * sn[1];
                        v1[0] = b[0] * cs[2] - b[1] * sn[2]; v1[1] = b[1] * cs[2] + b[0] * sn[2]; v1[2] = b[2] * cs[3] - b[3] * sn[3]; v1[3] = b[3] * cs[3] + b[2] * sn[3]; }
                    v0 = v0 * sc; v1 = v1 * sc; u32x4 w; w.x = cvt_pk_bf16(v0[0], v0[1]); w.y = cvt_pk_bf16(v0[2], v0[3]); w.z = cvt_pk_bf16(v1[0], v1[1]); w.w = cvt_pk_bf16(v1[2], v1[3]);
                    *(u32x4*)(rowp + bj * HALF) = w; } }
    }
};
struct EpiPlain {
    static constexpr bool PERM = true, AFTER_DRAIN = false;
    bf16_t* O; int ldc;
    __device__ __forceinline__ void operator()(const f32x4 (&acc)[2][2][4][2], const Unit& u, int wr, int wc, int fr, int fq) const {
        const int row0 = u.pm * BM + wr * 64 + fr, col0 = u.pn * BM + wc * 32 + 8 * fq;
#pragma unroll
        for (int ai = 0; ai < 2; ++ai)
#pragma unroll
            for (int m = 0; m < 4; ++m) { bf16_t* rowp = O + (size_t)(row0 + ai * HALF + m * 16) * ldc + col0;
#pragma unroll
                for (int bj = 0; bj < 2; ++bj) { const f32x4 v0 = acc[ai][bj][m][0], v1 = acc[ai][bj][m][1]; u32x4 w; w.x = cvt_pk_bf16(v0[0], v0[1]); w.y = cvt_pk_bf16(v0[2], v0[3]); w.z = cvt_pk_bf16(v1[0], v1[1]); w.w = cvt_pk_bf16(v1[2], v1[3]);
                    *(u32x4*)(rowp + bj * HALF) = w; } }
    }
};
struct EpiUp {
    static constexpr bool PERM = true, AFTER_DRAIN = false;
    const bf16_t* G; bf16_t* O; int ldc; const float* cw; const float* cb;
    __device__ __forceinline__ void operator()(const f32x4 (&acc)[2][2][4][2], const Unit& u, int wr, int wc, int fr, int fq) const {
        const int row0 = u.pm * BM + wr * 64 + fr, col0 = u.pn * BM + wc * 32 + 8 * fq;
#pragma unroll
        for (int bj = 0; bj < 2; ++bj) { const int c = col0 + bj * HALF;
            float w0[8], w1[8], w2[8], bb[8];
            { const f32x4 a = *(const f32x4*)(cw + c), b = *(const f32x4*)(cw + c + 4); w0[0] = a[0]; w0[1] = a[1]; w0[2] = a[2]; w0[3] = a[3]; w0[4] = b[0]; w0[5] = b[1]; w0[6] = b[2]; w0[7] = b[3]; }
            { const f32x4 a = *(const f32x4*)(cw + ldc + c), b = *(const f32x4*)(cw + ldc + c + 4); w1[0] = a[0]; w1[1] = a[1]; w1[2] = a[2]; w1[3] = a[3]; w1[4] = b[0]; w1[5] = b[1]; w1[6] = b[2]; w1[7] = b[3]; }
            { const f32x4 a = *(const f32x4*)(cw + 2 * ldc + c), b = *(const f32x4*)(cw + 2 * ldc + c + 4); w2[0] = a[0]; w2[1] = a[1]; w2[2] = a[2]; w2[3] = a[3]; w2[4] = b[0]; w2[5] = b[1]; w2[6] = b[2]; w2[7] = b[3]; }
            { const f32x4 a = *(const f32x4*)(cb + c), b = *(const f32x4*)(cb + c + 4); bb[0] = a[0]; bb[1] = a[1]; bb[2] = a[2]; bb[3] = a[3]; bb[4] = b[0]; bb[5] = b[1]; bb[6] = b[2]; bb[7] = b[3]; }
#pragma unroll
            for (int ai = 0; ai < 2; ++ai)
#pragma unroll
                for (int m = 0; m < 4; ++m) { const int row = row0 + ai * HALF + m * 16; const bf16_t* gp = G + (size_t)row * ldc + c;
                    const u32x4 z = (u32x4){0u, 0u, 0u, 0u};
                    const u32x4 r0 = *(const u32x4*)gp, r1 = row >= 1 ? *(const u32x4*)(gp - ldc) : z, r2 = row >= 2 ? *(const u32x4*)(gp - 2 * ldc) : z;
                    float g0[8], g1[8], g2[8], o[8]; unpack8(r0, g0); unpack8(r1, g1); unpack8(r2, g2);
                    const f32x4 v0 = acc[ai][bj][m][0], v1 = acc[ai][bj][m][1]; const float av[8] = {v0[0], v0[1], v0[2], v0[3], v1[0], v1[1], v1[2], v1[3]};
#pragma unroll
                    for (int e = 0; e < 8; ++e) { const float gc = bb[e] + w0[e] * g2[e] + w1[e] * g1[e] + w2[e] * g0[e]; o[e] = gc * sigm(gc) * av[e]; }
                    *(u32x4*)(O + (size_t)row * ldc + c) = pack8(o); } }
    }
};
struct EpiGateT {
    static constexpr bool PERM = true, AFTER_DRAIN = false;
    const bf16_t* Gt; float* T;
    __device__ __forceinline__ void operator()(const f32x4 (&acc)[2][2][4][2], const Unit& u, int wr, int wc, int fr, int fq) const {
        const int row0 = u.pm * BM + wr * 64 + fr, col0 = u.pn * BM + wc * 32 + 8 * fq;
#pragma unroll
        for (int ai = 0; ai < 2; ++ai)
#pragma unroll
            for (int m = 0; m < 4; ++m) { const size_t off = (size_t)(row0 + ai * HALF + m * 16) * 2048 + col0;
#pragma unroll
                for (int bj = 0; bj < 2; ++bj) { float g[8]; unpack8(*(const u32x4*)(Gt + off + bj * HALF), g); const f32x4 v0 = acc[ai][bj][m][0], v1 = acc[ai][bj][m][1];
                    *(f32x4*)(T + off + bj * HALF) = (f32x4){v0[0] * g[0], v0[1] * g[1], v0[2] * g[2], v0[3] * g[3]};
                    *(f32x4*)(T + off + bj * HALF + 4) = (f32x4){v1[0] * g[4], v1[1] * g[5], v1[2] * g[6], v1[3] * g[7]}; } }
    }
};
struct EpiMerge {
    static constexpr bool PERM = true, AFTER_DRAIN = false;
    const bf16_t* Gt; const float* T; bf16_t* O;
    __device__ __forceinline__ void operator()(const f32x4 (&acc)[2][2][4][2], const Unit& u, int wr, int wc, int fr, int fq) const {
        const int row0 = u.pm * BM + wr * 64 + fr, col0 = u.pn * BM + wc * 32 + 8 * fq;
#pragma unroll
        for (int ai = 0; ai < 2; ++ai)
#pragma unroll
            for (int m = 0; m < 4; ++m) { const size_t off = (size_t)(row0 + ai * HALF + m * 16) * 2048 + col0;
#pragma unroll
                for (int bj = 0; bj < 2; ++bj) { float g[8]; unpack8(*(const u32x4*)(Gt + off + bj * HALF), g); const f32x4 v0 = acc[ai][bj][m][0], v1 = acc[ai][bj][m][1];
                    const f32x4 t0 = *(const f32x4*)(T + off + bj * HALF), t1 = *(const f32x4*)(T + off + bj * HALF + 4);
                    float o[8] = {v0[0] * g[0] + t0[0], v0[1] * g[1] + t0[1], v0[2] * g[2] + t0[2], v0[3] * g[3] + t0[3], v1[0] * g[4] + t1[0], v1[1] * g[5] + t1[1], v1[2] * g[6] + t1[2], v1[3] * g[7] + t1[3]};
                    *(u32x4*)(O + off + bj * HALF) = pack8(o); } }
    }
};
struct EpiF32 {
    static constexpr bool PERM = false, AFTER_DRAIN = false;
    float* Y; int ldc;
    __device__ __forceinline__ void operator()(const f32x4 (&acc)[2][2][4][2], const Unit& u, int wr, int wc, int fr, int fq) const {
        const int row0 = u.pm * BM + wr * 64 + fr, col0 = u.pn * BM + wc * 32 + 4 * fq;
#pragma unroll
        for (int ai = 0; ai < 2; ++ai)
#pragma unroll
            for (int m = 0; m < 4; ++m) { float* rowp = Y + (size_t)(row0 + ai * HALF + m * 16) * ldc + col0;
#pragma unroll
                for (int bj = 0; bj < 2; ++bj)
#pragma unroll
                    for (int n = 0; n < 2; ++n) *(f32x4*)(rowp + bj * HALF + n * 16) = acc[ai][bj][m][n]; }
    }
};

template <class Epi, class Sched, bool ALIGN_EPI = false, bool SP2 = false>
__device__ __forceinline__ void gemm_phase(PG8_LAS unsigned char* lds, const Gemm g, const Sched& S, const Epi& E) {
    const int tid = fresh_tid(), wid = __builtin_amdgcn_readfirstlane(tid >> 6), lane = tid & 63, wr = wid >> 2, wc = wid & 3, fr = lane & 15, fq = lane >> 4;
    const int K = g.K, nt = K / BK;
    unsigned voffA[2], voffB[2];
#pragma unroll
    for (int i = 0; i < 2; ++i) { int R, C; stage_rc(tid * 16 + i * 8192, R, C); const int Rb = Epi::PERM ? ((R & ~31) + perm32(R & 31)) : R;
        voffA[i] = (unsigned)(R * K + C) * 2u; voffB[i] = (unsigned)(Rb * K + C) * 2u; }
    const size_t kstep = (size_t)(BK * 2);
    const size_t hstep = (size_t)HALF * K * 2;
    const size_t tstep = 2 * hstep;
    const unsigned ldsw = (unsigned)wid * 1024u;
    const int aoff = lds_byte(wr * 64 + fr, fq * 8), boff = lds_byte(wc * 32 + fr, fq * 8);
#define PG8_SA(b, h) (((b) * 2 + (h)) * HTB)
#define PG8_SB(b, h) ((4 + (b) * 2 + (h)) * HTB)
#define PG8_STAGE(bufoff, gbase, voff) do { _Pragma("unroll") for (int _i = 0; _i < 2; ++_i) \
        __builtin_amdgcn_global_load_lds((const unsigned*)((const char*)(gbase) + (voff)[_i]), (PG8_LAS unsigned*)(lds + (bufoff) + ldsw + _i * 8192), 16, 0, 0); } while (0)
#define PG8_LDA(dst, b, h) do { _Pragma("unroll") for (int m = 0; m < 4; ++m) _Pragma("unroll") for (int k = 0; k < 2; ++k) dst[m][k] = *(const PG8_LAS bf16x8*)(lds + PG8_SA(b, h) + aoff + m * 2048 + k * 1024); } while (0)
#define PG8_LDB(dst, b, h) do { _Pragma("unroll") for (int n = 0; n < 2; ++n) _Pragma("unroll") for (int k = 0; k < 2; ++k) dst[n][k] = *(const PG8_LAS bf16x8*)(lds + PG8_SB(b, h) + boff + n * 2048 + k * 1024); } while (0)
#define PG8_MMA(ai, bj, At, Bt) do { __builtin_amdgcn_s_setprio(1); _Pragma("unroll") for (int m = 0; m < 4; ++m) _Pragma("unroll") for (int n = 0; n < 2; ++n) _Pragma("unroll") for (int k = 0; k < 2; ++k) \
        acc[ai][bj][m][n] = __builtin_amdgcn_mfma_f32_16x16x32_bf16(Bt[n][k], At[m][k], acc[ai][bj][m][n], 0, 0, 0); __builtin_amdgcn_s_setprio(0); } while (0)
#define PG8_WAIT_V(n) asm volatile("s_waitcnt vmcnt(" #n ")" ::: "memory")
#define PG8_WAIT_L(n) asm volatile("s_waitcnt lgkmcnt(" #n ")" ::: "memory")
#define PG8_BAR __builtin_amdgcn_s_barrier()
#define PG8_SCHED __builtin_amdgcn_sched_barrier(0)
    Unit cur, nxt; int ui = 0;
    if (!S.next(0, cur)) return;
    f32x4 acc[2][2][4][2];
#pragma unroll
    for (int a = 0; a < 2; ++a)
#pragma unroll
        for (int b = 0; b < 2; ++b)
#pragma unroll
            for (int m = 0; m < 4; ++m)
#pragma unroll
                for (int n = 0; n < 2; ++n) acc[a][b][m][n] = (f32x4){0.f, 0.f, 0.f, 0.f};
    bf16x8 At[4][2], B0[2][2], B1[2][2];
    const char* cA = (const char*)g.A + (size_t)cur.pm * tstep; const char* cB = (const char*)g.Bt + (size_t)cur.pn * tstep;
    S.a_ready(cur);
    if constexpr (SP2) {
        PG8_STAGE(PG8_SB(0, 0), cB, voffB); PG8_STAGE(PG8_SB(0, 1), cB + hstep, voffB); PG8_STAGE(PG8_SA(0, 0), cA, voffA); PG8_STAGE(PG8_SA(0, 1), cA + hstep, voffA);
        if (wr == 1) PG8_BAR;
        PG8_WAIT_V(2); PG8_BAR;
        PG8_STAGE(PG8_SB(1, 0), cB + kstep, voffB); PG8_STAGE(PG8_SA(1, 0), cA + kstep, voffA); PG8_STAGE(PG8_SB(1, 1), cB + hstep + kstep, voffB);
        PG8_WAIT_V(6); PG8_BAR;
    } else {
        PG8_STAGE(PG8_SB(0, 0), cB, voffB); PG8_STAGE(PG8_SA(0, 0), cA, voffA); PG8_STAGE(PG8_SB(0, 1), cB + hstep, voffB); PG8_STAGE(PG8_SA(0, 1), cA + hstep, voffA);
        if (wr == 1) PG8_BAR;
        PG8_WAIT_V(4); PG8_BAR;
        PG8_STAGE(PG8_SB(1, 0), cB + kstep, voffB); PG8_STAGE(PG8_SA(1, 0), cA + kstep, voffA); PG8_STAGE(PG8_SB(1, 1), cB + hstep + kstep, voffB);
        PG8_WAIT_V(6); PG8_BAR;
    }
    for (;;) {
        const bool has_next = S.next(ui + 1, nxt);
        const char* nA = has_next ? (const char*)g.A + (size_t)nxt.pm * tstep : cA; const char* nB = has_next ? (const char*)g.Bt + (size_t)nxt.pn * tstep : cB;
        for (int t = 0; t < nt; t += 2) {
            const bool last = (t == nt - 2);
            const char* a1 = cA + (size_t)(t + 1) * kstep;
            const char* a2 = last ? nA : cA + (size_t)(t + 2) * kstep; const char* b2 = last ? nB : cB + (size_t)(t + 2) * kstep;
            const char* a3 = a2 + kstep; const char* b3 = b2 + kstep;
            if (last && has_next) S.a_ready(nxt);
            if constexpr (SP2) {
            PG8_LDB(B0, 0, 0); PG8_LDB(B1, 0, 1); PG8_SCHED; PG8_LDA(At, 0, 0); PG8_STAGE(PG8_SA(1, 1), a1 + hstep, voffA);
            PG8_WAIT_V(8); PG8_WAIT_L(0); PG8_BAR; PG8_MMA(0, 0, At, B0); PG8_MMA(0, 1, At, B1); PG8_BAR; PG8_SCHED;
            PG8_LDA(At, 0, 1); PG8_STAGE(PG8_SB(0, 0), b2, voffB); PG8_STAGE(PG8_SB(0, 1), b2 + hstep, voffB); PG8_STAGE(PG8_SA(0, 0), a2, voffA);
            PG8_WAIT_V(8); PG8_WAIT_L(0); PG8_BAR; PG8_MMA(1, 0, At, B0); PG8_MMA(1, 1, At, B1); PG8_BAR; PG8_SCHED;
            PG8_LDB(B0, 1, 0); PG8_LDB(B1, 1, 1); PG8_SCHED; PG8_LDA(At, 1, 0); PG8_STAGE(PG8_SA(0, 1), a2 + hstep, voffA);
            PG8_WAIT_V(8); PG8_WAIT_L(0); PG8_BAR; PG8_MMA(0, 0, At, B0); PG8_MMA(0, 1, At, B1); PG8_BAR; PG8_SCHED;
            PG8_LDA(At, 1, 1); PG8_STAGE(PG8_SB(1, 0), b3, voffB); PG8_STAGE(PG8_SB(1, 1), b3 + hstep, voffB); PG8_STAGE(PG8_SA(1, 0), a3, voffA);
            PG8_WAIT_V(8); PG8_WAIT_L(0); PG8_BAR; PG8_MMA(1, 0, At, B0); PG8_MMA(1, 1, At, B1); PG8_BAR; PG8_SCHED;
            } else {
            PG8_LDB(B0, 0, 0); PG8_SCHED; PG8_LDA(At, 0, 0); PG8_STAGE(PG8_SA(1, 1), a1 + hstep, voffA);
            PG8_WAIT_L(8); PG8_BAR; PG8_WAIT_L(0); PG8_MMA(0, 0, At, B0); PG8_BAR; PG8_SCHED;
            PG8_LDB(B1, 0, 1); PG8_STAGE(PG8_SB(0, 0), b2, voffB);
            PG8_BAR; PG8_WAIT_L(0); PG8_MMA(0, 1, At, B1); PG8_BAR;
            PG8_LDA(At, 0, 1); PG8_STAGE(PG8_SA(0, 0), a2, voffA);
            PG8_BAR; PG8_WAIT_L(0); PG8_MMA(1, 0, At, B0); PG8_BAR; PG8_SCHED;
            PG8_STAGE(PG8_SB(0, 1), b2 + hstep, voffB);
            PG8_WAIT_V(6); PG8_BAR; PG8_MMA(1, 1, At, B1); PG8_BAR;
            PG8_LDB(B0, 1, 0); PG8_SCHED; PG8_LDA(At, 1, 0); PG8_STAGE(PG8_SA(0, 1), a2 + hstep, voffA);
            PG8_WAIT_L(8); PG8_BAR; PG8_WAIT_L(0); PG8_MMA(0, 0, At, B0); PG8_BAR; PG8_SCHED;
            PG8_LDB(B1, 1, 1); PG8_STAGE(PG8_SB(1, 0), b3, voffB);
            PG8_BAR; PG8_WAIT_L(0); PG8_MMA(0, 1, At, B1); PG8_BAR;
            PG8_LDA(At, 1, 1); PG8_STAGE(PG8_SA(1, 0), a3, voffA);
            PG8_BAR; PG8_WAIT_L(0); PG8_MMA(1, 0, At, B0); PG8_BAR; PG8_SCHED;
            PG8_STAGE(PG8_SB(1, 1), b3 + hstep, voffB);
            PG8_WAIT_V(6); PG8_BAR; PG8_MMA(1, 1, At, B1); PG8_BAR;
            }
        }
        if constexpr (ALIGN_EPI) { if (wr == 0) PG8_BAR; }
        if constexpr (!Epi::AFTER_DRAIN) { E(acc, cur, wr, wc, fr, fq); S.done(cur); }
        if (!has_next) break;
#pragma unroll
        for (int a = 0; a < 2; ++a)
#pragma unroll
            for (int b = 0; b < 2; ++b)
#pragma unroll
                for (int m = 0; m < 4; ++m)
#pragma unroll
                    for (int n = 0; n < 2; ++n) acc[a][b][m][n] = (f32x4){0.f, 0.f, 0.f, 0.f};
        cur = nxt; cA = nA; cB = nB; ++ui;
        if constexpr (ALIGN_EPI) { if (wr == 1) PG8_BAR; }
    }
    PG8_WAIT_V(0);
    if constexpr (!ALIGN_EPI) { if (wr == 0) PG8_BAR; }
    PG8_BAR;
    if constexpr (Epi::AFTER_DRAIN) { E.fused(acc, cur, wr, wc, fr, fq, lds, wid, lane); S.done(cur); }
#undef PG8_SA
#undef PG8_SB
#undef PG8_STAGE
#undef PG8_LDA
#undef PG8_LDB
#undef PG8_MMA
#undef PG8_WAIT_V
#undef PG8_WAIT_L
#undef PG8_BAR
#undef PG8_SCHED
}
}
namespace attn_body {
using bf16=__hip_bfloat16;
using bf16x8=__attribute__((ext_vector_type(8)))short;
using s16x4=__attribute__((ext_vector_type(4)))short;
using f32x16=__attribute__((ext_vector_type(16)))float;
using u32x4=__attribute__((ext_vector_type(4)))unsigned;
constexpr int SEQ=8192,D=64,DM=2048;
constexpr int NW=8,QBLK=32,QB=QBLK*NW,KVBLK=64,NQB=SEQ/QB;
constexpr int ATTN_PITCH=DM, ATTN_UNIT_ROWS=QB;
__device__ __forceinline__ int crow(int r,int hi){return (r&3)+8*(r>>2)+4*hi;}
#define SBAR() __builtin_amdgcn_sched_barrier(0)
__device__ __forceinline__ void cmask(f32x16&p0,f32x16&p1,int jb,int wid){
  const float NEG=-INFINITY;
  if(jb>(wid>>1)){
    #pragma unroll
    for(int r=0;r<16;++r){p0[r]=NEG;p1[r]=NEG;}
  }
}

constexpr int NSLOT=3, SLOTB=8192;
constexpr int LDS_K=0, LDS_V=NSLOT*SLOTB, LDS_WS=2*NSLOT*SLOTB, LDS_OST=LDS_WS+NW*64*4, LDS_BYTES=LDS_OST+NW*4096;
constexpr float C2=0.125f*1.4426950408889634f;
__device__ __forceinline__ void glds16(const void*gsrc,unsigned lds_dst){unsigned keep;
  asm volatile("s_mov_b32 %0, m0\n\ts_mov_b32 m0, %2\n\ts_nop 0\n\tglobal_load_lds_dwordx4 %1, off\n\ts_mov_b32 m0, %0":"=&s"(keep):"v"(gsrc),"s"(lds_dst):"memory");}
__device__ __forceinline__ float max3f(float a,float b,float c){float r;asm("v_max3_f32 %0, %1, %2, %3":"=v"(r):"v"(a),"v"(b),"v"(c));return r;}
__device__ __forceinline__ float max2f(float a,float b){float r;asm("v_max_f32_e32 %0, %1, %2":"=v"(r):"v"(a),"v"(b));return r;}
__device__ __forceinline__ float fadd_s(float a,float b){float r;asm("v_add_f32_e32 %0, %1, %2":"=v"(r):"v"(a),"v"(b));return r;}
__device__ __forceinline__ float fsub_s(float a,float b){float r;asm("v_sub_f32_e32 %0, %1, %2":"=v"(r):"v"(a),"v"(b));return r;}
typedef float f32x2_t __attribute__((ext_vector_type(2))); typedef __bf16 bf16x2_t __attribute__((ext_vector_type(2)));
__device__ __forceinline__ unsigned cvtpk_s(float lo,float hi){f32x2_t v={lo,hi};bf16x2_t b=__builtin_convertvector(v,bf16x2_t);return __builtin_bit_cast(unsigned,b);}
#define WAIT_BAR(N) asm volatile("s_waitcnt vmcnt(" #N ") lgkmcnt(0)\n\ts_barrier":::"memory")

__device__ __forceinline__ void qkt(f32x16&p0,f32x16&p1,const char*Kslot,const bf16x8*qr,const f32x16&negm,int r32,int hi){
  const char*kb=Kslot+hi*1024+r32*16;
  #pragma unroll
  for(int d0=0;d0<4;++d0){
    const bf16x8 b0=*reinterpret_cast<const bf16x8*>(kb+d0*2048);
    const bf16x8 b1=*reinterpret_cast<const bf16x8*>(kb+d0*2048+512);
    if(d0==0){p0=__builtin_amdgcn_mfma_f32_32x32x16_bf16(b0,qr[0],negm,0,0,0);p1=__builtin_amdgcn_mfma_f32_32x32x16_bf16(b1,qr[0],negm,0,0,0);}
    else{p0=__builtin_amdgcn_mfma_f32_32x32x16_bf16(b0,qr[d0],p0,0,0,0);p1=__builtin_amdgcn_mfma_f32_32x32x16_bf16(b1,qr[d0],p1,0,0,0);}}
}
typedef __attribute__((address_space(3))) const char* lds_cptr;
typedef short v4i16_t __attribute__((ext_vector_type(4)));
__device__ __forceinline__ void kload8(bf16x8*kf,lds_cptr kp){
  kf[0]=*(const __attribute__((address_space(3))) bf16x8*)(kp);      kf[1]=*(const __attribute__((address_space(3))) bf16x8*)(kp+512);
  kf[2]=*(const __attribute__((address_space(3))) bf16x8*)(kp+2048); kf[3]=*(const __attribute__((address_space(3))) bf16x8*)(kp+2560);
  kf[4]=*(const __attribute__((address_space(3))) bf16x8*)(kp+4096); kf[5]=*(const __attribute__((address_space(3))) bf16x8*)(kp+4608);
  kf[6]=*(const __attribute__((address_space(3))) bf16x8*)(kp+6144); kf[7]=*(const __attribute__((address_space(3))) bf16x8*)(kp+6656);
}
__device__ __forceinline__ void kload2(bf16x8*kf,lds_cptr kp,int j){ kf[2*j]=*(const __attribute__((address_space(3))) bf16x8*)(kp+j*2048); kf[2*j+1]=*(const __attribute__((address_space(3))) bf16x8*)(kp+j*2048+512); }
__device__ __forceinline__ s16x4 vtr(lds_cptr p){ return __builtin_bit_cast(s16x4,__builtin_amdgcn_ds_read_tr16_b64_v4i16((__attribute__((address_space(3))) v4i16_t*)p)); }
__device__ __forceinline__ float rowmax(const f32x16&p0,const f32x16&p1){
  float a=max3f(p0[0],p0[1],p1[0]),b=max3f(p0[2],p0[3],p1[1]);a=max3f(a,p1[2],p1[3]);
  #pragma unroll
  for(int r=4;r<16;r+=4){a=max3f(a,p0[r],p0[r+1]);b=max3f(b,p0[r+2],p0[r+3]);a=max3f(a,p1[r],p1[r+1]);b=max3f(b,p1[r+2],p1[r+3]);}
  const float m=max2f(a,b);
  auto rr=__builtin_amdgcn_permlane32_swap(__float_as_uint(m),__float_as_uint(m),false,false);
  return max2f(__uint_as_float(rr[0]),__uint_as_float(rr[1]));
}
__device__ __forceinline__ void pv(f32x16*o,int vb,bf16x8 pa0,bf16x8 pa1,bf16x8 pa2,bf16x8 pa3){
  #pragma unroll
  for(int d0=0;d0<2;++d0){s16x4 lo[4],hi[4];
    #pragma unroll
    for(int ks=0;ks<4;++ks){
      asm volatile("ds_read_b64_tr_b16 %0,%1 offset:%c2":"=&v"(lo[ks]):"v"(vb),"i"(d0*4096+ks*1024):"memory");
      asm volatile("ds_read_b64_tr_b16 %0,%1 offset:%c2":"=&v"(hi[ks]):"v"(vb),"i"(d0*4096+ks*1024+512):"memory");}
    asm volatile("s_waitcnt lgkmcnt(0)":::"memory");SBAR();
    #define PK(k) (bf16x8){lo[k][0],lo[k][1],lo[k][2],lo[k][3],hi[k][0],hi[k][1],hi[k][2],hi[k][3]}
    o[d0]=__builtin_amdgcn_mfma_f32_32x32x16_bf16(pa0,PK(0),o[d0],0,0,0);
    o[d0]=__builtin_amdgcn_mfma_f32_32x32x16_bf16(pa1,PK(1),o[d0],0,0,0);
    o[d0]=__builtin_amdgcn_mfma_f32_32x32x16_bf16(pa2,PK(2),o[d0],0,0,0);
    o[d0]=__builtin_amdgcn_mfma_f32_32x32x16_bf16(pa3,PK(3),o[d0],0,0,0);
    #undef PK
  }
}

#ifndef ATTN_STORE16
#define ATTN_STORE16(p,v) (*(u32x4*)(p)=(v))
#endif
template<int THRL> __device__ __forceinline__ void attn_unit(int qb,const bf16*Qh,const bf16*__restrict__ Kh,const bf16*__restrict__ Vh,bf16*Oh,char*shm){
  const int tid=fresh_tid(),lane=tid&63,r32=lane&31,hi=lane>>5; const int wid=__builtin_amdgcn_readfirstlane(tid>>6);
  const int q0=qb*QB;
  const bf16*Qw=Qh+(long)(q0+wid*QBLK)*DM;
  const unsigned lds0=(unsigned)(uintptr_t)shm;
  float*wsf=(float*)(shm+LDS_WS)+wid*64;
  const bf16*ksrc=Kh+(long)lane*DM+wid*8;
  const bf16*vsrc=Vh+(long)(16*(wid&3)+(lane>>2))*DM+(wid>>2)*32+(lane&3)*8;
  const unsigned kdst=lds0+LDS_K+wid*1024, vdst=lds0+LDS_V+wid*1024;
  #define DMA_K(t,slot) glds16(ksrc+(long)(t)*KVBLK*DM,(unsigned)__builtin_amdgcn_readfirstlane(kdst+(slot)))
  #define DMA_V(t,slot) glds16(vsrc+(long)(t)*KVBLK*DM,(unsigned)__builtin_amdgcn_readfirstlane(vdst+(slot)))
  const int vb0=(int)(lds0+LDS_V)+((lane>>4)&1)*32+(lane&3)*8+(4*hi+((lane&15)>>2))*64;
  const char*Kbase=shm+LDS_K; bf16x8 kf[8];
  const lds_cptr shm3=(lds_cptr)shm; const lds_cptr kp0=shm3+LDS_K+hi*1024+r32*16; const lds_cptr vp0=shm3+LDS_V+((lane>>4)&1)*32+(lane&3)*8+(4*hi+((lane&15)>>2))*64;
  const int NT=(q0+QB)/KVBLK;
  DMA_K(0,0);DMA_V(0,0);DMA_K(1,SLOTB);
  bf16x8 qr[4];
  #pragma unroll
  for(int d0=0;d0<4;++d0)qr[d0]=*reinterpret_cast<const bf16x8*>(&Qw[(long)r32*DM+d0*16+hi*8]);
  float mhat=0.f,l_reg=0.f;f32x16 o[2];o[0]=f32x16{};o[1]=f32x16{};f32x16 negm=f32x16{};asm volatile("":"+v"(negm));
  #define CMASK(P0,P1,t) do{int jb_=(t)-(NT-4); if(jb_>=0)cmask(P0,P1,jb_,wid);}while(0)
  bool resc=false;
  #define START(P0,P1) do{ const float rm=rowmax(P0,P1); resc=false; \
    { const float dl=rm; mhat=fadd_s(mhat,dl); \
      _Pragma("unroll") for(int r=0;r<16;++r){P0[r]=fsub_s(P0[r],dl);P1[r]=fsub_s(P1[r],dl);} \
      _Pragma("unroll") for(int r=0;r<16;++r)negm[r]=-mhat; asm volatile("":"+v"(negm)); } \
    _Pragma("unroll") for(int r=0;r<16;++r)P0[r]=__builtin_amdgcn_exp2f(P0[r]); }while(0)
  #define RESC() do{ if(resc){ asm volatile("s_waitcnt lgkmcnt(0)":::"memory"); \
      _Pragma("unroll") for(int d_=0;d_<2;++d_) _Pragma("unroll") for(int r=0;r<16;++r)o[d_][r]*=wsf[crow(r,hi)]; } }while(0)
  f32x16 pA0,pA1,pB0,pB1;
  int sl_prev=0,sl_cur=0,sl_next=SLOTB;
  #define ROT() do{sl_prev=sl_cur;sl_cur=sl_next;sl_next=(sl_next==(NSLOT-1)*SLOTB)?0:sl_next+SLOTB;}while(0)
  DMA_K(2,2*SLOTB);
  WAIT_BAR(3);
  qkt(pA0,pA1,Kbase,qr,negm,r32,hi);asm volatile("s_nop 15\n\ts_nop 7":"+v"(pA0),"+v"(pA1));CMASK(pA0,pA1,0);
  START(pA0,pA1);
  _Pragma("unroll") for(int r=0;r<16;++r)pA1[r]=__builtin_amdgcn_exp2f(pA1[r]);
  WAIT_BAR(0);
  DMA_K(3,0);DMA_V(1,SLOTB);
  ROT();
  kload8(kf,kp0+sl_cur);
  WAIT_BAR(2);
  s16x4 vlo[8],vhi[8]; u32x4 pw0,pw1,pw2,pw3;
  #define PKW(P,B) cvtpk_s(P[B],P[B+1])
  #define PAF(k) __builtin_bit_cast(bf16x8,pw##k)
  #define VFR(i) (bf16x8){vlo[i][0],vlo[i][1],vlo[i][2],vlo[i][3],vhi[i][0],vhi[i][1],vhi[i][2],vhi[i][3]}
  #define PIN(x) asm volatile("":"+v"(x))
  #define MX3(a,b,c) __builtin_fmaxf(__builtin_fmaxf((a),(b)),(c))
  #define GAPA(MF,A0,A1,A2,A3,W0,W1,PW) do{ MF; sacc+=A0; sacc+=A1; sacc+=A2; sacc+=A3; PIN(sacc); W0; W1; PIN(PW); SBAR(); }while(0)
  #define EX(v) __builtin_amdgcn_exp2f(v)
  #define GAPB(MF,X,B) do{ MF; X[B]=EX(X[B]); X[B+1]=EX(X[B+1]); X[B+2]=EX(X[B+2]); X[B+3]=EX(X[B+3]); PIN(X); SBAR(); }while(0)
  #define VRD(i) do{ vlo[i]=vtr(vp_+(((i)>>2)*4096+((i)&3)*1024)); vhi[i]=vtr(vp_+(((i)>>2)*4096+((i)&3)*1024+512)); }while(0)
  #define KRD(G,j) do{ if(G){ kload2(kf,kp0+sl_next,j); SBAR(); } }while(0)
  #define STEP(C0,C1,P0,P1,t,GK,GV,GL) do{ SBAR(); \
    const lds_cptr vp_=vp0+sl_prev; \
    VRD(0); SBAR(); float sacc=(P0[0]+P0[1]); \
    GAPA(C0=__builtin_amdgcn_mfma_f32_32x32x16_bf16(kf[0],qr[0],negm,0,0,0), P0[2],P0[3],P0[4],P0[5],     pw0[0]=PKW(P0,0), pw0[1]=PKW(P0,2), pw0); \
    VRD(4); SBAR(); GAPA(C1=__builtin_amdgcn_mfma_f32_32x32x16_bf16(kf[1],qr[0],negm,0,0,0), P0[6],P0[7],P0[8],P0[9],     pw0[2]=PKW(P0,4), pw0[3]=PKW(P0,6), pw0); \
    VRD(1); SBAR(); GAPA(C0=__builtin_amdgcn_mfma_f32_32x32x16_bf16(kf[2],qr[1],C0,0,0,0),   P0[10],P0[11],P0[12],P0[13], pw1[0]=PKW(P0,8), pw1[1]=PKW(P0,10), pw1); \
    VRD(5); SBAR(); GAPA(C1=__builtin_amdgcn_mfma_f32_32x32x16_bf16(kf[3],qr[1],C1,0,0,0),   P0[14],P0[15],P1[0],P1[1],   pw1[2]=PKW(P0,12),pw1[3]=PKW(P0,14), pw1); \
    VRD(2); SBAR(); GAPA(C0=__builtin_amdgcn_mfma_f32_32x32x16_bf16(kf[4],qr[2],C0,0,0,0),   P1[2],P1[3],P1[4],P1[5],     pw2[0]=PKW(P1,0), pw2[1]=PKW(P1,2), pw2); \
    VRD(6); SBAR(); GAPA(C1=__builtin_amdgcn_mfma_f32_32x32x16_bf16(kf[5],qr[2],C1,0,0,0),   P1[6],P1[7],P1[8],P1[9],     pw2[2]=PKW(P1,4), pw2[3]=PKW(P1,6), pw2); \
    VRD(3); SBAR(); GAPA(C0=__builtin_amdgcn_mfma_f32_32x32x16_bf16(kf[6],qr[3],C0,0,0,0),   P1[10],P1[11],P1[12],P1[13], pw3[0]=PKW(P1,8), pw3[1]=PKW(P1,10), pw3); \
    VRD(7); SBAR(); GAPA(C1=__builtin_amdgcn_mfma_f32_32x32x16_bf16(kf[7],qr[3],C1,0,0,0),   P1[14],P1[15],0.f,0.f,       pw3[2]=PKW(P1,12),pw3[3]=PKW(P1,14), pw3); \
    l_reg+=sacc; \
    if(GK){DMA_K((t)+3,sl_cur);} if(GV){DMA_V((t)+1,sl_next);} \
    CMASK(C0,C1,t); \
    { float a=MX3(C0[0],C0[1],C1[0]),b=MX3(C0[2],C0[3],C1[1]); a=MX3(a,C1[2],C1[3]); \
      _Pragma("unroll") for(int r=4;r<16;r+=4){a=MX3(a,C0[r],C0[r+1]);b=MX3(b,C0[r+2],C0[r+3]);a=MX3(a,C1[r],C1[r+1]);b=MX3(b,C1[r+2],C1[r+3]);} \
      float rm=__builtin_fmaxf(a,b); { auto rr=__builtin_amdgcn_permlane32_swap(__float_as_uint(rm),__float_as_uint(rm),false,false); rm=__builtin_fmaxf(__uint_as_float(rr[0]),__uint_as_float(rr[1])); } \
      resc=false; \
      if(__builtin_expect(__any(rm>(float)THRL),0)){ const float dl=__builtin_fmaxf(rm,0.f); mhat+=dl; \
        _Pragma("unroll") for(int r=0;r<16;++r){C0[r]-=dl;C1[r]-=dl;} \
        _Pragma("unroll") for(int r=0;r<16;++r)negm[r]=-mhat; asm volatile("":"+v"(negm)); \
        const float f=__builtin_amdgcn_exp2f(-dl); l_reg*=f; if(hi==0)wsf[r32]=f; resc=true; } } \
    SBAR(); \
    GAPB(o[0]=__builtin_amdgcn_mfma_f32_32x32x16_bf16(PAF(0),VFR(0),o[0],0,0,0), C0,0); \
    GAPB(o[1]=__builtin_amdgcn_mfma_f32_32x32x16_bf16(PAF(0),VFR(4),o[1],0,0,0), C0,4); \
    KRD(GL,0); GAPB(o[0]=__builtin_amdgcn_mfma_f32_32x32x16_bf16(PAF(1),VFR(1),o[0],0,0,0), C0,8); \
    KRD(GL,1); GAPB(o[1]=__builtin_amdgcn_mfma_f32_32x32x16_bf16(PAF(1),VFR(5),o[1],0,0,0), C0,12); \
    KRD(GL,2); GAPB(o[0]=__builtin_amdgcn_mfma_f32_32x32x16_bf16(PAF(2),VFR(2),o[0],0,0,0), C1,0); \
    KRD(GL,3); GAPB(o[1]=__builtin_amdgcn_mfma_f32_32x32x16_bf16(PAF(2),VFR(6),o[1],0,0,0), C1,4); \
    GAPB(o[0]=__builtin_amdgcn_mfma_f32_32x32x16_bf16(PAF(3),VFR(3),o[0],0,0,0), C1,8); \
    GAPB(o[1]=__builtin_amdgcn_mfma_f32_32x32x16_bf16(PAF(3),VFR(7),o[1],0,0,0), C1,12); \
    }while(0)
  int t=1;
  #undef CMASK
  #define CMASK(P0,P1,t) do{}while(0)
  for(;t+5<NT;t+=2){
    STEP(pB0,pB1,pA0,pA1,t,true,true,true);     WAIT_BAR(2); RESC(); ROT();
    STEP(pA0,pA1,pB0,pB1,t+1,true,true,true);   WAIT_BAR(2); RESC(); ROT();
  }
  #undef CMASK
  #define CMASK(P0,P1,t) do{int jb_=(t)-(NT-4); if(jb_>=0)cmask(P0,P1,jb_,wid);}while(0)
  #define ENDW(tt) do{ if((tt)+3<NT){WAIT_BAR(2);} else if((tt)+2<NT){WAIT_BAR(1);} else {WAIT_BAR(0);} }while(0)
  for(;t+1<NT;t+=2){
    STEP(pB0,pB1,pA0,pA1,t,(t+3<NT),(t+1<NT),(t+1<NT));       ENDW(t);   RESC(); ROT();
    STEP(pA0,pA1,pB0,pB1,t+1,(t+4<NT),(t+2<NT),(t+2<NT));     ENDW(t+1); RESC(); ROT();
  }
  STEP(pB0,pB1,pA0,pA1,NT-1,false,false,false); RESC();
  { float sacc=pB0[0]+pB0[1]; _Pragma("unroll") for(int r=2;r<16;++r)sacc+=pB0[r]; _Pragma("unroll") for(int r=0;r<16;++r)sacc+=pB1[r]; l_reg+=sacc;
    pw0=(u32x4){PKW(pB0,0),PKW(pB0,2),PKW(pB0,4),PKW(pB0,6)};pw1=(u32x4){PKW(pB0,8),PKW(pB0,10),PKW(pB0,12),PKW(pB0,14)};pw2=(u32x4){PKW(pB1,0),PKW(pB1,2),PKW(pB1,4),PKW(pB1,6)};pw3=(u32x4){PKW(pB1,8),PKW(pB1,10),PKW(pB1,12),PKW(pB1,14)};
    SBAR(); pv(o,vb0+sl_cur,PAF(0),PAF(1),PAF(2),PAF(3)); }
  #undef PKW
  #undef PAF
  #undef VFR
  #undef PIN
  #undef MX3
  #undef GAPA
  #undef GAPB
  #undef EX
  #undef VRD
  #undef KRD
  #undef STEP
  #undef ENDW
  {auto rr=__builtin_amdgcn_permlane32_swap(__float_as_uint(l_reg),__float_as_uint(l_reg),false,false);l_reg=__uint_as_float(rr[0])+__uint_as_float(rr[1]);}
  if(hi==0)wsf[32+r32]=l_reg;asm volatile("s_waitcnt lgkmcnt(0)":::"memory");
  float rli[16];
  #pragma unroll
  for(int r=0;r<16;++r)rli[r]=__builtin_amdgcn_rcpf(wsf[32+crow(r,hi)]);
  bf16*Ow=Oh+(long)(q0+wid*QBLK)*DM;
  { bf16*stg=(bf16*)(shm+LDS_OST)+wid*2048;
    #pragma unroll
    for(int r=0;r<16;++r){const int orow=crow(r,hi);
      #pragma unroll
      for(int d0=0;d0<2;++d0)stg[orow*64+d0*32+r32]=__float2bfloat16(o[d0][r]*rli[r]);}
    asm volatile("s_waitcnt lgkmcnt(0)":::"memory");
    #pragma unroll
    for(int i=0;i<4;++i){const int row=i*8+(lane>>3),ch=lane&7; const u32x4 v=*(const u32x4*)(stg+row*64+ch*8); ATTN_STORE16(Ow+(long)row*DM+ch*8,v);} }
  asm volatile("s_waitcnt lgkmcnt(0)\n\ts_barrier":::"memory");
  #undef DMA_K
  #undef DMA_V
  #undef CMASK
  #undef START
  #undef RESC
  #undef ROT
}
constexpr int ATTN_LDS_BYTES=LDS_BYTES;
struct AttnTensors { const bf16* Q; const bf16* K; const bf16* V; bf16* O1; bf16* O2; };
struct AttnUnit { int bh; int qb; };
struct StaticOrder {
  int vcu;
  __device__ __forceinline__ explicit StaticOrder(int grid,int block):vcu((block%8)*(grid/8)+block/8){}
  __device__ __forceinline__ bool next(int i,AttnUnit&u)const{ if(i>=8)return false; const int s=vcu&7,ii=i&3; u.bh=(vcu>>3)+32*(i>>2); u.qb=(ii==0)?s:(ii==1)?15-s:(ii==2)?16+s:31-s; return true; }
  __device__ __forceinline__ void a_ready(const AttnUnit&)const{}
  __device__ __forceinline__ void done(const AttnUnit&)const{}
};
template<class Sched,int THRL=8> __device__ __forceinline__ void attn_phase(char*lds,const AttnTensors&T,const Sched&S){
  AttnUnit u;
  for(int i=0;S.next(i,u);++i){ S.a_ready(u);
    const int hh=u.bh>>2,c=(u.bh>>1)&1,vh=u.bh&1;
    attn_unit<THRL>(u.qb,T.Q+hh*128+c*64,T.K+hh*128+c*64,T.V+hh*128+vh*64,(c?T.O2:T.O1)+hh*128+vh*64,lds); S.done(u); }
}
#undef SBAR
#undef WAIT_BAR
}
#define GAS __attribute__((address_space(1)))
#define LAS __attribute__((address_space(3)))
typedef unsigned short bf16;
typedef unsigned v4u __attribute__((ext_vector_type(4)));
typedef float f32x4 __attribute__((ext_vector_type(4)));
typedef short bf16x8 __attribute__((ext_vector_type(8)));
typedef GAS unsigned gu32;
typedef GAS unsigned long long gu64;
#define RLX_AGENT __ATOMIC_RELAXED, __HIP_MEMORY_SCOPE_AGENT
#define LDS_WAIT() asm volatile("s_waitcnt lgkmcnt(0)" ::: "memory")
#define VM_WAIT() asm volatile("s_waitcnt vmcnt(0)" ::: "memory")
__device__ __forceinline__ unsigned long long rt() { return __builtin_amdgcn_s_memrealtime(); }
__device__ __forceinline__ unsigned f2bf(float f) { unsigned u = __builtin_bit_cast(unsigned, f); return (u + 0x7fffu + ((u >> 16) & 1u)) >> 16; }
__device__ __forceinline__ unsigned pk2(float lo, float hi) { return f2bf(lo) | (f2bf(hi) << 16); }

#define XB_TMO      128
#define XB_XCNT(j)  (256  + 64 * (j))
#define XB_XSUB(j)  (1280 + 64 * (j))
#define XB_XGEN(j)  (2304 + 64 * (j))
#define XB_TOP      3328
#define XB_TOPGEN   3392
#define XCD_BAR_WORDS 3456
#define XB_SPIN_CAP (1u << 18)

__device__ __forceinline__ unsigned xb_ld(unsigned* p)              { return __hip_atomic_load(p, __ATOMIC_RELAXED, __HIP_MEMORY_SCOPE_AGENT); }
__device__ __forceinline__ unsigned xb_add(unsigned* p, unsigned v) { return __hip_atomic_fetch_add(p, v, __ATOMIC_RELAXED, __HIP_MEMORY_SCOPE_AGENT); }
__device__ __forceinline__ unsigned xb_xcc_id() { return (unsigned)__builtin_amdgcn_s_getreg((3 << 11) | 20) & 0xFu; }
#define XB_SPIN(cond, bar) do { unsigned _sp = 0; while (cond) { __builtin_amdgcn_s_sleep(1); \
    if ((++_sp & 255u) == 0u) { if (xb_ld(&(bar)[XB_TMO])) break; if (_sp > XB_SPIN_CAP) { atomicAdd(&(bar)[XB_TMO], 1u); break; } } } } while (0)

struct XcdBarrier {
    unsigned* bar; unsigned x;
    volatile LAS unsigned* st;
};

__device__ __forceinline__ XcdBarrier xcd_barrier_post(unsigned* bar, volatile LAS unsigned* st) {
    XcdBarrier b; b.bar = bar; b.x = xb_xcc_id(); b.st = st;
    if (threadIdx.x == 0) (void)xb_add(&bar[XB_XCNT(b.x)], 1u);
    return b;
}
__device__ __forceinline__ void xcd_barrier_complete(unsigned* bar, unsigned x, unsigned& nloc, unsigned& nx) {
    const unsigned G = gridDim.x * gridDim.y * gridDim.z;
    unsigned sum, cnt, mine, sp = 0u;
    for (;;) {
        sum = 0u; cnt = 0u; mine = 0u;
#pragma unroll
        for (unsigned j = 0; j < 16; ++j) { const unsigned c = xb_ld(&bar[XB_XCNT(j)]); sum += c; cnt += (c > 0u) ? 1u : 0u; mine = (j == x) ? c : mine; }
        if (sum == G) break;
        __builtin_amdgcn_s_sleep(1);
        if ((++sp & 255u) == 0u) { if (xb_ld(&bar[XB_TMO])) break; if (sp > XB_SPIN_CAP) { atomicAdd(&bar[XB_TMO], 1u); break; } }
    }
    nloc = mine > 0u ? mine : 1u; nx = cnt > 0u ? cnt : 1u;
}

__device__ __forceinline__ void xcd_barrier(const XcdBarrier& b) {
    asm volatile("s_waitcnt vmcnt(0)" ::: "memory");
    __syncthreads();
    if (threadIdx.x == 0) {
        unsigned* bar = b.bar;
        __builtin_amdgcn_s_waitcnt(0);
        unsigned nloc = b.st[0], nx = b.st[1];
        if (nloc == 0u) { xcd_barrier_complete(bar, b.x, nloc, nx); b.st[0] = nloc; b.st[1] = nx; }
        const unsigned old = xb_add(&bar[XB_XSUB(b.x)], 1u);
        const unsigned gen = old / nloc;
        if (old + 1u == (gen + 1u) * nloc) {
            __builtin_amdgcn_fence(__ATOMIC_RELEASE, "agent");
            asm volatile("s_waitcnt vmcnt(0)" ::: "memory");
            const unsigned og = xb_add(&bar[XB_TOP], 1u);
            const unsigned tg = og / nx;
            if (og + 1u == (tg + 1u) * nx) xb_add(&bar[XB_TOPGEN], 1u);
            else XB_SPIN(xb_ld(&bar[XB_TOPGEN]) == tg, bar);
            __builtin_amdgcn_fence(__ATOMIC_ACQUIRE, "agent");
            xb_add(&bar[XB_XGEN(b.x)], 1u);
            asm volatile("s_waitcnt vmcnt(0)" ::: "memory");
        } else {
            XB_SPIN(xb_ld(&bar[XB_XGEN(b.x)]) == gen, bar);
            __builtin_amdgcn_fence(__ATOMIC_ACQUIRE, "agent");
            asm volatile("s_waitcnt vmcnt(0)" ::: "memory");
        }
    }
    __syncthreads();
}
constexpr int S = 8192, D = 2048, NINP = 16384, NIN_SRC = 16392, FF = 5632, DEPTH = 4, NWAVES = 8;
constexpr float EPS = 1e-6f;
constexpr int NPH_LAYER = 13, NPH = 2 + DEPTH * NPH_LAYER;
#ifndef MK_ONE_LAUNCH
#define MK_ONE_LAUNCH 0
#endif
constexpr size_t MiB = 1u << 20;
constexpr size_t WS_CTL = 0, CTL_ZERO_BYTES = 1 * MiB;
constexpr size_t WS_MOD = 1 * MiB;
constexpr size_t WS_ROPE = 2 * MiB;
constexpr size_t WS_WG = 3 * MiB;
constexpr size_t WS_GATES = 4 * MiB;
constexpr size_t WS_MG = 5 * MiB;
constexpr size_t WS_DEC = 5 * MiB + 768 * 1024;
constexpr size_t WS_MODP = 8 * MiB;
constexpr size_t WS_W = 16 * MiB, W_LAYER = 154 * MiB;
constexpr size_t WO_IN = 0, WO_A = 64 * MiB, WO_B = 72 * MiB, WO_OUT = 80 * MiB, WO_G = 88 * MiB, WO_U = 110 * MiB, WO_D = 132 * MiB;
constexpr size_t WS_H = 640 * MiB;
constexpr size_t WS_P8 = 672 * MiB, P8_STRIDE = 32 * MiB;
constexpr size_t WS_QKC = 928 * MiB, WS_HM = 960 * MiB, WS_O1 = 992 * MiB, WS_O2 = 1024 * MiB, WS_AM = 1056 * MiB, WS_AB = 1088 * MiB;
constexpr size_t WS_T = 1120 * MiB, WS_MRG = 1184 * MiB, WS_Y = 1216 * MiB, WS_G = 1280 * MiB, WS_AFF = 1368 * MiB, WS_END = 1456 * MiB;
constexpr int CW_BAR = 4096;
constexpr int LDS_BYTES = 147456, LDSCTL_OFF = LDS_BYTES - 512, MISC_OFF = LDSCTL_OFF + 320;

struct Frame { LAS unsigned char* lds; volatile LAS unsigned* MISC; gu32* ctl; int tid, lane, wave, vcu, G; };

__device__ __forceinline__ float wave_sum(float v) {
#pragma unroll
    for (int o = 1; o < 64; o <<= 1) v += __shfl_xor(v, o);
    return v;
}
__device__ __forceinline__ float dot4(f32x4 a, f32x4 b) { return (a.x * b.x + a.y * b.y) + (a.z * b.z + a.w * b.w); }
__device__ __forceinline__ float bflo(unsigned u) { return __builtin_bit_cast(float, u << 16); }
__device__ __forceinline__ float bfhi(unsigned u) { return __builtin_bit_cast(float, u & 0xffff0000u); }
__device__ __forceinline__ void unpk8(const v4u w, float (&f)[8]) { f[0] = bflo(w.x); f[1] = bfhi(w.x); f[2] = bflo(w.y); f[3] = bfhi(w.y); f[4] = bflo(w.z); f[5] = bfhi(w.z); f[6] = bflo(w.w); f[7] = bfhi(w.w); }
__device__ __forceinline__ v4u pk8(const float (&f)[8]) { v4u w; w.x = pg8::cvt_pk_bf16(f[0], f[1]); w.y = pg8::cvt_pk_bf16(f[2], f[3]); w.z = pg8::cvt_pk_bf16(f[4], f[5]); w.w = pg8::cvt_pk_bf16(f[6], f[7]); return w; }
__device__ __forceinline__ float sigmf(float x) { return __builtin_amdgcn_rcpf(1.0f + __expf(-x)); }

template <int MAP> __device__ __forceinline__ int src_col(int p) {
    if (MAP == 0) return p;
    int c = p;
    if (p >= 6144 && p < 10240) { const int pp = p & 63; if (pp < 16) c = (p & ~63) + (pp >> 1) + 8 * (pp & 1); }
    return c < 6144 ? c : c + 8;
}
template <int MAP> __device__ __forceinline__ void p0_transpose_item(const float* W, int K, int ldw, int N, bf16* WT, LAS float* scr, int item, int lane) {
    const int nblk = N / 32, kb = item / nblk, nb = item % nblk, k0 = 64 * kb, n0 = 32 * nb;
    const int sc = src_col<MAP>(n0 + (lane & 31));
#pragma unroll 8
    for (int i = 0; i < 32; ++i) { const int kk = 2 * i + (lane >> 5); scr[kk * 33 + (lane & 31)] = W[(size_t)(k0 + kk) * ldw + sc]; }
    LDS_WAIT(); asm volatile("" ::: "memory");
    const int c = lane & 7;
#pragma unroll
    for (int j = 0; j < 4; ++j) { const int n = (lane >> 3) + 8 * j; const LAS float* s = scr + (8 * c) * 33 + n;
        v4u o; o.x = pk2(s[0 * 33], s[1 * 33]); o.y = pk2(s[2 * 33], s[3 * 33]); o.z = pk2(s[4 * 33], s[5 * 33]); o.w = pk2(s[6 * 33], s[7 * 33]);
        *(GAS v4u*)(WT + (size_t)(n0 + n) * K + k0 + 8 * c) = o; }
    LDS_WAIT(); asm volatile("" ::: "memory");
}
struct Args { const float* in[25]; float* out; unsigned char* ws; double inv[8]; int ph_lo, ph_hi, mode, pad; };

struct Args; typedef const __attribute__((address_space(4))) Args* CArgs0;
__device__ __forceinline__ void p0_prologue(Frame& F, const __attribute__((address_space(4))) Args* Ap) {
    const __attribute__((address_space(4))) Args& A = *Ap;
    LAS float* scr = (LAS float*)(F.lds + F.wave * 16384);
    const int gw = F.vcu * NWAVES + F.wave, NGW = F.G * NWAVES;
    unsigned char* ws = A.ws;
    constexpr int I_IN = (D / 64) * (NINP / 32), I_SQ = (D / 64) * (D / 32), I_FF = (D / 64) * (FF / 32), I_DN = (FF / 64) * (D / 32);
    constexpr int I_LAYER = I_IN + 3 * I_SQ + 2 * I_FF + I_DN;
    for (int it = gw; it < DEPTH * I_LAYER; it += NGW) {
        const int l = it / I_LAYER; int r = it % I_LAYER; unsigned char* wl = ws + WS_W + (size_t)l * W_LAYER;
        if (r < I_IN) { p0_transpose_item<1>(A.in[9] + (size_t)l * D * NIN_SRC, D, NIN_SRC, NINP, (bf16*)(wl + WO_IN), scr, r, F.lane); continue; } r -= I_IN;
        if (r < I_SQ) { p0_transpose_item<0>(A.in[17] + (size_t)l * D * D, D, D, D, (bf16*)(wl + WO_A), scr, r, F.lane); continue; } r -= I_SQ;
        if (r < I_SQ) { p0_transpose_item<0>(A.in[18] + (size_t)l * D * D, D, D, D, (bf16*)(wl + WO_B), scr, r, F.lane); continue; } r -= I_SQ;
        if (r < I_SQ) { p0_transpose_item<0>(A.in[19] + (size_t)l * D * D, D, D, D, (bf16*)(wl + WO_OUT), scr, r, F.lane); continue; } r -= I_SQ;
        if (r < I_FF) { p0_transpose_item<0>(A.in[20] + (size_t)l * D * FF, D, FF, FF, (bf16*)(wl + WO_G), scr, r, F.lane); continue; } r -= I_FF;
        if (r < I_FF) { p0_transpose_item<0>(A.in[21] + (size_t)l * D * FF, D, FF, FF, (bf16*)(wl + WO_U), scr, r, F.lane); continue; } r -= I_FF;
        p0_transpose_item<0>(A.in[24] + (size_t)l * FF * D, FF, D, D, (bf16*)(wl + WO_D), scr, r, F.lane);
    }
    { const float* c = A.in[1]; const float* wada = A.in[3]; float* modp = (float*)(ws + WS_MODP);
      for (int it = gw; it < DEPTH * 48 * 32; it += NGW) {
        const int l = it / 1536, rem = it % 1536, jg = rem >> 5, kp = rem & 31, k0 = 64 * kp;
        const float cv = c[k0 + F.lane]; const float ca = cv * sigmf(cv);
        const float* wp = wada + ((size_t)l * D + k0) * (6 * D) + 256 * jg + 4 * F.lane;
        f32x4 acc = (f32x4){0.f, 0.f, 0.f, 0.f};
#pragma unroll 16
        for (int kk = 0; kk < 64; ++kk) { const f32x4 w = *(const f32x4*)(wp + (size_t)kk * (6 * D)); const float a = __shfl(ca, kk); acc += w * a; }
        *(f32x4*)(modp + ((size_t)kp * DEPTH + l) * (6 * D) + 256 * jg + 4 * F.lane) = acc; } }
    { const int gt = (F.vcu * NWAVES + F.wave) * 64 + F.lane, NGT = NGW * 64; const int* pos = (const int*)A.in[2];
      float* rc = (float*)(ws + WS_ROPE); float* rs = rc + S * 8;
      for (int i = gt; i < S * 8; i += NGT) { const int row = i >> 3, j = i & 7; const double ang = (double)pos[row] * A.inv[j];
        const double rev = ang * 0.15915494309189535; const double fr = rev - __builtin_floor(rev); const float a = (float)(fr * 6.283185307179586);
        rc[i] = __cosf(a); rs[i] = __sinf(a); }
      float* wg = (float*)(ws + WS_WG); const float* win = A.in[9];
      for (int i = gt; i < DEPTH * 8 * D; i += NGT) { const int l = i / (8 * D), g = (i / D) & 7, k = i % D; wg[i] = win[((size_t)l * D + k) * NIN_SRC + 6144 + g]; } }
}
__device__ __forceinline__ void p0b_mod_reduce(Frame& F, const __attribute__((address_space(4))) Args* Ap) {
    const __attribute__((address_space(4))) Args& A = *Ap;
    const int gt = (F.vcu * NWAVES + F.wave) * 64 + F.lane, NGT = F.G * NWAVES * 64;
    const float* modp = (const float*)(A.ws + WS_MODP); float* mod = (float*)(A.ws + WS_MOD); const float* bada = A.in[4];
    for (int i = gt; i < DEPTH * 6 * D; i += NGT) { float s = bada[i];
#pragma unroll 8
        for (int kp = 0; kp < 32; ++kp) s += modp[(size_t)kp * (DEPTH * 6 * D) + i];
        mod[i] = s; }
}

template <bool RES, bool NORM, bool GATES>
__device__ __forceinline__ void row_phase(Frame& F, const float* xin, float* xout, const float* Y, const float* gt, const float* gpost,
                                          const float* gpre, const float* sc, const float* sh, bf16* hout, const float* wg, const float* bi, const float* bfg, float* gout) {
    LAS float* wl = (LAS float*)F.lds;
    if (GATES) { for (int i = F.tid; i < 8 * D / 4; i += NWAVES * 64) ((LAS f32x4*)wl)[i] = ((const f32x4*)wg)[i]; __syncthreads(); }
    const int gw = F.vcu * NWAVES + F.wave, NGW = F.G * NWAVES;
    for (int row = gw; row < S; row += NGW) {
        asm volatile("" ::: "memory");
        f32x4 x[8];
        { const f32x4* xr = (const f32x4*)(xin + (size_t)row * D) + F.lane;
#pragma unroll
          for (int j = 0; j < 8; ++j) x[j] = xr[64 * j]; }
        if (RES) {
            const f32x4* yr = (const f32x4*)(Y + (size_t)row * D) + F.lane; f32x4 y[8]; float ss = 0.f;
#pragma unroll
            for (int j = 0; j < 8; ++j) { y[j] = yr[64 * j]; ss += dot4(y[j], y[j]); }
            const float rstd = 1.0f / sqrtf(wave_sum(ss) * (1.0f / D) + EPS);
            f32x4* xo = (f32x4*)(xout + (size_t)row * D) + F.lane;
#pragma unroll
            for (int j = 0; j < 8; ++j) { const f32x4 a = ((const f32x4*)gt)[F.lane + 64 * j], b = ((const f32x4*)gpost)[F.lane + 64 * j]; x[j] = x[j] + a * ((y[j] * rstd) * b); xo[64 * j] = x[j]; }
        }
        if (NORM) {
            float ss = 0.f;
#pragma unroll
            for (int j = 0; j < 8; ++j) ss += dot4(x[j], x[j]);
            const float rstd = 1.0f / sqrtf(wave_sum(ss) * (1.0f / D) + EPS);
            GAS unsigned long long* o8 = (GAS unsigned long long*)(hout + (size_t)row * D) + F.lane;
#pragma unroll
            for (int j = 0; j < 8; ++j) { const f32x4 g = ((const f32x4*)gpre)[F.lane + 64 * j], s1 = ((const f32x4*)sc)[F.lane + 64 * j], b = ((const f32x4*)sh)[F.lane + 64 * j];
                const f32x4 h = ((x[j] * rstd) * g) * (s1 + 1.0f) + b; x[j] = h;
                o8[64 * j] = (unsigned long long)pg8::cvt_pk_bf16(h.x, h.y) | ((unsigned long long)pg8::cvt_pk_bf16(h.z, h.w) << 32); }
            if (GATES) {
                float d[8];
#pragma unroll
                for (int g = 0; g < 8; ++g) { float a = 0.f;
#pragma unroll
                    for (int j = 0; j < 8; ++j) a += dot4(x[j], ((const LAS f32x4*)(wl + g * D))[F.lane + 64 * j]);
                    d[g] = wave_sum(a); }
                if (F.lane == 0) { *(f32x4*)(gout + (size_t)row * 8) = (f32x4){d[0] + bi[0], d[1] + bi[1], d[2] + bi[2], d[3] + bi[3]};
                                   *(f32x4*)(gout + (size_t)row * 8 + 4) = (f32x4){d[4] + bfg[0], d[5] + bfg[1], d[6] + bfg[2], d[7] + bfg[3]}; }
            }
        }
    }
    if (GATES) __syncthreads();
}

__device__ __forceinline__ void prep_conv(Frame& F, const bf16* QKM, bf16* QKC, const float* cw, const float* cb) {
    const int gw = F.vcu * NWAVES + F.wave, NGW = F.G * NWAVES;
    for (int it = gw; it < (S / 16) * 4; it += NGW) {
        const int rb = it >> 2, cg = it & 3, c0 = cg * 512 + 8 * F.lane, r0 = rb * 16;
        float w[4][8], b[8];
#pragma unroll
        for (int k = 0; k < 4; ++k) { const f32x4 a = *(const f32x4*)(cw + k * 2048 + c0), bb = *(const f32x4*)(cw + k * 2048 + c0 + 4); w[k][0] = a.x; w[k][1] = a.y; w[k][2] = a.z; w[k][3] = a.w; w[k][4] = bb.x; w[k][5] = bb.y; w[k][6] = bb.z; w[k][7] = bb.w; }
        { const f32x4 a = *(const f32x4*)(cb + c0), bb = *(const f32x4*)(cb + c0 + 4); b[0] = a.x; b[1] = a.y; b[2] = a.z; b[3] = a.w; b[4] = bb.x; b[5] = bb.y; b[6] = bb.z; b[7] = bb.w; }
        float xm3[8], xm2[8], xm1[8], x0[8], o[8];
        const v4u z = (v4u){0u, 0u, 0u, 0u};
        unpk8(r0 >= 3 ? *(const v4u*)(QKM + (size_t)(r0 - 3) * 2048 + c0) : z, xm3);
        unpk8(r0 >= 2 ? *(const v4u*)(QKM + (size_t)(r0 - 2) * 2048 + c0) : z, xm2);
        unpk8(r0 >= 1 ? *(const v4u*)(QKM + (size_t)(r0 - 1) * 2048 + c0) : z, xm1);
        const float qs = (c0 < 1024) ? 0.0625f : 1.0f;
#pragma unroll 4
        for (int r = 0; r < 16; ++r) {
            unpk8(*(const v4u*)(QKM + (size_t)(r0 + r) * 2048 + c0), x0);
#pragma unroll
            for (int e = 0; e < 8; ++e) { const float y = b[e] + w[0][e] * xm3[e] + w[1][e] * xm2[e] + w[2][e] * xm1[e] + w[3][e] * x0[e]; o[e] = y * sigmf(y) * qs; xm3[e] = xm2[e]; xm2[e] = xm1[e]; xm1[e] = x0[e]; }
            *(v4u*)(QKC + (size_t)(r0 + r) * 2048 + c0) = pk8(o);
        }
    }
}
__device__ __forceinline__ float logsig(float f) { return fminf(f, 0.f) - log1pf(__expf(-fabsf(f))); }
__device__ __forceinline__ void gate_scan(Frame& F, int hd, const float* GATES, float* MG, float* DEC) {
    LAS float* sb = (LAS float*)F.lds;
    const int c = F.tid;
    if (c < 128) { float b = 0.f, amax = -INFINITY;
        for (int s = 0; s < 64; ++s) { const float* gp = GATES + (size_t)(64 * c + s) * 8; const float iv = gp[hd], fv = gp[4 + hd]; b += logsig(fv); amax = fmaxf(amax, iv - b); }
        sb[c] = b; sb[128 + c] = b + amax; }
    __syncthreads();
    if (F.tid == 0) { float m = 0.f; for (int k = 0; k < 128; ++k) { sb[256 + k] = m; m = fmaxf(sb[k] + m, sb[128 + k]); } sb[256 + 128] = m; }
    __syncthreads();
    if (c < 128) { const float mprev = sb[256 + c], mnew = sb[256 + c + 1], bL = sb[c]; float b = 0.f, amax = -INFINITY; float* mg = MG + (size_t)hd * 5 * S + 64 * c;
        for (int s = 0; s < 64; ++s) { const float* gp = GATES + (size_t)(64 * c + s) * 8; const float iv = gp[hd], fv = gp[4 + hd]; b += logsig(fv); const float a = iv - b; amax = fmaxf(amax, a);
            const float mt = b + fmaxf(mprev, amax);
            mg[s] = b - mt; mg[S + s] = a; mg[2 * S + s] = __expf(b + mprev - mt); mg[3 * S + s] = __expf(-mt); mg[4 * S + s] = __expf(bL - b + iv - mnew); }
        DEC[hd * 128 + c] = __expf(bL + mprev - mnew); }
    __syncthreads();
}

typedef float f32x16 __attribute__((ext_vector_type(16)));
constexpr int ML_QS = 0, ML_KS = 33792, ML_KT = 67584, ML_VT = 104448, ML_CB = 109056, ML_PS = 125952, ML_SC = 135168, ML_DENP = 136704, ML_DQ = 137728, ML_NV = 137984, ML_END = 139008;
static_assert(ML_END <= LDSCTL_OFF, "mLSTM LDS map");
__device__ __forceinline__ void mlstm_unit(Frame& F, int hd, int vs, const bf16* QKC, const bf16* VM, const float* MG, const float* DEC, bf16* HM, int mode) {
    LAS unsigned char* L = F.lds; const int tid = F.tid, lane = F.lane, wave = F.wave, r32 = lane & 31, hi = lane >> 5;
    for (int i = tid; i < (ML_PS - ML_CB) / 4; i += 512) ((LAS unsigned*)(L + ML_CB))[i] = 0u;
    if (tid < 256) ((LAS float*)(L + ML_NV))[tid] = 0.f;
    f32x16 cacc;
#pragma unroll
    for (int r = 0; r < 16; ++r) cacc[r] = 0.f;
    const float* mgh = MG + (size_t)hd * 5 * S;
    v4u rq[4], rk[4], rv; float rws[4], rsc;
    const int sq = tid >> 5, dc = tid & 31;
    const int sv = tid >> 2, vc = tid & 3;
#define ML_LOAD(c) do { const int t0_ = 64 * (c); \
        _Pragma("unroll") for (int i = 0; i < 4; ++i) { const size_t ro = (size_t)(t0_ + sq + 16 * i) * 2048; rq[i] = *(const v4u*)(QKC + ro + 256 * hd + 8 * dc); rk[i] = *(const v4u*)(QKC + ro + 1024 + 256 * hd + 8 * dc); rws[i] = mgh[4 * S + t0_ + sq + 16 * i]; } \
        if (tid < 256) rv = *(const v4u*)(VM + (size_t)(t0_ + sv) * 2048 + 512 * hd + 32 * vs + 8 * vc); \
        if (tid < 320) rsc = mgh[(size_t)(tid >> 6) * S + t0_ + (tid & 63)]; else if (tid == 320) rsc = DEC[hd * 128 + (c)]; } while (0)
    ML_LOAD(0);
    for (int c = 0; c < 128; ++c) {
#pragma unroll
        for (int i = 0; i < 4; ++i) { const int s = sq + 16 * i;
            *(LAS v4u*)(L + ML_QS + s * 528 + dc * 16) = rq[i]; *(LAS v4u*)(L + ML_KS + s * 528 + dc * 16) = rk[i];
            float kf[8]; unpk8(rk[i], kf);
#pragma unroll
            for (int e = 0; e < 8; ++e) *(LAS bf16*)(L + ML_KT + (8 * dc + e) * 144 + s * 2) = (bf16)f2bf(kf[e] * rws[i]); }
        if (tid < 256) { const unsigned w[4] = {rv.x, rv.y, rv.z, rv.w};
#pragma unroll
            for (int e = 0; e < 8; ++e) *(LAS bf16*)(L + ML_VT + (8 * vc + e) * 144 + sv * 2) = (bf16)((w[e >> 1] >> (16 * (e & 1))) & 0xffffu); }
        if (tid <= 320) ((LAS float*)(L + ML_SC))[tid] = rsc;
        if (c + 1 < 128) ML_LOAD(c + 1);
        __syncthreads();
        const LAS float* SC = (const LAS float*)(L + ML_SC);
        f32x16 hacc;
        if (wave < 4) {
            const int si = wave >> 1, ti = wave & 1; f32x16 acc;
#pragma unroll
            for (int r = 0; r < 16; ++r) acc[r] = 0.f;
            const LAS unsigned char* ka = L + ML_KS + (32 * si + r32) * 528 + hi * 16; const LAS unsigned char* qb = L + ML_QS + (32 * ti + r32) * 528 + hi * 16;
#pragma unroll
            for (int kk = 0; kk < 16; ++kk) acc = __builtin_amdgcn_mfma_f32_32x32x16_bf16(*(const LAS bf16x8*)(ka + kk * 32), *(const LAS bf16x8*)(qb + kk * 32), acc, 0, 0, 0);
            const int t = 32 * ti + r32; const float rt_ = SC[t]; float dsum = 0.f;
#pragma unroll
            for (int g = 0; g < 4; ++g) { const int s0 = 32 * si + 8 * g + 4 * hi; float p[4];
#pragma unroll
                for (int e = 0; e < 4; ++e) { const int s = s0 + e; const float wgt = ((s <= t) && (mode & 1)) ? __expf(rt_ + SC[64 + s]) : 0.f; p[e] = acc[4 * g + e] * wgt; dsum += p[e]; }
                *(LAS unsigned long long*)(L + ML_PS + t * 144 + s0 * 2) = (unsigned long long)pg8::cvt_pk_bf16(p[0], p[1]) | ((unsigned long long)pg8::cvt_pk_bf16(p[2], p[3]) << 32); }
            ((LAS float*)(L + ML_DENP))[(si * 2 + hi) * 64 + t] = dsum;
        } else if (wave < 6) {
            const int ti = wave - 4;
#pragma unroll
            for (int r = 0; r < 16; ++r) hacc[r] = 0.f;
            const LAS unsigned char* ca = L + ML_CB + r32 * 528 + hi * 16; const LAS unsigned char* qb = L + ML_QS + (32 * ti + r32) * 528 + hi * 16;
#pragma unroll
            for (int kk = 0; kk < 16; ++kk) hacc = __builtin_amdgcn_mfma_f32_32x32x16_bf16(*(const LAS bf16x8*)(ca + kk * 32), *(const LAS bf16x8*)(qb + kk * 32), hacc, 0, 0, 0);
        } else {
            const int tq = 32 * (wave - 6) + r32; const LAS unsigned char* qp = L + ML_QS + tq * 528 + hi * 256; const LAS float* nv = (const LAS float*)(L + ML_NV) + hi * 128; float a = 0.f;
#pragma unroll
            for (int j = 0; j < 16; ++j) { float qf[8]; unpk8(*(const LAS v4u*)(qp + j * 16), qf);
#pragma unroll
                for (int e = 0; e < 8; ++e) a += qf[e] * nv[8 * j + e]; }
            a += __shfl_xor(a, 32);
            if (hi == 0) ((LAS float*)(L + ML_DQ))[tq] = a;
        }
        __syncthreads();
        if (wave == 4 || wave == 5) {
            const int ti = wave - 4, t = 32 * ti + r32; const float wi = SC[128 + t], nr = SC[192 + t]; const LAS float* dp = (const LAS float*)(L + ML_DENP);
            float den = wi * ((const LAS float*)(L + ML_DQ))[t] + ((dp[t] + dp[64 + t]) + (dp[128 + t] + dp[192 + t])); if (!(mode & 8)) den = 1.f;
#pragma unroll
            for (int r = 0; r < 16; ++r) hacc[r] *= (mode & 2) ? wi : 0.f;
            const LAS unsigned char* va = L + ML_VT + r32 * 144 + hi * 16; const LAS unsigned char* pb = L + ML_PS + t * 144 + hi * 16;
#pragma unroll
            for (int kk = 0; kk < 4; ++kk) hacc = __builtin_amdgcn_mfma_f32_32x32x16_bf16(*(const LAS bf16x8*)(va + kk * 32), *(const LAS bf16x8*)(pb + kk * 32), hacc, 0, 0, 0);
            const float inv = 1.0f / fmaxf(fabsf(den), nr);
            bf16* op = HM + (size_t)(64 * c + t) * 2048 + 512 * hd + 32 * vs + 4 * hi;
#pragma unroll
            for (int g = 0; g < 4; ++g) *(unsigned long long*)(op + 8 * g) = (unsigned long long)pg8::cvt_pk_bf16(hacc[4 * g] * inv, hacc[4 * g + 1] * inv) | ((unsigned long long)pg8::cvt_pk_bf16(hacc[4 * g + 2] * inv, hacc[4 * g + 3] * inv) << 32);
        }
        if (mode & 4) { const float dcy = SC[320];
#pragma unroll
          for (int r = 0; r < 16; ++r) cacc[r] *= dcy;
          const LAS unsigned char* ka = L + ML_KT + (32 * wave + r32) * 144 + hi * 16; const LAS unsigned char* vb = L + ML_VT + r32 * 144 + hi * 16;
#pragma unroll
          for (int kk = 0; kk < 4; ++kk) cacc = __builtin_amdgcn_mfma_f32_32x32x16_bf16(*(const LAS bf16x8*)(ka + kk * 32), *(const LAS bf16x8*)(vb + kk * 32), cacc, 0, 0, 0);
#pragma unroll
          for (int g = 0; g < 4; ++g) *(LAS unsigned long long*)(L + ML_CB + r32 * 528 + (32 * wave + 8 * g + 4 * hi) * 2) = (unsigned long long)pg8::cvt_pk_bf16(cacc[4 * g], cacc[4 * g + 1]) | ((unsigned long long)pg8::cvt_pk_bf16(cacc[4 * g + 2], cacc[4 * g + 3]) << 32);
          if (tid < 256) { const LAS unsigned char* kr = L + ML_KT + tid * 144; float a = 0.f;
#pragma unroll
              for (int j = 0; j < 8; ++j) { float kf[8]; unpk8(*(const LAS v4u*)(kr + j * 16), kf); a += ((kf[0] + kf[1]) + (kf[2] + kf[3])) + ((kf[4] + kf[5]) + (kf[6] + kf[7])); }
              LAS float* nv = (LAS float*)(L + ML_NV); nv[tid] = dcy * nv[tid] + a; }
        }
        __syncthreads();
    }
#undef ML_LOAD
}

__device__ __forceinline__ void post_phase(Frame& F, const bf16* HM, const bf16* OG, const bf16* O1, const bf16* O2, const float* gm, const float* gd, const float* lmb, float lam_init, bf16* AM, bf16* AB) {
    const float lam = expf(wave_sum(lmb[F.lane] * lmb[64 + F.lane])) - expf(wave_sum(lmb[128 + F.lane] * lmb[192 + F.lane])) + lam_init;
    const float omli = 1.0f - lam_init;
    const int gw = F.vcu * NWAVES + F.wave, NGW = F.G * NWAVES;
    for (int row = gw; row < S; row += NGW) {
#pragma unroll
        for (int j = 0; j < 4; ++j) { const size_t off = (size_t)row * 2048 + 8 * F.lane + 512 * j; const int c = 8 * F.lane + 512 * j;
            float h[8], og[8], o1[8], o2[8], o[8], ga[8], gb[8];
            unpk8(*(const v4u*)(HM + off), h); unpk8(*(const v4u*)(OG + off), og); unpk8(*(const v4u*)(O1 + off), o1); unpk8(*(const v4u*)(O2 + off), o2);
            { const f32x4 a = *(const f32x4*)(gm + c), b = *(const f32x4*)(gm + c + 4); ga[0] = a.x; ga[1] = a.y; ga[2] = a.z; ga[3] = a.w; ga[4] = b.x; ga[5] = b.y; ga[6] = b.z; ga[7] = b.w; }
            { const f32x4 a = *(const f32x4*)(gd + c), b = *(const f32x4*)(gd + c + 4); gb[0] = a.x; gb[1] = a.y; gb[2] = a.z; gb[3] = a.w; gb[4] = b.x; gb[5] = b.y; gb[6] = b.z; gb[7] = b.w; }
            float ss = 0.f, sd = 0.f;
#pragma unroll
            for (int e = 0; e < 8; ++e) { ss += h[e] * h[e]; o[e] = o1[e] - lam * o2[e]; sd += o[e] * o[e]; }
            ss = wave_sum(ss);
            sd += __shfl_xor(sd, 1); sd += __shfl_xor(sd, 2); sd += __shfl_xor(sd, 4); sd += __shfl_xor(sd, 8);
            const float rm = 1.0f / sqrtf(ss * (1.0f / 512.0f) + EPS), rd = 1.0f / sqrtf(sd * (1.0f / 128.0f) + EPS) * omli;
#pragma unroll
            for (int e = 0; e < 8; ++e) { h[e] = og[e] * (h[e] * rm * ga[e]); o[e] = o[e] * rd * gb[e]; }
            *(v4u*)(AM + off) = pk8(h); *(v4u*)(AB + off) = pk8(o); }
    }
}

typedef const __attribute__((address_space(4))) Args* CArgs;
__device__ __forceinline__ CArgs get_args() { CArgs p = (CArgs)__builtin_amdgcn_kernarg_segment_ptr(); asm volatile("" : "+s"(p)); return p; }
#define P8B(ws, i) ((bf16*)((ws) + WS_P8 + (size_t)(i) * P8_STRIDE))
__global__ void __launch_bounds__(NWAVES * 64, 2) trunk_fwd(Args args_unused) {
    extern __shared__ __attribute__((aligned(16))) unsigned char lds[];
    Frame F;
    F.lds = (LAS unsigned char*)lds; F.MISC = (volatile LAS unsigned*)(F.lds + MISC_OFF);
    F.tid = threadIdx.x; F.lane = F.tid & 63; F.wave = __builtin_amdgcn_readfirstlane(F.tid >> 6);
    F.G = gridDim.x; { const int bx = blockIdx.x; F.vcu = (F.G % 8 == 0) ? (bx % 8) * (F.G / 8) + bx / 8 : bx; }
    F.ctl = (gu32*)(get_args()->ws + WS_CTL);
#ifdef DBG_POISON
    for (int u = F.tid; u < LDSCTL_OFF / 4; u += NWAVES * 64) ((LAS unsigned*)F.lds)[u] = 0xAAAAAAAAu;
#endif
    for (int u = F.tid; u < (LDS_BYTES - LDSCTL_OFF) / 4; u += NWAVES * 64) ((LAS unsigned*)(F.lds + LDSCTL_OFF))[u] = 0u;
    __syncthreads();
#if MK_ONE_LAUNCH
    XcdBarrier bar = xcd_barrier_post((unsigned*)(F.ctl + CW_BAR), F.MISC + 8);
#define GRID_BAR() xcd_barrier(bar)
#else
#define GRID_BAR() do { } while (0)
#endif
    const int lo = get_args()->ph_lo, hi = get_args()->ph_hi;
#ifndef PH_MASK
#define PH_MASK 0xFFFFFFFFu
#endif
#define EN(k) ((PH_MASK >> (k)) & 1u)
#define IN(k) (lo <= (k) && (k) < hi)
#define BOTH(k) (IN(k) && IN((k) + 1))
    if (EN(13) && IN(0)) { p0_prologue(F, get_args()); if (BOTH(0)) GRID_BAR(); }
    if (EN(14) && IN(1)) { p0b_mod_reduce(F, get_args()); if (BOTH(1)) GRID_BAR(); }

    for (int l = 0; l < DEPTH; ++l) {
        const int pb = 2 + NPH_LAYER * l;
        if (EN(0) && IN(pb + 0)) { if (l == 0) { CArgs A = get_args(); unsigned char* ws = A->ws; F.tid = fresh_tid(); F.lane = F.tid & 63; const float* mod = (const float*)(ws + WS_MOD);
                row_phase<false, true, true>(F, A->in[0], nullptr, nullptr, nullptr, nullptr, A->in[5], mod + D, mod, (bf16*)(ws + WS_H), (const float*)(ws + WS_WG), A->in[12], A->in[13], (float*)(ws + WS_GATES)); }
            if (BOTH(pb + 0)) GRID_BAR(); }
        if (EN(1) && IN(pb + 1)) { CArgs A = get_args(); unsigned char* ws = A->ws; F.tid = fresh_tid(); F.lane = F.tid & 63; const float* ropeC = (const float*)(ws + WS_ROPE);
            pg8::Gemm g{(const bf16*)(ws + WS_H), (const bf16*)(ws + WS_W + (size_t)l * W_LAYER + WO_IN), S, NINP, D}; pg8::StaticOrder So; So.init(S, NINP, F.G, (int)blockIdx.x);
            pg8::EpiIn E{P8B(ws, 0), P8_STRIDE / 2, ropeC, ropeC + S * 8, attn_body::C2};
            pg8::gemm_phase<pg8::EpiIn, pg8::StaticOrder, true, true>(F.lds, g, So, E);
            if (BOTH(pb + 1)) GRID_BAR(); }
        if (EN(2) && IN(pb + 2)) { CArgs A = get_args(); unsigned char* ws = A->ws; F.tid = fresh_tid(); F.lane = F.tid & 63;
            prep_conv(F, P8B(ws, 0), (bf16*)(ws + WS_QKC), A->in[10] + (size_t)l * 4 * 2048, A->in[11] + (size_t)l * 2048);
            if (blockIdx.x < 4) gate_scan(F, (int)blockIdx.x, (const float*)(ws + WS_GATES), (float*)(ws + WS_MG), (float*)(ws + WS_DEC));
            if (BOTH(pb + 2)) GRID_BAR(); }
        if (EN(3) && IN(pb + 3)) { CArgs A = get_args(); unsigned char* ws = A->ws; F.tid = fresh_tid(); F.lane = F.tid & 63; __syncthreads();
            for (int u = blockIdx.x; u < 64; u += F.G) mlstm_unit(F, u >> 4, u & 15, (const bf16*)(ws + WS_QKC), P8B(ws, 1), (const float*)(ws + WS_MG), (const float*)(ws + WS_DEC), (bf16*)(ws + WS_HM), A->mode);
            if (BOTH(pb + 3)) GRID_BAR(); }
        if (EN(4) && IN(pb + 4)) { CArgs A = get_args(); unsigned char* ws = A->ws; F.tid = fresh_tid(); F.lane = F.tid & 63; __syncthreads();
            const attn_body::AttnTensors AT{(const attn_body::bf16*)P8B(ws, 3), (const attn_body::bf16*)P8B(ws, 4), (const attn_body::bf16*)P8B(ws, 5), (attn_body::bf16*)(ws + WS_O1), (attn_body::bf16*)(ws + WS_O2)};
            const attn_body::StaticOrder So((int)F.G, (int)blockIdx.x);
            attn_body::attn_phase<attn_body::StaticOrder>((char*)lds, AT, So);
            if (BOTH(pb + 4)) GRID_BAR(); }
        if (EN(5) && IN(pb + 5)) { CArgs A = get_args(); unsigned char* ws = A->ws; F.tid = fresh_tid(); F.lane = F.tid & 63;
            post_phase(F, (const bf16*)(ws + WS_HM), P8B(ws, 2), (const bf16*)(ws + WS_O1), (const bf16*)(ws + WS_O2), A->in[14] + (size_t)l * 2048, A->in[16] + (size_t)l * 2048, A->in[15] + (size_t)l * 256,
                       0.8f - 0.6f * expf(-0.3f * (float)l), (bf16*)(ws + WS_AM), (bf16*)(ws + WS_AB));
            if (BOTH(pb + 5)) GRID_BAR(); }
        if (EN(6) && IN(pb + 6)) { __syncthreads();
            { CArgs A = get_args(); unsigned char* ws = A->ws; F.tid = fresh_tid(); F.lane = F.tid & 63; pg8::Gemm g{(const bf16*)(ws + WS_AB), (const bf16*)(ws + WS_W + (size_t)l * W_LAYER + WO_B), S, D, D}; pg8::StaticOrder So; So.init(S, D, F.G, (int)blockIdx.x); pg8::EpiGateT E{P8B(ws, 7), (float*)(ws + WS_T)};
              pg8::gemm_phase<pg8::EpiGateT, pg8::StaticOrder, true, true>(F.lds, g, So, E); }
            asm volatile("s_waitcnt vmcnt(0)" ::: "memory"); __syncthreads();
            { CArgs A = get_args(); unsigned char* ws = A->ws; F.tid = fresh_tid(); F.lane = F.tid & 63; pg8::Gemm g{(const bf16*)(ws + WS_AM), (const bf16*)(ws + WS_W + (size_t)l * W_LAYER + WO_A), S, D, D}; pg8::StaticOrder So; So.init(S, D, F.G, (int)blockIdx.x); pg8::EpiMerge E{P8B(ws, 6), (const float*)(ws + WS_T), (bf16*)(ws + WS_MRG)};
              pg8::gemm_phase<pg8::EpiMerge, pg8::StaticOrder, true, true>(F.lds, g, So, E); }
            if (BOTH(pb + 6)) GRID_BAR(); }
        if (EN(7) && IN(pb + 7)) { CArgs A = get_args(); unsigned char* ws = A->ws; F.tid = fresh_tid(); F.lane = F.tid & 63; __syncthreads();
            pg8::Gemm g{(const bf16*)(ws + WS_MRG), (const bf16*)(ws + WS_W + (size_t)l * W_LAYER + WO_OUT), S, D, D}; pg8::StaticOrder So; So.init(S, D, F.G, (int)blockIdx.x); pg8::EpiF32 E{(float*)(ws + WS_Y), D};
            pg8::gemm_phase<pg8::EpiF32, pg8::StaticOrder, true, true>(F.lds, g, So, E);
            if (BOTH(pb + 7)) GRID_BAR(); }
        if (EN(8) && IN(pb + 8)) { CArgs A = get_args(); unsigned char* ws = A->ws; F.tid = fresh_tid(); F.lane = F.tid & 63; __syncthreads(); const float* mod = (const float*)(ws + WS_MOD) + (size_t)l * 6 * D;
            row_phase<true, true, false>(F, l == 0 ? A->in[0] : (const float*)A->out, A->out, (const float*)(ws + WS_Y), mod + 2 * D, A->in[6] + (size_t)l * D, A->in[7] + (size_t)l * D, mod + 4 * D, mod + 3 * D, (bf16*)(ws + WS_H), nullptr, nullptr, nullptr, nullptr);
            if (BOTH(pb + 8)) GRID_BAR(); }
        if (EN(9) && IN(pb + 9)) { CArgs A = get_args(); unsigned char* ws = A->ws; F.tid = fresh_tid(); F.lane = F.tid & 63; __syncthreads();
            pg8::Gemm g{(const bf16*)(ws + WS_H), (const bf16*)(ws + WS_W + (size_t)l * W_LAYER + WO_G), S, FF, D}; pg8::StaticOrder So; So.init(S, FF, F.G, (int)blockIdx.x); pg8::EpiPlain E{(bf16*)(ws + WS_G), FF};
            pg8::gemm_phase<pg8::EpiPlain, pg8::StaticOrder, true, true>(F.lds, g, So, E);
            if (BOTH(pb + 9)) GRID_BAR(); }
        if (EN(10) && IN(pb + 10)) { CArgs A = get_args(); unsigned char* ws = A->ws; F.tid = fresh_tid(); F.lane = F.tid & 63; __syncthreads();
            pg8::Gemm g{(const bf16*)(ws + WS_H), (const bf16*)(ws + WS_W + (size_t)l * W_LAYER + WO_U), S, FF, D}; pg8::StaticOrder So; So.init(S, FF, F.G, (int)blockIdx.x);
            pg8::EpiUp E{(const bf16*)(ws + WS_G), (bf16*)(ws + WS_AFF), FF, A->in[22] + (size_t)l * 3 * FF, A->in[23] + (size_t)l * FF};
            pg8::gemm_phase<pg8::EpiUp, pg8::StaticOrder, true, true>(F.lds, g, So, E);
            if (BOTH(pb + 10)) GRID_BAR(); }
        if (EN(11) && IN(pb + 11)) { CArgs A = get_args(); unsigned char* ws = A->ws; F.tid = fresh_tid(); F.lane = F.tid & 63; __syncthreads();
            pg8::Gemm g{(const bf16*)(ws + WS_AFF), (const bf16*)(ws + WS_W + (size_t)l * W_LAYER + WO_D), S, D, FF}; pg8::StaticOrder So; So.init(S, D, F.G, (int)blockIdx.x); pg8::EpiF32 E{(float*)(ws + WS_Y), D};
            pg8::gemm_phase<pg8::EpiF32, pg8::StaticOrder, true, true>(F.lds, g, So, E);
            if (BOTH(pb + 11)) GRID_BAR(); }
        if (EN(12) && IN(pb + 12)) { CArgs A = get_args(); unsigned char* ws = A->ws; F.tid = fresh_tid(); F.lane = F.tid & 63; __syncthreads(); const float* mod = (const float*)(ws + WS_MOD) + (size_t)l * 6 * D;
            if (l + 1 < DEPTH) { const float* modn = mod + 6 * D;
                row_phase<true, true, true>(F, A->out, A->out, (const float*)(ws + WS_Y), mod + 5 * D, A->in[8] + (size_t)l * D, A->in[5] + (size_t)(l + 1) * D, modn + D, modn, (bf16*)(ws + WS_H),
                                            (const float*)(ws + WS_WG) + (size_t)(l + 1) * 8 * D, A->in[12] + 4 * (l + 1), A->in[13] + 4 * (l + 1), (float*)(ws + WS_GATES)); }
            else row_phase<true, false, false>(F, A->out, A->out, (const float*)(ws + WS_Y), mod + 5 * D, A->in[8] + (size_t)l * D, nullptr, nullptr, nullptr, nullptr, nullptr, nullptr, nullptr, nullptr);
            if (BOTH(pb + 12)) GRID_BAR(); }
    }
#undef IN
#undef BOTH
}

#ifdef DBG_CHK
__global__ void chk_kernel(const unsigned* ws, size_t nws, const unsigned* out, size_t nout, unsigned long long* slot) {
    unsigned long long acc = 0; const size_t gt = (size_t)blockIdx.x * blockDim.x + threadIdx.x, NT = (size_t)gridDim.x * blockDim.x;
    for (size_t i = gt; i < nws; i += NT) acc += (unsigned long long)ws[i] * (unsigned long long)((i & 1023) * 2 + 1);
    for (size_t i = gt; i < nout; i += NT) acc += (unsigned long long)out[i] * (unsigned long long)((i & 1023) * 2 + 1);
    for (int o = 32; o > 0; o >>= 1) acc += __shfl_xor(acc, o);
    if ((threadIdx.x & 63) == 0) atomicAdd(slot, acc);
}
__global__ void chk_final(const unsigned long long* chk, int nph, float* out, size_t nout) {
    __shared__ int code;
    if (threadIdx.x == 0) { int c = 99; for (int p = nph - 1; p >= 0; --p) if (chk[p] != chk[64 + p]) c = p + 1; code = c; }
    __syncthreads();
    const size_t gt = (size_t)blockIdx.x * blockDim.x + threadIdx.x, NT = (size_t)gridDim.x * blockDim.x;
    for (size_t i = gt; i < nout; i += NT) out[i] = (i == 0) ? 1000.0f * (float)code : 0.0f;
}
#endif
extern "C" void kernel_launch(void* const* d_in, const int* in_sizes, int n_in, void* d_out, int out_size, void* d_ws, size_t ws_size, hipStream_t stream) {
    static int grid = 0;
    if (grid == 0) {
        if (n_in != 25 || out_size != S * D || ws_size < WS_END) { fprintf(stderr, "kernel_launch: unexpected shapes (n_in %d, out %d, ws %zu); nothing launched\n", n_in, out_size, ws_size); grid = -1; return; }
        int dev = 0, cus = 0, per_cu = 0;
        if (hipGetDevice(&dev) != hipSuccess || hipDeviceGetAttribute(&cus, hipDeviceAttributeMultiprocessorCount, dev) != hipSuccess) { grid = -1; return; }
        if (hipFuncSetAttribute((const void*)trunk_fwd, hipFuncAttributeMaxDynamicSharedMemorySize, LDS_BYTES) != hipSuccess) { fprintf(stderr, "kernel_launch: hipFuncSetAttribute failed\n"); grid = -1; return; }
        if (hipOccupancyMaxActiveBlocksPerMultiprocessor(&per_cu, (const void*)trunk_fwd, NWAVES * 64, LDS_BYTES) != hipSuccess || per_cu < 1) fprintf(stderr, "kernel_launch: occupancy query reports %d\n", per_cu);
        (void)hipGetLastError();
        grid = cus;
        if (grid != 256) fprintf(stderr, "kernel_launch: %d CUs (built for 256)\n", grid);
    }
    if (grid < 0) return;
    if (hipMemsetAsync((char*)d_ws + WS_CTL, 0, CTL_ZERO_BYTES, stream) != hipSuccess) return;
    Args a{};
    for (int i = 0; i < 25; ++i) a.in[i] = (const float*)d_in[i];
    a.out = (float*)d_out; a.ws = (unsigned char*)d_ws;
    for (int j = 0; j < 8; ++j) a.inv[j] = pow(500000.0, -(double)j / 8.0);
    a.mode = 15;
#if MK_ONE_LAUNCH
    a.ph_lo = 0; a.ph_hi = NPH;
    hipLaunchKernelGGL(trunk_fwd, dim3(grid), dim3(NWAVES * 64), LDS_BYTES, stream, a);
#else
#ifdef DBG_CHK
    unsigned long long* chk = (unsigned long long*)((char*)d_ws + 65536);
    for (int run = 0; run < 2; ++run) {
    (void)hipMemsetAsync((char*)d_ws + CTL_ZERO_BYTES, 0xAA, WS_END - CTL_ZERO_BYTES, stream);
    (void)hipMemsetAsync(d_out, 0xAA, (size_t)S * D * 4, stream);
#endif
    for (int p = 0; p < NPH; ++p) {
        if (p >= 2 + NPH_LAYER && ((p - 2) % NPH_LAYER) == 0) continue;
#ifdef DBG_CHK
        if (p >= 2 + DBG_CHK * NPH_LAYER) continue;
#endif
        a.ph_lo = p; a.ph_hi = p + 1;
        hipLaunchKernelGGL(trunk_fwd, dim3(grid), dim3(NWAVES * 64), LDS_BYTES, stream, a);
#ifdef DBG_CHK
        hipLaunchKernelGGL(chk_kernel, dim3(2048), dim3(256), 0, stream, (const unsigned*)((char*)d_ws + CTL_ZERO_BYTES), (size_t)(WS_END - CTL_ZERO_BYTES) / 4, (const unsigned*)d_out, (size_t)S * D, chk + run * 64 + p);
#endif
    }
#ifdef DBG_CHK
    }
    hipLaunchKernelGGL(chk_final, dim3(1024), dim3(256), 0, stream, (const unsigned long long*)chk, 2 + DBG_CHK * NPH_LAYER, (float*)d_out, (size_t)S * D);
#endif
#endif
    const hipError_t le = hipPeekAtLastError();
    if (le != hipSuccess) fprintf(stderr, "kernel_launch: launch failed: %s\n", hipGetErrorName(le));
}
```

```cpp
#include <hip/hip_runtime.h>
#include <hip/hip_bf16.h>
#include <cstdio>
#include <cstdint>
#include <cmath>
__device__ __forceinline__ int fresh_tid(int wave) { int l_; asm volatile("v_mbcnt_lo_u32_b32 %0, -1, 0\n\tv_mbcnt_hi_u32_b32 %0, -1, %0" : "=v"(l_)); return l_ + 64 * wave; }
namespace pg8 {
#define PG8_LAS __attribute__((address_space(3)))
typedef unsigned short bf16_t;
typedef short bf16x8 __attribute__((ext_vector_type(8)));
typedef float f32x4 __attribute__((ext_vector_type(4)));
typedef unsigned u32x4 __attribute__((ext_vector_type(4)));
constexpr int BM = 256, BK = 64, HALF = 128, HTB = HALF * BK * 2  , STAGE_BYTES = 8 * HTB, NXCD = 8, WGM = 8;

__host__ __device__ __forceinline__ int lds_byte(int r, int c) { const int st = (r >> 4) * 2 + (c >> 5), rr = r & 15, cc = c & 31, ob = rr * 64 + cc * 2; return st * 1024 + (ob ^ (((ob >> 9) & 1) << 5)); }
__host__ __device__ __forceinline__ void stage_rc(int b, int& R, int& C) { const int st = b / 1024, sb = b % 1024, swz = sb ^ (((sb >> 9) & 1) << 5); R = (st >> 1) * 16 + swz / 64; C = (st & 1) * 32 + (swz % 64) / 2; }
__host__ __device__ __forceinline__ int perm32(int rho) { const int n = rho >> 4, i = rho & 15; return 8 * (i >> 2) + 4 * n + (i & 3); }

struct Unit { int pm, pn, kh; };
struct Gemm { const bf16_t* A; const bf16_t* Bt; int M, N, K; };

struct StaticOrder {
    int nM, nN, nwg, G, c;
    __host__ __device__ void init(int M, int N, int G_, int c_) { nM = M / BM; nN = N / BM; nwg = nM * nN; G = G_; c = c_; }
    __host__ __device__ bool next(int i, Unit& u) const {
        const long L = (long)i * G + c; if (L >= nwg) return false;
        int wgid = (int)L; { const int q = nwg / NXCD, r = nwg % NXCD, xcd = wgid % NXCD, off = wgid / NXCD; wgid = (xcd < r ? xcd * (q + 1) : r * (q + 1) + (xcd - r) * q) + off; }
        const int nig = WGM * nN, gid = wgid / nig, fm = gid * WGM, gsz = (nM - fm) < WGM ? (nM - fm) : WGM;
        u.pm = fm + ((wgid % nig) % gsz); u.pn = (wgid % nig) / gsz; u.kh = 0; return true;
    }
    __device__ __forceinline__ void a_ready(const Unit&) const {}
    __device__ __forceinline__ void done(const Unit&) const {}
};

struct SplitK2Order { StaticOrder base;
    __device__ __forceinline__ bool next(int i, Unit& u) const { if (!base.next(i >> 1, u)) return false; u.kh = i & 1; return true; }
    __device__ __forceinline__ void a_ready(const Unit&) const {}
    __device__ __forceinline__ void done(const Unit&) const {} };

typedef float cvt_f32x2_t __attribute__((ext_vector_type(2))); typedef __bf16 cvt_bf16x2_t __attribute__((ext_vector_type(2)));
__device__ __forceinline__ unsigned cvt_pk_bf16(float lo, float hi) { cvt_f32x2_t v = {lo, hi}; cvt_bf16x2_t b = __builtin_convertvector(v, cvt_bf16x2_t); return __builtin_bit_cast(unsigned, b); }
typedef float f32x2 __attribute__((ext_vector_type(2)));
__device__ __forceinline__ float sigm(float x) { return __builtin_amdgcn_rcpf(1.0f + __expf(-x)); }
__device__ __forceinline__ float bf_lo(unsigned u) { return __builtin_bit_cast(float, u << 16); }
__device__ __forceinline__ float bf_hi(unsigned u) { return __builtin_bit_cast(float, u & 0xffff0000u); }
__device__ __forceinline__ void unpack8(const u32x4 w, float (&f)[8]) { f[0] = bf_lo(w.x); f[1] = bf_hi(w.x); f[2] = bf_lo(w.y); f[3] = bf_hi(w.y); f[4] = bf_lo(w.z); f[5] = bf_hi(w.z); f[6] = bf_lo(w.w); f[7] = bf_hi(w.w); }
__device__ __forceinline__ u32x4 pack8(const float (&f)[8]) { u32x4 w; w.x = cvt_pk_bf16(f[0], f[1]); w.y = cvt_pk_bf16(f[2], f[3]); w.z = cvt_pk_bf16(f[4], f[5]); w.w = cvt_pk_bf16(f[6], f[7]); return w; }

struct EpiIn {
    static constexpr bool PERM = true, AFTER_DRAIN = false, HAS_MID = false;
    bf16_t* base; size_t split_stride; const float* ropeC; const float* ropeS; float qscale;
    __device__ __forceinline__ void operator()(const f32x4 (&acc)[2][2][4][2], const Unit& u, int wr, int wc, int fr, int fq) const {
        const int t = u.pn >> 3; bf16_t* O = base + (size_t)t * split_stride;
        const int row0 = u.pm * BM + wr * 64 + fr, col0 = (u.pn & 7) * BM + wc * 32 + 8 * fq;
        const bool sg = (t == 2) || (t >= 6), rope = (t == 3 || t == 4) && ((wc & 1) == 0) && (fq < 2);
        const float sc = (t == 3) ? qscale : 1.f;
#pragma unroll
        for (int ai = 0; ai < 2; ++ai)
#pragma unroll
            for (int m = 0; m < 4; ++m) { const int row = row0 + ai * HALF + m * 16; bf16_t* rowp = O + (size_t)row * 2048 + col0;
                f32x4 cs = (f32x4){1.f, 1.f, 1.f, 1.f}, sn = (f32x4){0.f, 0.f, 0.f, 0.f};
                if (rope) { cs = *(const f32x4*)(ropeC + (size_t)row * 8 + 4 * fq); sn = *(const f32x4*)(ropeS + (size_t)row * 8 + 4 * fq); }
#pragma unroll
                for (int bj = 0; bj < 2; ++bj) { f32x4 v0 = acc[ai][bj][m][0], v1 = acc[ai][bj][m][1];
                    if (sg) { v0 = (f32x4){sigm(v0[0]), sigm(v0[1]), sigm(v0[2]), sigm(v0[3])}; v1 = (f32x4){sigm(v1[0]), sigm(v1[1]), sigm(v1[2]), sigm(v1[3])}; }
                    if (rope) { const f32x4 a = v0, b = v1;
                        v0[0] = a[0] * cs[0] - a[1] * sn[0]; v0[1] = a[1] * cs[0] + a[0] * sn[0]; v0[2] = a[2] * cs[1] - a[3] * sn[1]; v0[3] = a[3] * cs[1] + a[2] * sn[1];
                        v1[0] = b[0] * cs[2] - b[1] * sn[2]; v1[1] = b[1] * cs[2] + b[0] * sn[2]; v1[2] = b[2] * cs[3] - b[3] * sn[3]; v1[3] = b[3] * cs[3] + b[2] * sn[3]; }
                    v0 = v0 * sc; v1 = v1 * sc; u32x4 w; w.x = cvt_pk_bf16(v0[0], v0[1]); w.y = cvt_pk_bf16(v0[2], v0[3]); w.z = cvt_pk_bf16(v1[0], v1[1]); w.w = cvt_pk_bf16(v1[2], v1[3]);
                    *(u32x4*)(rowp + bj * HALF) = w; } }
    }
};
struct EpiPlain {
    static constexpr bool PERM = true, AFTER_DRAIN = false, HAS_MID = false;
    bf16_t* O; int ldc;
    __device__ __forceinline__ void operator()(const f32x4 (&acc)[2][2][4][2], const Unit& u, int wr, int wc, int fr, int fq) const {
        const int row0 = u.pm * BM + wr * 64 + fr, col0 = u.pn * BM + wc * 32 + 8 * fq;
#pragma unroll
        for (int ai = 0; ai < 2; ++ai)
#pragma unroll
            for (int m = 0; m < 4; ++m) { bf16_t* rowp = O + (size_t)(row0 + ai * HALF + m * 16) * ldc + col0;
#pragma unroll
                for (int bj = 0; bj < 2; ++bj) { const f32x4 v0 = acc[ai][bj][m][0], v1 = acc[ai][bj][m][1]; u32x4 w; w.x = cvt_pk_bf16(v0[0], v0[1]); w.y = cvt_pk_bf16(v0[2], v0[3]); w.z = cvt_pk_bf16(v1[0], v1[1]); w.w = cvt_pk_bf16(v1[2], v1[3]);
                    *(u32x4*)(rowp + bj * HALF) = w; } }
    }
};
struct EpiUp {
    static constexpr bool PERM = true, AFTER_DRAIN = false, HAS_MID = false;
    const bf16_t* G; bf16_t* O; int ldc; const float* cw; const float* cb;
    __device__ __forceinline__ void operator()(const f32x4 (&acc)[2][2][4][2], const Unit& u, int wr, int wc, int fr, int fq) const {
        const int row0 = u.pm * BM + wr * 64 + fr, col0 = u.pn * BM + wc * 32 + 8 * fq;
#pragma unroll
        for (int bj = 0; bj < 2; ++bj) { const int c = col0 + bj * HALF;
            float w0[8], w1[8], w2[8], bb[8];
            { const f32x4 a = *(const f32x4*)(cw + c), b = *(const f32x4*)(cw + c + 4); w0[0] = a[0]; w0[1] = a[1]; w0[2] = a[2]; w0[3] = a[3]; w0[4] = b[0]; w0[5] = b[1]; w0[6] = b[2]; w0[7] = b[3]; }
            { const f32x4 a = *(const f32x4*)(cw + ldc + c), b = *(const f32x4*)(cw + ldc + c + 4); w1[0] = a[0]; w1[1] = a[1]; w1[2] = a[2]; w1[3] = a[3]; w1[4] = b[0]; w1[5] = b[1]; w1[6] = b[2]; w1[7] = b[3]; }
            { const f32x4 a = *(const f32x4*)(cw + 2 * ldc + c), b = *(const f32x4*)(cw + 2 * ldc + c + 4); w2[0] = a[0]; w2[1] = a[1]; w2[2] = a[2]; w2[3] = a[3]; w2[4] = b[0]; w2[5] = b[1]; w2[6] = b[2]; w2[7] = b[3]; }
            { const f32x4 a = *(const f32x4*)(cb + c), b = *(const f32x4*)(cb + c + 4); bb[0] = a[0]; bb[1] = a[1]; bb[2] = a[2]; bb[3] = a[3]; bb[4] = b[0]; bb[5] = b[1]; bb[6] = b[2]; bb[7] = b[3]; }
#pragma unroll
            for (int ai = 0; ai < 2; ++ai)
#pragma unroll
                for (int m = 0; m < 4; ++m) { const int row = row0 + ai * HALF + m * 16; const bf16_t* gp = G + (size_t)row * ldc + c;
                    const u32x4 z = (u32x4){0u, 0u, 0u, 0u};
                    const u32x4 r0 = *(const u32x4*)gp, r1 = row >= 1 ? *(const u32x4*)(gp - ldc) : z, r2 = row >= 2 ? *(const u32x4*)(gp - 2 * ldc) : z;
                    float g0[8], g1[8], g2[8], o[8]; unpack8(r0, g0); unpack8(r1, g1); unpack8(r2, g2);
                    const f32x4 v0 = acc[ai][bj][m][0], v1 = acc[ai][bj][m][1]; const float av[8] = {v0[0], v0[1], v0[2], v0[3], v1[0], v1[1], v1[2], v1[3]};
#pragma unroll
                    for (int e = 0; e < 8; ++e) { const float gc = bb[e] + w0[e] * g2[e] + w1[e] * g1[e] + w2[e] * g0[e]; o[e] = gc * sigm(gc) * av[e]; }
                    *(u32x4*)(O + (size_t)row * ldc + c) = pack8(o); } }
    }
};
struct EpiMerge2 {
    static constexpr bool PERM = true, AFTER_DRAIN = false, HAS_MID = true;
    const bf16_t* Ga; const bf16_t* Gb; bf16_t* O;
    __device__ __forceinline__ void mid(f32x4 (&acc)[2][2][4][2], const Unit& u, int wr, int wc, int fr, int fq) const {
        const int row0 = u.pm * BM + wr * 64 + fr, col0 = u.pn * BM + wc * 32 + 8 * fq;
#pragma unroll
        for (int ai = 0; ai < 2; ++ai)
#pragma unroll
            for (int m = 0; m < 4; ++m) { const size_t off = (size_t)(row0 + ai * HALF + m * 16) * 2048 + col0;
#pragma unroll
                for (int bj = 0; bj < 2; ++bj) { float ga[8], gb[8]; unpack8(*(const u32x4*)(Ga + off + bj * HALF), ga); unpack8(*(const u32x4*)(Gb + off + bj * HALF), gb);
                    f32x4 r0 = (f32x4){gb[0] * __builtin_amdgcn_rcpf(ga[0]), gb[1] * __builtin_amdgcn_rcpf(ga[1]), gb[2] * __builtin_amdgcn_rcpf(ga[2]), gb[3] * __builtin_amdgcn_rcpf(ga[3])};
                    f32x4 r1 = (f32x4){gb[4] * __builtin_amdgcn_rcpf(ga[4]), gb[5] * __builtin_amdgcn_rcpf(ga[5]), gb[6] * __builtin_amdgcn_rcpf(ga[6]), gb[7] * __builtin_amdgcn_rcpf(ga[7])};
                    acc[ai][bj][m][0] = acc[ai][bj][m][0] * r0; acc[ai][bj][m][1] = acc[ai][bj][m][1] * r1; }
                }
    }
    __device__ __forceinline__ void operator()(const f32x4 (&acc)[2][2][4][2], const Unit& u, int wr, int wc, int fr, int fq) const {
        const int row0 = u.pm * BM + wr * 64 + fr, col0 = u.pn * BM + wc * 32 + 8 * fq;
#pragma unroll
        for (int ai = 0; ai < 2; ++ai)
#pragma unroll
            for (int m = 0; m < 4; ++m) { const size_t off = (size_t)(row0 + ai * HALF + m * 16) * 2048 + col0;
#pragma unroll
                for (int bj = 0; bj < 2; ++bj) { float g[8]; unpack8(*(const u32x4*)(Ga + off + bj * HALF), g); const f32x4 v0 = acc[ai][bj][m][0], v1 = acc[ai][bj][m][1];
                    float o[8] = {v0[0] * g[0], v0[1] * g[1], v0[2] * g[2], v0[3] * g[3], v1[0] * g[4], v1[1] * g[5], v1[2] * g[6], v1[3] * g[7]};
                    *(u32x4*)(O + off + bj * HALF) = pack8(o); } }
    }
};
struct EpiF32 {
    static constexpr bool PERM = false, AFTER_DRAIN = false, HAS_MID = false;
    float* Y; int ldc;
    __device__ __forceinline__ void operator()(const f32x4 (&acc)[2][2][4][2], const Unit& u, int wr, int wc, int fr, int fq) const {
        const int row0 = u.pm * BM + wr * 64 + fr, col0 = u.pn * BM + wc * 32 + 4 * fq;
#pragma unroll
        for (int ai = 0; ai < 2; ++ai)
#pragma unroll
            for (int m = 0; m < 4; ++m) { float* rowp = Y + (size_t)(row0 + ai * HALF + m * 16) * ldc + col0;
#pragma unroll
                for (int bj = 0; bj < 2; ++bj)
#pragma unroll
                    for (int n = 0; n < 2; ++n) *(f32x4*)(rowp + bj * HALF + n * 16) = acc[ai][bj][m][n]; }
    }
};

template <class Epi, class Sched, bool ALIGN_EPI = false, bool SP2 = false>
__device__ __forceinline__ void gemm_phase(PG8_LAS unsigned char* lds, const Gemm g, const Sched& S, const Epi& E, const int wave_id) {
    const int tid = fresh_tid(wave_id), wid = __builtin_amdgcn_readfirstlane(tid >> 6), lane = tid & 63, wr = wid >> 2, wc = wid & 3, fr = lane & 15, fq = lane >> 4;
    const int K = g.K, nt = (Epi::HAS_MID ? K / 2 : K) / BK;
    unsigned voffA[2], voffB[2];
#pragma unroll
    for (int i = 0; i < 2; ++i) { int R, C; stage_rc(tid * 16 + i * 8192, R, C); const int Rb = Epi::PERM ? ((R & ~31) + perm32(R & 31)) : R;
        voffA[i] = (unsigned)(R * K + C) * 2u; voffB[i] = (unsigned)(Rb * K + C) * 2u; }
    const size_t kstep = (size_t)(BK * 2);
    const size_t hstep = (size_t)HALF * K * 2;
    const size_t tstep = 2 * hstep;
    const unsigned ldsw = (unsigned)wid * 1024u;
    const int aoff = lds_byte(wr * 64 + fr, fq * 8), boff = lds_byte(wc * 32 + fr, fq * 8);
#define PG8_SA(b, h) (((b) * 2 + (h)) * HTB)
#define PG8_SB(b, h) ((4 + (b) * 2 + (h)) * HTB)
#define PG8_STAGE(bufoff, gbase, voff) do { _Pragma("unroll") for (int _i = 0; _i < 2; ++_i) \
        __builtin_amdgcn_global_load_lds((const unsigned*)((const char*)(gbase) + (voff)[_i]), (PG8_LAS unsigned*)(lds + (bufoff) + ldsw + _i * 8192), 16, 0, 0); } while (0)
#define PG8_LDA(dst, b, h) do { _Pragma("unroll") for (int m = 0; m < 4; ++m) _Pragma("unroll") for (int k = 0; k < 2; ++k) dst[m][k] = *(const PG8_LAS bf16x8*)(lds + PG8_SA(b, h) + aoff + m * 2048 + k * 1024); } while (0)
#define PG8_LDB(dst, b, h) do { _Pragma("unroll") for (int n = 0; n < 2; ++n) _Pragma("unroll") for (int k = 0; k < 2; ++k) dst[n][k] = *(const PG8_LAS bf16x8*)(lds + PG8_SB(b, h) + boff + n * 2048 + k * 1024); } while (0)
#define PG8_MMA(ai, bj, At, Bt) do { __builtin_amdgcn_s_setprio(1); _Pragma("unroll") for (int m = 0; m < 4; ++m) _Pragma("unroll") for (int n = 0; n < 2; ++n) _Pragma("unroll") for (int k = 0; k < 2; ++k) \
        acc[ai][bj][m][n] = __builtin_amdgcn_mfma_f32_16x16x32_bf16(Bt[n][k], At[m][k], acc[ai][bj][m][n], 0, 0, 0); __builtin_amdgcn_s_setprio(0); } while (0)
#define PG8_WAIT_V(n) asm volatile("s_waitcnt vmcnt(" #n ")" ::: "memory")
#define PG8_WAIT_L(n) asm volatile("s_waitcnt lgkmcnt(" #n ")" ::: "memory")
#define PG8_BAR __builtin_amdgcn_s_barrier()
#define PG8_SCHED __builtin_amdgcn_sched_barrier(0)
    Unit cur, nxt; int ui = 0;
    if (!S.next(0, cur)) return;
    f32x4 acc[2][2][4][2];
#pragma unroll
    for (int a = 0; a < 2; ++a)
#pragma unroll
        for (int b = 0; b < 2; ++b)
#pragma unroll
            for (int m = 0; m < 4; ++m)
#pragma unroll
                for (int n = 0; n < 2; ++n) acc[a][b][m][n] = (f32x4){0.f, 0.f, 0.f, 0.f};
    bf16x8 At[4][2], B0[2][2], B1[2][2];
    const char* cA = (const char*)g.A + (size_t)cur.pm * tstep + (size_t)cur.kh * K; const char* cB = (const char*)g.Bt + (size_t)cur.pn * tstep + (size_t)cur.kh * K;
    S.a_ready(cur);
    if constexpr (SP2) {
        PG8_STAGE(PG8_SB(0, 0), cB, voffB); PG8_STAGE(PG8_SB(0, 1), cB + hstep, voffB); PG8_STAGE(PG8_SA(0, 0), cA, voffA); PG8_STAGE(PG8_SA(0, 1), cA + hstep, voffA);
        if (wr == 1) PG8_BAR;
        PG8_WAIT_V(2); PG8_BAR;
        PG8_STAGE(PG8_SB(1, 0), cB + kstep, voffB); PG8_STAGE(PG8_SA(1, 0), cA + kstep, voffA); PG8_STAGE(PG8_SB(1, 1), cB + hstep + kstep, voffB);
        PG8_WAIT_V(6); PG8_BAR;
    } else {
        PG8_STAGE(PG8_SB(0, 0), cB, voffB); PG8_STAGE(PG8_SA(0, 0), cA, voffA); PG8_STAGE(PG8_SB(0, 1), cB + hstep, voffB); PG8_STAGE(PG8_SA(0, 1), cA + hstep, voffA);
        if (wr == 1) PG8_BAR;
        PG8_WAIT_V(4); PG8_BAR;
        PG8_STAGE(PG8_SB(1, 0), cB + kstep, voffB); PG8_STAGE(PG8_SA(1, 0), cA + kstep, voffA); PG8_STAGE(PG8_SB(1, 1), cB + hstep + kstep, voffB);
        PG8_WAIT_V(6); PG8_BAR;
    }
    for (;;) {
        const bool has_next = S.next(ui + 1, nxt);
        const char* nA = has_next ? (const char*)g.A + (size_t)nxt.pm * tstep + (size_t)nxt.kh * K : cA; const char* nB = has_next ? (const char*)g.Bt + (size_t)nxt.pn * tstep + (size_t)nxt.kh * K : cB;
        for (int t = 0; t < nt; t += 2) {
            const bool last = (t == nt - 2);
            const char* a1 = cA + (size_t)(t + 1) * kstep;
            const char* a2 = last ? nA : cA + (size_t)(t + 2) * kstep; const char* b2 = last ? nB : cB + (size_t)(t + 2) * kstep;
            const char* a3 = a2 + kstep; const char* b3 = b2 + kstep;
            if (last && has_next) S.a_ready(nxt);
            if constexpr (SP2) {
            PG8_LDB(B0, 0, 0); PG8_LDB(B1, 0, 1); PG8_SCHED; PG8_LDA(At, 0, 0); PG8_STAGE(PG8_SA(1, 1), a1 + hstep, voffA);
            PG8_WAIT_V(8); PG8_WAIT_L(0); PG8_BAR; PG8_MMA(0, 0, At, B0); PG8_MMA(0, 1, At, B1); PG8_BAR; PG8_SCHED;
            PG8_LDA(At, 0, 1); PG8_STAGE(PG8_SB(0, 0), b2, voffB); PG8_STAGE(PG8_SB(0, 1), b2 + hstep, voffB); PG8_STAGE(PG8_SA(0, 0), a2, voffA);
            PG8_WAIT_V(8); PG8_WAIT_L(0); PG8_BAR; PG8_MMA(1, 0, At, B0); PG8_MMA(1, 1, At, B1); PG8_BAR; PG8_SCHED;
            PG8_LDB(B0, 1, 0); PG8_LDB(B1, 1, 1); PG8_SCHED; PG8_LDA(At, 1, 0); PG8_STAGE(PG8_SA(0, 1), a2 + hstep, voffA);
            PG8_WAIT_V(8); PG8_WAIT_L(0); PG8_BAR; PG8_MMA(0, 0, At, B0); PG8_MMA(0, 1, At, B1); PG8_BAR; PG8_SCHED;
            PG8_LDA(At, 1, 1); PG8_STAGE(PG8_SB(1, 0), b3, voffB); PG8_STAGE(PG8_SB(1, 1), b3 + hstep, voffB); PG8_STAGE(PG8_SA(1, 0), a3, voffA);
            PG8_WAIT_V(8); PG8_WAIT_L(0); PG8_BAR; PG8_MMA(1, 0, At, B0); PG8_MMA(1, 1, At, B1); PG8_BAR; PG8_SCHED;
            } else {
            PG8_LDB(B0, 0, 0); PG8_SCHED; PG8_LDA(At, 0, 0); PG8_STAGE(PG8_SA(1, 1), a1 + hstep, voffA);
            PG8_WAIT_L(8); PG8_BAR; PG8_WAIT_L(0); PG8_MMA(0, 0, At, B0); PG8_BAR; PG8_SCHED;
            PG8_LDB(B1, 0, 1); PG8_STAGE(PG8_SB(0, 0), b2, voffB);
            PG8_BAR; PG8_WAIT_L(0); PG8_MMA(0, 1, At, B1); PG8_BAR;
            PG8_LDA(At, 0, 1); PG8_STAGE(PG8_SA(0, 0), a2, voffA);
            PG8_BAR; PG8_WAIT_L(0); PG8_MMA(1, 0, At, B0); PG8_BAR; PG8_SCHED;
            PG8_STAGE(PG8_SB(0, 1), b2 + hstep, voffB);
            PG8_WAIT_V(6); PG8_BAR; PG8_MMA(1, 1, At, B1); PG8_BAR;
            PG8_LDB(B0, 1, 0); PG8_SCHED; PG8_LDA(At, 1, 0); PG8_STAGE(PG8_SA(0, 1), a2 + hstep, voffA);
            PG8_WAIT_L(8); PG8_BAR; PG8_WAIT_L(0); PG8_MMA(0, 0, At, B0); PG8_BAR; PG8_SCHED;
            PG8_LDB(B1, 1, 1); PG8_STAGE(PG8_SB(1, 0), b3, voffB);
            PG8_BAR; PG8_WAIT_L(0); PG8_MMA(0, 1, At, B1); PG8_BAR;
            PG8_LDA(At, 1, 1); PG8_STAGE(PG8_SA(1, 0), a3, voffA);
            PG8_BAR; PG8_WAIT_L(0); PG8_MMA(1, 0, At, B0); PG8_BAR; PG8_SCHED;
            PG8_STAGE(PG8_SB(1, 1), b3 + hstep, voffB);
            PG8_WAIT_V(6); PG8_BAR; PG8_MMA(1, 1, At, B1); PG8_BAR;
            }
        }
        if constexpr (ALIGN_EPI) { if (wr == 0) PG8_BAR; }
        bool keep = false;
        if constexpr (Epi::HAS_MID) { keep = (cur.kh == 0); if (keep) E.mid(acc, cur, wr, wc, fr, fq); else E(acc, cur, wr, wc, fr, fq); S.done(cur); }
        else if constexpr (!Epi::AFTER_DRAIN) { E(acc, cur, wr, wc, fr, fq); S.done(cur); }
        if (!has_next) break;
        if (!keep)
#pragma unroll
        for (int a = 0; a < 2; ++a)
#pragma unroll
            for (int b = 0; b < 2; ++b)
#pragma unroll
                for (int m = 0; m < 4; ++m)
#pragma unroll
                    for (int n = 0; n < 2; ++n) acc[a][b][m][n] = (f32x4){0.f, 0.f, 0.f, 0.f};
        cur = nxt; cA = nA; cB = nB; ++ui;
        if constexpr (ALIGN_EPI) { if (wr == 1) PG8_BAR; }
    }
    PG8_WAIT_V(0);
    if constexpr (!ALIGN_EPI) { if (wr == 0) PG8_BAR; }
    PG8_BAR;
    if constexpr (Epi::AFTER_DRAIN) { E.fused(acc, cur, wr, wc, fr, fq, lds, wid, lane); S.done(cur); }
#undef PG8_SA
#undef PG8_SB
#undef PG8_STAGE
#undef PG8_LDA
#undef PG8_LDB
#undef PG8_MMA
#undef PG8_WAIT_V
#undef PG8_WAIT_L
#undef PG8_BAR
#undef PG8_SCHED
}
}
namespace attn_body {
using bf16=__hip_bfloat16;
using bf16x8=__attribute__((ext_vector_type(8)))short;
using s16x4=__attribute__((ext_vector_type(4)))short;
using f32x16=__attribute__((ext_vector_type(16)))float;
using u32x4=__attribute__((ext_vector_type(4)))unsigned;
constexpr int SEQ=8192,D=64,DM=2048;
constexpr int NW=8,QBLK=32,QB=QBLK*NW,KVBLK=64,NQB=SEQ/QB;
constexpr int ATTN_PITCH=DM, ATTN_UNIT_ROWS=QB;
__device__ __forceinline__ int crow(int r,int hi){return (r&3)+8*(r>>2)+4*hi;}
#define SBAR() __builtin_amdgcn_sched_barrier(0)
__device__ __forceinline__ void cmask(f32x16&p0,f32x16&p1,int jb,int wid){
  const float NEG=-INFINITY;
  if(jb>(wid>>1)){
    #pragma unroll
    for(int r=0;r<16;++r){p0[r]=NEG;p1[r]=NEG;}
  }
}

constexpr int NSLOT=3, SLOTB=8192;
constexpr int LDS_K=0, LDS_V=NSLOT*SLOTB, LDS_WS=3*NSLOT*SLOTB, LDS_OST=LDS_WS+NW*64*4, LDS_QS=LDS_OST+NW*4096, LDS_BYTES=LDS_QS+NW*4608;
constexpr float C2=0.125f*1.4426950408889634f;
__device__ __forceinline__ void glds16(const void*gsrc,unsigned lds_dst){unsigned keep;
  asm volatile("s_mov_b32 %0, m0\n\ts_mov_b32 m0, %2\n\ts_nop 0\n\tglobal_load_lds_dwordx4 %1, off\n\ts_mov_b32 m0, %0":"=&s"(keep):"v"(gsrc),"s"(lds_dst):"memory");}
__device__ __forceinline__ float max3f(float a,float b,float c){float r;asm("v_max3_f32 %0, %1, %2, %3":"=v"(r):"v"(a),"v"(b),"v"(c));return r;}
__device__ __forceinline__ float max2f(float a,float b){float r;asm("v_max_f32_e32 %0, %1, %2":"=v"(r):"v"(a),"v"(b));return r;}
__device__ __forceinline__ float fadd_s(float a,float b){float r;asm("v_add_f32_e32 %0, %1, %2":"=v"(r):"v"(a),"v"(b));return r;}
__device__ __forceinline__ float fsub_s(float a,float b){float r;asm("v_sub_f32_e32 %0, %1, %2":"=v"(r):"v"(a),"v"(b));return r;}
typedef float f32x2_t __attribute__((ext_vector_type(2))); typedef __bf16 bf16x2_t __attribute__((ext_vector_type(2)));
__device__ __forceinline__ unsigned cvtpk_s(float lo,float hi){f32x2_t v={lo,hi};bf16x2_t b=__builtin_convertvector(v,bf16x2_t);return __builtin_bit_cast(unsigned,b);}
#define WAIT_BAR(N) asm volatile("s_waitcnt vmcnt(" #N ") lgkmcnt(0)\n\ts_barrier":::"memory")

__device__ __forceinline__ void qkt(f32x16&p0,f32x16&p1,const char*Kslot,const bf16x8*qr,int r32,int hi){ const f32x16 negm=f32x16{};
  const char*kb=Kslot+hi*1024+r32*16;
  #pragma unroll
  for(int d0=0;d0<4;++d0){
    const bf16x8 b0=*reinterpret_cast<const bf16x8*>(kb+d0*2048);
    const bf16x8 b1=*reinterpret_cast<const bf16x8*>(kb+d0*2048+512);
    if(d0==0){p0=__builtin_amdgcn_mfma_f32_32x32x16_bf16(b0,qr[0],negm,0,0,0);p1=__builtin_amdgcn_mfma_f32_32x32x16_bf16(b1,qr[0],negm,0,0,0);}
    else{p0=__builtin_amdgcn_mfma_f32_32x32x16_bf16(b0,qr[d0],p0,0,0,0);p1=__builtin_amdgcn_mfma_f32_32x32x16_bf16(b1,qr[d0],p1,0,0,0);}}
}
typedef __attribute__((address_space(3))) const char* lds_cptr;
typedef short v4i16_t __attribute__((ext_vector_type(4)));
__device__ __forceinline__ void kload8(bf16x8*kf,lds_cptr kp){
  kf[0]=*(const __attribute__((address_space(3))) bf16x8*)(kp);      kf[1]=*(const __attribute__((address_space(3))) bf16x8*)(kp+512);
  kf[2]=*(const __attribute__((address_space(3))) bf16x8*)(kp+2048); kf[3]=*(const __attribute__((address_space(3))) bf16x8*)(kp+2560);
  kf[4]=*(const __attribute__((address_space(3))) bf16x8*)(kp+4096); kf[5]=*(const __attribute__((address_space(3))) bf16x8*)(kp+4608);
  kf[6]=*(const __attribute__((address_space(3))) bf16x8*)(kp+6144); kf[7]=*(const __attribute__((address_space(3))) bf16x8*)(kp+6656);
}
__device__ __forceinline__ void kload2(bf16x8*kf,lds_cptr kp,int j){ kf[2*j]=*(const __attribute__((address_space(3))) bf16x8*)(kp+j*2048); kf[2*j+1]=*(const __attribute__((address_space(3))) bf16x8*)(kp+j*2048+512); }
__device__ __forceinline__ s16x4 vtr(lds_cptr p){ return __builtin_bit_cast(s16x4,__builtin_amdgcn_ds_read_tr16_b64_v4i16((__attribute__((address_space(3))) v4i16_t*)p)); }
__device__ __forceinline__ float rowmax(const f32x16&p0,const f32x16&p1){
  float a=max3f(p0[0],p0[1],p1[0]),b=max3f(p0[2],p0[3],p1[1]);a=max3f(a,p1[2],p1[3]);
  #pragma unroll
  for(int r=4;r<16;r+=4){a=max3f(a,p0[r],p0[r+1]);b=max3f(b,p0[r+2],p0[r+3]);a=max3f(a,p1[r],p1[r+1]);b=max3f(b,p1[r+2],p1[r+3]);}
  const float m=max2f(a,b);
  auto rr=__builtin_amdgcn_permlane32_swap(__float_as_uint(m),__float_as_uint(m),false,false);
  return max2f(__uint_as_float(rr[0]),__uint_as_float(rr[1]));
}
__device__ __forceinline__ void pv(f32x16*o,int vb,bf16x8 pa0,bf16x8 pa1,bf16x8 pa2,bf16x8 pa3){
  #pragma unroll
  for(int d0=0;d0<2;++d0){s16x4 lo[4],hi[4];
    #pragma unroll
    for(int ks=0;ks<4;++ks){
      asm volatile("ds_read_b64_tr_b16 %0,%1 offset:%c2":"=&v"(lo[ks]):"v"(vb),"i"(d0*4096+ks*1024):"memory");
      asm volatile("ds_read_b64_tr_b16 %0,%1 offset:%c2":"=&v"(hi[ks]):"v"(vb),"i"(d0*4096+ks*1024+512):"memory");}
    asm volatile("s_waitcnt lgkmcnt(0)":::"memory");SBAR();
    #define PK(k) (bf16x8){lo[k][0],lo[k][1],lo[k][2],lo[k][3],hi[k][0],hi[k][1],hi[k][2],hi[k][3]}
    o[d0]=__builtin_amdgcn_mfma_f32_32x32x16_bf16(pa0,PK(0),o[d0],0,0,0);
    o[d0]=__builtin_amdgcn_mfma_f32_32x32x16_bf16(pa1,PK(1),o[d0],0,0,0);
    o[d0]=__builtin_amdgcn_mfma_f32_32x32x16_bf16(pa2,PK(2),o[d0],0,0,0);
    o[d0]=__builtin_amdgcn_mfma_f32_32x32x16_bf16(pa3,PK(3),o[d0],0,0,0);
    #undef PK
  }
}

#ifndef ATTN_STORE16
#define ATTN_STORE16(p,v) (*(u32x4*)(p)=(v))
#endif
template<int THRL> __device__ __forceinline__ void attn_unit(int qb,const bf16*Qh,const bf16*__restrict__ Kh,const bf16*__restrict__ Vh,bf16*Oh,char*shm,const int wave_id){
  const int tid=fresh_tid(wave_id),lane=tid&63,r32=lane&31,hi=lane>>5; const int wid=__builtin_amdgcn_readfirstlane(tid>>6);
  const int q0=qb*QB;
  const bf16*Qw=Qh+(long)(q0+wid*QBLK)*DM;
  const unsigned lds0=(unsigned)(uintptr_t)shm;
  float*wsf=(float*)(shm+LDS_WS)+wid*64;
  const bf16*ksrc=Kh+(long)lane*DM+wid*8;
  const bf16*vsrc=Vh+(long)(16*(wid&3)+(lane>>2))*DM+(wid>>2)*32+(lane&3)*8;
  const unsigned kdst=lds0+LDS_K+wid*1024, vdst=lds0+LDS_V+wid*1024;
  #define DMA_K(t,slot) glds16(ksrc+(long)(t)*KVBLK*DM,(unsigned)__builtin_amdgcn_readfirstlane(kdst+(slot)))
  #define DMA_V(t,slot) do{ glds16(vsrc+(long)(t)*KVBLK*DM,(unsigned)__builtin_amdgcn_readfirstlane(vdst+2*(slot))); glds16(vsrc+64+(long)(t)*KVBLK*DM,(unsigned)__builtin_amdgcn_readfirstlane(vdst+2*(slot)+SLOTB)); }while(0)
  const int vb0=(int)(lds0+LDS_V)+((lane>>4)&1)*32+(lane&3)*8+(4*hi+((lane&15)>>2))*64;
  const char*Kbase=shm+LDS_K; bf16x8 kf[8];
  const lds_cptr shm3=(lds_cptr)shm; const lds_cptr kp0=shm3+LDS_K+hi*1024+r32*16; const lds_cptr vp0=shm3+LDS_V+((lane>>4)&1)*32+(lane&3)*8+(4*hi+((lane&15)>>2))*64;
  const int NT=(q0+QB)/KVBLK;
  DMA_K(0,0);DMA_V(0,0);DMA_K(1,SLOTB);
  bf16x8 qr[4];
  #pragma unroll
  for(int d0=0;d0<4;++d0)qr[d0]=*reinterpret_cast<const bf16x8*>(&Qw[(long)r32*DM+d0*16+hi*8]);
  const lds_cptr qpk=(lds_cptr)shm+LDS_QS+wid*4608+r32*144+hi*16;
  #pragma unroll
  for(int d0=0;d0<4;++d0)*(__attribute__((address_space(3))) bf16x8*)(qpk+d0*32)=qr[d0];
  #define QF(d) (*(const __attribute__((address_space(3))) bf16x8*)(qpk+(d)*32))
  float mhat=0.f,l_reg=0.f;f32x16 o[4];o[0]=f32x16{};o[1]=f32x16{};o[2]=f32x16{};o[3]=f32x16{};const f32x16 zacc=f32x16{};
  #define CMASK(P0,P1,t) do{int jb_=(t)-(NT-4); if(jb_>=0)cmask(P0,P1,jb_,wid);}while(0)
  bool resc=false;
  #define START(P0,P1) do{ const float rm=rowmax(P0,P1); resc=false; \
    { const float dl=rm; mhat=fadd_s(mhat,dl); \
      _Pragma("unroll") for(int r=0;r<16;++r){P0[r]=fsub_s(P0[r],dl);P1[r]=fsub_s(P1[r],dl);} \
      } \
    _Pragma("unroll") for(int r=0;r<16;++r)P0[r]=__builtin_amdgcn_exp2f(P0[r]); }while(0)
  #define RESC() do{ if(resc){ asm volatile("s_waitcnt lgkmcnt(0)":::"memory"); \
      _Pragma("unroll") for(int d_=0;d_<4;++d_) _Pragma("unroll") for(int r=0;r<16;++r)o[d_][r]*=wsf[crow(r,hi)]; } }while(0)
  f32x16 pA0,pA1,pB0,pB1;
  int sl_prev=0,sl_cur=0,sl_next=SLOTB;
  #define ROT() do{sl_prev=sl_cur;sl_cur=sl_next;sl_next=(sl_next==(NSLOT-1)*SLOTB)?0:sl_next+SLOTB;}while(0)
  if(wid>=4)__builtin_amdgcn_s_setprio(1);
  DMA_K(2,2*SLOTB);
  WAIT_BAR(3);
  qkt(pA0,pA1,Kbase,qr,r32,hi);asm volatile("s_nop 15\n\ts_nop 7":"+v"(pA0),"+v"(pA1));CMASK(pA0,pA1,0);
  START(pA0,pA1);
  _Pragma("unroll") for(int r=0;r<16;++r)pA1[r]=__builtin_amdgcn_exp2f(pA1[r]);
  WAIT_BAR(0);
  DMA_K(3,0);DMA_V(1,SLOTB);
  ROT();
  kload8(kf,kp0+sl_cur);
  WAIT_BAR(3);
  s16x4 vlo[8],vhi[8]; u32x4 pw0,pw1,pw2,pw3;
  #define PKW(P,B) cvtpk_s(P[B],P[B+1])
  #define PAF(k) __builtin_bit_cast(bf16x8,pw##k)
  #define VFR(i) (bf16x8){vlo[i][0],vlo[i][1],vlo[i][2],vlo[i][3],vhi[i][0],vhi[i][1],vhi[i][2],vhi[i][3]}
  #define PIN(x) asm volatile("":"+v"(x))
  #define MX3(a,b,c) __builtin_fmaxf(__builtin_fmaxf((a),(b)),(c))
  #define GAPA(MF,A0,A1,A2,A3,W0,W1,PW) do{ MF; sacc+=A0; sacc+=A1; sacc+=A2; sacc+=A3; PIN(sacc); W0; W1; PIN(PW); SBAR(); }while(0)
  #define EX(v) __builtin_amdgcn_exp2f(v)
  #define GAPB(MF,X,B) do{ MF; X[B]=EX(X[B]); X[B+1]=EX(X[B+1]); X[B+2]=EX(X[B+2]); X[B+3]=EX(X[B+3]); PIN(X); SBAR(); }while(0)
  #define VRD(i) do{ vlo[i]=vtr(vp_+(((i)>>2)*4096+((i)&3)*1024)); vhi[i]=vtr(vp_+(((i)>>2)*4096+((i)&3)*1024+512)); }while(0)
  #define VRD2(i) do{ vlo[i]=vtr(vp_+(8192+((i)>>2)*4096+((i)&3)*1024)); vhi[i]=vtr(vp_+(8192+((i)>>2)*4096+((i)&3)*1024+512)); }while(0)
  #define GAPB2(MF,X,B,RD) do{ MF; RD; X[B]=EX(X[B]); X[B+1]=EX(X[B+1]); PIN(X); SBAR(); }while(0)
  #define KRD(G,j) do{ if(G){ kload2(kf,kp0+sl_next,j); SBAR(); } }while(0)
  #define STEP(C0,C1,P0,P1,t,GK,GV,GL) do{ SBAR(); \
    const lds_cptr vp_=vp0+2*sl_prev; \
    VRD(0); SBAR(); float sacc=(P0[0]+P0[1]); \
    GAPA(C0=__builtin_amdgcn_mfma_f32_32x32x16_bf16(kf[0],QF(0),zacc,0,0,0), P0[2],P0[3],P0[4],P0[5],     pw0[0]=PKW(P0,0), pw0[1]=PKW(P0,2), pw0); \
    VRD(4); SBAR(); GAPA(C1=__builtin_amdgcn_mfma_f32_32x32x16_bf16(kf[1],QF(0),zacc,0,0,0), P0[6],P0[7],P0[8],P0[9],     pw0[2]=PKW(P0,4), pw0[3]=PKW(P0,6), pw0); \
    VRD(1); SBAR(); GAPA(C0=__builtin_amdgcn_mfma_f32_32x32x16_bf16(kf[2],QF(1),C0,0,0,0),   P0[10],P0[11],P0[12],P0[13], pw1[0]=PKW(P0,8), pw1[1]=PKW(P0,10), pw1); \
    VRD(5); SBAR(); GAPA(C1=__builtin_amdgcn_mfma_f32_32x32x16_bf16(kf[3],QF(1),C1,0,0,0),   P0[14],P0[15],P1[0],P1[1],   pw1[2]=PKW(P0,12),pw1[3]=PKW(P0,14), pw1); \
    VRD(2); SBAR(); GAPA(C0=__builtin_amdgcn_mfma_f32_32x32x16_bf16(kf[4],QF(2),C0,0,0,0),   P1[2],P1[3],P1[4],P1[5],     pw2[0]=PKW(P1,0), pw2[1]=PKW(P1,2), pw2); \
    VRD(6); SBAR(); GAPA(C1=__builtin_amdgcn_mfma_f32_32x32x16_bf16(kf[5],QF(2),C1,0,0,0),   P1[6],P1[7],P1[8],P1[9],     pw2[2]=PKW(P1,4), pw2[3]=PKW(P1,6), pw2); \
    VRD(3); SBAR(); GAPA(C0=__builtin_amdgcn_mfma_f32_32x32x16_bf16(kf[6],QF(3),C0,0,0,0),   P1[10],P1[11],P1[12],P1[13], pw3[0]=PKW(P1,8), pw3[1]=PKW(P1,10), pw3); \
    VRD(7); SBAR(); GAPA(C1=__builtin_amdgcn_mfma_f32_32x32x16_bf16(kf[7],QF(3),C1,0,0,0),   P1[14],P1[15],0.f,0.f,       pw3[2]=PKW(P1,12),pw3[3]=PKW(P1,14), pw3); \
    l_reg+=sacc; \
    if(GK){DMA_K((t)+3,sl_cur);} if(GV){DMA_V((t)+1,sl_next);} \
    _Pragma("unroll") for(int r=0;r<16;++r){C0[r]-=mhat;C1[r]-=mhat;} \
    CMASK(C0,C1,t); \
    { float a=MX3(C0[0],C0[1],C1[0]),b=MX3(C0[2],C0[3],C1[1]); a=MX3(a,C1[2],C1[3]); \
      _Pragma("unroll") for(int r=4;r<16;r+=4){a=MX3(a,C0[r],C0[r+1]);b=MX3(b,C0[r+2],C0[r+3]);a=MX3(a,C1[r],C1[r+1]);b=MX3(b,C1[r+2],C1[r+3]);} \
      float rm=__builtin_fmaxf(a,b); { auto rr=__builtin_amdgcn_permlane32_swap(__float_as_uint(rm),__float_as_uint(rm),false,false); rm=__builtin_fmaxf(__uint_as_float(rr[0]),__uint_as_float(rr[1])); } \
      resc=false; \
      if(__builtin_expect(__any(rm>(float)THRL),0)){ const float dl=__builtin_fmaxf(rm,0.f); mhat+=dl; \
        _Pragma("unroll") for(int r=0;r<16;++r){C0[r]-=dl;C1[r]-=dl;} \
        const float f=__builtin_amdgcn_exp2f(-dl); l_reg*=f; if(hi==0)wsf[r32]=f; resc=true; } } \
    SBAR(); \
    GAPB2(o[0]=__builtin_amdgcn_mfma_f32_32x32x16_bf16(PAF(0),VFR(0),o[0],0,0,0), C0,0, VRD2(0)); \
    GAPB2(o[1]=__builtin_amdgcn_mfma_f32_32x32x16_bf16(PAF(0),VFR(4),o[1],0,0,0), C0,2, VRD2(4)); \
    KRD(GL,0); GAPB2(o[0]=__builtin_amdgcn_mfma_f32_32x32x16_bf16(PAF(1),VFR(1),o[0],0,0,0), C0,4, VRD2(1)); \
    KRD(GL,1); GAPB2(o[1]=__builtin_amdgcn_mfma_f32_32x32x16_bf16(PAF(1),VFR(5),o[1],0,0,0), C0,6, VRD2(5)); \
    KRD(GL,2); GAPB2(o[0]=__builtin_amdgcn_mfma_f32_32x32x16_bf16(PAF(2),VFR(2),o[0],0,0,0), C0,8, VRD2(2)); \
    KRD(GL,3); GAPB2(o[1]=__builtin_amdgcn_mfma_f32_32x32x16_bf16(PAF(2),VFR(6),o[1],0,0,0), C0,10, VRD2(6)); \
    GAPB2(o[0]=__builtin_amdgcn_mfma_f32_32x32x16_bf16(PAF(3),VFR(3),o[0],0,0,0), C0,12, VRD2(3)); \
    GAPB2(o[1]=__builtin_amdgcn_mfma_f32_32x32x16_bf16(PAF(3),VFR(7),o[1],0,0,0), C0,14, VRD2(7)); \
    GAPB2(o[2]=__builtin_amdgcn_mfma_f32_32x32x16_bf16(PAF(0),VFR(0),o[2],0,0,0), C1,0, (void)0); \
    GAPB2(o[3]=__builtin_amdgcn_mfma_f32_32x32x16_bf16(PAF(0),VFR(4),o[3],0,0,0), C1,2, (void)0); \
    GAPB2(o[2]=__builtin_amdgcn_mfma_f32_32x32x16_bf16(PAF(1),VFR(1),o[2],0,0,0), C1,4, (void)0); \
    GAPB2(o[3]=__builtin_amdgcn_mfma_f32_32x32x16_bf16(PAF(1),VFR(5),o[3],0,0,0), C1,6, (void)0); \
    GAPB2(o[2]=__builtin_amdgcn_mfma_f32_32x32x16_bf16(PAF(2),VFR(2),o[2],0,0,0), C1,8, (void)0); \
    GAPB2(o[3]=__builtin_amdgcn_mfma_f32_32x32x16_bf16(PAF(2),VFR(6),o[3],0,0,0), C1,10, (void)0); \
    GAPB2(o[2]=__builtin_amdgcn_mfma_f32_32x32x16_bf16(PAF(3),VFR(3),o[2],0,0,0), C1,12, (void)0); \
    GAPB2(o[3]=__builtin_amdgcn_mfma_f32_32x32x16_bf16(PAF(3),VFR(7),o[3],0,0,0), C1,14, (void)0); \
    }while(0)
  int t=1;
  #undef CMASK
  #define CMASK(P0,P1,t) do{}while(0)
  for(;t+5<NT;t+=2){
    STEP(pB0,pB1,pA0,pA1,t,true,true,true);     WAIT_BAR(3); RESC(); ROT();
    STEP(pA0,pA1,pB0,pB1,t+1,true,true,true);   WAIT_BAR(3); RESC(); ROT();
  }
  #undef CMASK
  #define CMASK(P0,P1,t) do{int jb_=(t)-(NT-4); if(jb_>=0)cmask(P0,P1,jb_,wid);}while(0)
  #define ENDW(tt) do{ if((tt)+3<NT){WAIT_BAR(3);} else if((tt)+2<NT){WAIT_BAR(2);} else {WAIT_BAR(0);} }while(0)
  for(;t+1<NT;t+=2){
    STEP(pB0,pB1,pA0,pA1,t,(t+3<NT),(t+1<NT),(t+1<NT));       ENDW(t);   RESC(); ROT();
    STEP(pA0,pA1,pB0,pB1,t+1,(t+4<NT),(t+2<NT),(t+2<NT));     ENDW(t+1); RESC(); ROT();
  }
  STEP(pB0,pB1,pA0,pA1,NT-1,false,false,false); RESC();
  { float sacc=pB0[0]+pB0[1]; _Pragma("unroll") for(int r=2;r<16;++r)sacc+=pB0[r]; _Pragma("unroll") for(int r=0;r<16;++r)sacc+=pB1[r]; l_reg+=sacc;
    pw0=(u32x4){PKW(pB0,0),PKW(pB0,2),PKW(pB0,4),PKW(pB0,6)};pw1=(u32x4){PKW(pB0,8),PKW(pB0,10),PKW(pB0,12),PKW(pB0,14)};pw2=(u32x4){PKW(pB1,0),PKW(pB1,2),PKW(pB1,4),PKW(pB1,6)};pw3=(u32x4){PKW(pB1,8),PKW(pB1,10),PKW(pB1,12),PKW(pB1,14)};
    SBAR(); pv(o,vb0+2*sl_cur,PAF(0),PAF(1),PAF(2),PAF(3)); pv(o+2,vb0+2*sl_cur+8192,PAF(0),PAF(1),PAF(2),PAF(3)); }
  #undef PKW
  #undef PAF
  #undef VFR
  #undef PIN
  #undef MX3
  #undef GAPA
  #undef GAPB
  #undef GAPB2
  #undef QF
  #undef VRD2
  #undef EX
  #undef VRD
  #undef KRD
  #undef STEP
  #undef ENDW
  {auto rr=__builtin_amdgcn_permlane32_swap(__float_as_uint(l_reg),__float_as_uint(l_reg),false,false);l_reg=__uint_as_float(rr[0])+__uint_as_float(rr[1]);}
  if(hi==0)wsf[32+r32]=l_reg;asm volatile("s_waitcnt lgkmcnt(0)":::"memory");
  float rli[16];
  #pragma unroll
  for(int r=0;r<16;++r)rli[r]=__builtin_amdgcn_rcpf(wsf[32+crow(r,hi)]);
  bf16*Ow=Oh+(long)(q0+wid*QBLK)*DM;
  { bf16*stg=(bf16*)(shm+LDS_OST)+wid*2048;
    #pragma unroll
    for(int hf=0;hf<2;++hf){
      #pragma unroll
      for(int r=0;r<16;++r){const int orow=crow(r,hi);
        #pragma unroll
        for(int d0=0;d0<2;++d0)stg[orow*64+d0*32+r32]=__float2bfloat16(o[2*hf+d0][r]*rli[r]);}
      asm volatile("s_waitcnt lgkmcnt(0)":::"memory");
      #pragma unroll
      for(int i=0;i<4;++i){const int row=i*8+(lane>>3),ch=lane&7; const u32x4 v=*(const u32x4*)(stg+row*64+ch*8); ATTN_STORE16(Ow+(long)row*DM+hf*64+ch*8,v);}
      asm volatile("s_waitcnt lgkmcnt(0)":::"memory"); } }
  __builtin_amdgcn_s_setprio(0);
  asm volatile("s_waitcnt lgkmcnt(0)\n\ts_barrier":::"memory");
  #undef DMA_K
  #undef DMA_V
  #undef CMASK
  #undef START
  #undef RESC
  #undef ROT
}
constexpr int ATTN_LDS_BYTES=LDS_BYTES;
#undef SBAR
#undef WAIT_BAR
}
#define GAS __attribute__((address_space(1)))
#define LAS __attribute__((address_space(3)))
typedef unsigned short bf16;
typedef unsigned v4u __attribute__((ext_vector_type(4)));
typedef float f32x4 __attribute__((ext_vector_type(4)));
typedef short bf16x8 __attribute__((ext_vector_type(8)));
typedef GAS unsigned gu32;
typedef GAS unsigned long long gu64;
#define RLX_AGENT __ATOMIC_RELAXED, __HIP_MEMORY_SCOPE_AGENT
#define LDS_WAIT() asm volatile("s_waitcnt lgkmcnt(0)" ::: "memory")
#define VM_WAIT() asm volatile("s_waitcnt vmcnt(0)" ::: "memory")
__device__ __forceinline__ unsigned long long rt() { return __builtin_amdgcn_s_memrealtime(); }
__device__ __forceinline__ unsigned f2bf(float f) { unsigned u = __builtin_bit_cast(unsigned, f); return (u + 0x7fffu + ((u >> 16) & 1u)) >> 16; }
__device__ __forceinline__ unsigned pk2(float lo, float hi) { return f2bf(lo) | (f2bf(hi) << 16); }

#define XB_TMO      128
#define XB_XCNT(j)  (256  + 64 * (j))
#define XB_XSUB(j)  (1280 + 64 * (j))
#define XB_XGEN(j)  (2304 + 64 * (j))
#define XB_TOP      3328
#define XB_TOPGEN   3392
#define XCD_BAR_WORDS 3456
#define XB_SPIN_CAP (1u << 18)

__device__ __forceinline__ unsigned xb_ld(unsigned* p)              { return __hip_atomic_load(p, __ATOMIC_RELAXED, __HIP_MEMORY_SCOPE_AGENT); }
__device__ __forceinline__ unsigned xb_add(unsigned* p, unsigned v) { return __hip_atomic_fetch_add(p, v, __ATOMIC_RELAXED, __HIP_MEMORY_SCOPE_AGENT); }
__device__ __forceinline__ unsigned xb_xcc_id() { return (unsigned)__builtin_amdgcn_s_getreg((3 << 11) | 20) & 0xFu; }
#define XB_SPIN(cond, bar) do { unsigned _sp = 0; while (cond) { __builtin_amdgcn_s_sleep(1); \
    if ((++_sp & 255u) == 0u) { if (xb_ld(&(bar)[XB_TMO])) break; if (_sp > XB_SPIN_CAP) { atomicAdd(&(bar)[XB_TMO], 1u); break; } } } } while (0)

struct XcdBarrier {
    unsigned* bar; unsigned x;
    volatile LAS unsigned* st;
};

__device__ __forceinline__ XcdBarrier xcd_barrier_post(unsigned* bar, volatile LAS unsigned* st) {
    XcdBarrier b; b.bar = bar; b.x = xb_xcc_id(); b.st = st;
    if (threadIdx.x == 0) (void)xb_add(&bar[XB_XCNT(b.x)], 1u);
    return b;
}
__device__ __forceinline__ void xcd_barrier_complete(unsigned* bar, unsigned x, unsigned& nloc, unsigned& nx) {
    const unsigned G = gridDim.x * gridDim.y * gridDim.z;
    unsigned sum, cnt, mine, sp = 0u;
    for (;;) {
        sum = 0u; cnt = 0u; mine = 0u;
#pragma unroll
        for (unsigned j = 0; j < 16; ++j) { const unsigned c = xb_ld(&bar[XB_XCNT(j)]); sum += c; cnt += (c > 0u) ? 1u : 0u; mine = (j == x) ? c : mine; }
        if (sum == G) break;
        __builtin_amdgcn_s_sleep(1);
        if ((++sp & 255u) == 0u) { if (xb_ld(&bar[XB_TMO])) break; if (sp > XB_SPIN_CAP) { atomicAdd(&bar[XB_TMO], 1u); break; } }
    }
    nloc = mine > 0u ? mine : 1u; nx = cnt > 0u ? cnt : 1u;
}

__device__ __forceinline__ void xcd_barrier(const XcdBarrier& b) {
    asm volatile("s_waitcnt vmcnt(0)" ::: "memory");
    __syncthreads();
    if (threadIdx.x == 0) {
        unsigned* bar = b.bar;
        __builtin_amdgcn_s_waitcnt(0);
        unsigned nloc = b.st[0], nx = b.st[1];
        if (nloc == 0u) { xcd_barrier_complete(bar, b.x, nloc, nx); b.st[0] = nloc; b.st[1] = nx; }
        const unsigned old = xb_add(&bar[XB_XSUB(b.x)], 1u);
        const unsigned gen = old / nloc;
        if (old + 1u == (gen + 1u) * nloc) {
            __builtin_amdgcn_fence(__ATOMIC_RELEASE, "agent");
            asm volatile("s_waitcnt vmcnt(0)" ::: "memory");
            const unsigned og = xb_add(&bar[XB_TOP], 1u);
            const unsigned tg = og / nx;
            if (og + 1u == (tg + 1u) * nx) xb_add(&bar[XB_TOPGEN], 1u);
            else XB_SPIN(xb_ld(&bar[XB_TOPGEN]) == tg, bar);
            __builtin_amdgcn_fence(__ATOMIC_ACQUIRE, "agent");
            xb_add(&bar[XB_XGEN(b.x)], 1u);
            asm volatile("s_waitcnt vmcnt(0)" ::: "memory");
        } else {
            XB_SPIN(xb_ld(&bar[XB_XGEN(b.x)]) == gen, bar);
            __builtin_amdgcn_fence(__ATOMIC_ACQUIRE, "agent");
            asm volatile("s_waitcnt vmcnt(0)" ::: "memory");
        }
    }
    __syncthreads();
}
constexpr int S = 8192, D = 2048, NINP = 16384, NIN_SRC = 16392, FF = 5632, DEPTH = 4, NWAVES = 8;
constexpr float EPS = 1e-6f;
constexpr int NPH_LAYER = 13, NPH = 2 + DEPTH * NPH_LAYER;
#ifndef MK_ONE_LAUNCH
#define MK_ONE_LAUNCH 1
#endif
#ifndef CONV_WGS
#define CONV_WGS 64
#endif
constexpr size_t MiB = 1u << 20;
constexpr size_t WS_CTL = 0, CTL_ZERO_BYTES = 1 * MiB;
constexpr size_t WS_MOD = 1 * MiB;
constexpr size_t WS_ROPE = 2 * MiB;
constexpr size_t WS_WG = 3 * MiB;
constexpr size_t WS_GATES = 4 * MiB;
constexpr size_t WS_MG = 5 * MiB;
constexpr size_t WS_DEC = 5 * MiB + 768 * 1024;
constexpr size_t WS_MODP = 8 * MiB;
constexpr size_t WS_W = 16 * MiB, W_LAYER = 154 * MiB;
constexpr size_t WO_IN = 0, WO_A = 64 * MiB, WO_B = 72 * MiB, WO_OUT = 80 * MiB, WO_G = 88 * MiB, WO_U = 110 * MiB, WO_D = 132 * MiB;
constexpr size_t WS_H = 640 * MiB;
constexpr size_t WS_P8 = 672 * MiB, P8_STRIDE = 32 * MiB;
constexpr size_t WS_QKC = 928 * MiB, WS_HM = 960 * MiB, WS_O1 = 992 * MiB, WS_O2 = 1024 * MiB, WS_AM = 1056 * MiB, WS_AB = 1088 * MiB;
constexpr size_t WS_T = 1120 * MiB, WS_MRG = 1184 * MiB, WS_Y = 1216 * MiB, WS_G = 1280 * MiB, WS_AFF = 1368 * MiB, WS_KT = 1456 * MiB, WS_VT = 1472 * MiB, WS_PG = 1504 * MiB, WS_DG = 1508 * MiB, WS_END = 1512 * MiB;
constexpr int CW_BAR = 4096, CW_Q = 8192, CW_PF = 20480;
constexpr int LDS_BYTES = 147456, LDSCTL_OFF = LDS_BYTES - 512, MISC_OFF = LDSCTL_OFF + 320;

struct Frame { LAS unsigned char* lds; volatile LAS unsigned* MISC; gu32* ctl; int tid, lane, wave, vcu, G; };

template <int O> __device__ __forceinline__ float xor_lanes(float v) { static_assert(O >= 1 && O <= 16, "xor within 32 lanes"); return __uint_as_float((unsigned)__builtin_amdgcn_ds_swizzle((int)__float_as_uint(v), (O << 10) | 0x1f)); }
__device__ __forceinline__ float add_halves(float v) { auto rr = __builtin_amdgcn_permlane32_swap(__float_as_uint(v), __float_as_uint(v), false, false); return __uint_as_float(rr[0]) + __uint_as_float(rr[1]); }
__device__ __forceinline__ float wave_sum(float v) {
    v += xor_lanes<1>(v); v += xor_lanes<2>(v); v += xor_lanes<4>(v); v += xor_lanes<8>(v); v += xor_lanes<16>(v);
    return add_halves(v);
}
__device__ __forceinline__ float dot4(f32x4 a, f32x4 b) { return (a.x * b.x + a.y * b.y) + (a.z * b.z + a.w * b.w); }
__device__ __forceinline__ float bflo(unsigned u) { return __builtin_bit_cast(float, u << 16); }
__device__ __forceinline__ float bfhi(unsigned u) { return __builtin_bit_cast(float, u & 0xffff0000u); }
__device__ __forceinline__ void unpk8(const v4u w, float (&f)[8]) { f[0] = bflo(w.x); f[1] = bfhi(w.x); f[2] = bflo(w.y); f[3] = bfhi(w.y); f[4] = bflo(w.z); f[5] = bfhi(w.z); f[6] = bflo(w.w); f[7] = bfhi(w.w); }
__device__ __forceinline__ v4u pk8(const float (&f)[8]) { v4u w; w.x = pg8::cvt_pk_bf16(f[0], f[1]); w.y = pg8::cvt_pk_bf16(f[2], f[3]); w.z = pg8::cvt_pk_bf16(f[4], f[5]); w.w = pg8::cvt_pk_bf16(f[6], f[7]); return w; }
__device__ __forceinline__ float sigmf(float x) { return __builtin_amdgcn_rcpf(1.0f + __expf(-x)); }

struct Args { const float* in[25]; float* out; unsigned char* ws; double inv[8]; int ph_lo, ph_hi, mode, pad; };

constexpr int WI_IN = (D / 64) * (NINP / 64), WI_SQ = (D / 64) * (D / 64), WI_FF = (D / 64) * (FF / 64), WI_DN = (FF / 64) * (D / 64), WI_LAYER = WI_IN + 3 * WI_SQ + 2 * WI_FF + WI_DN;
__device__ __forceinline__ void adaln_item(const float* c, const float* wada, unsigned char* ws, int l, int rem, int lane) {
    const int jg = rem >> 5, kp = rem & 31, k0 = 64 * kp; float* modp = (float*)(ws + WS_MODP);
    const float cv = c[k0 + lane]; const float ca = cv * sigmf(cv);
    const float* wp = wada + ((size_t)l * D + k0) * (6 * D) + 256 * jg + 4 * lane;
    f32x4 acc = (f32x4){0.f, 0.f, 0.f, 0.f};
#pragma unroll 16
    for (int kk = 0; kk < 64; ++kk) { const f32x4 w = __builtin_nontemporal_load((const f32x4*)(wp + (size_t)kk * (6 * D))); const float a = __uint_as_float((unsigned)__builtin_amdgcn_readlane((int)__float_as_uint(ca), kk)); acc += w * a; }
    *(f32x4*)(modp + ((size_t)kp * DEPTH + l) * (6 * D) + 256 * jg + 4 * lane) = acc;
}
struct WItem { const float* src; bf16* dst; int ldt; int rope; };
__device__ __forceinline__ int witem_desc(const float* w_in, const float* w_a, const float* w_b, const float* w_out, const float* w_gate, const float* w_up, const float* w_down,
                                          unsigned char* ws, int l, int r, int lane, WItem& d) {
    unsigned char* wl = ws + WS_W + (size_t)l * W_LAYER; const float* W; bf16* WT; int K, ldw, N, ldt, koff = 0, map = 0;
    if (r < WI_IN) { W = w_in + (size_t)l * D * NIN_SRC; K = D; ldw = NIN_SRC; N = NINP; WT = (bf16*)(wl + WO_IN); ldt = D; map = 1; }
    else if ((r -= WI_IN) < WI_SQ) { W = w_a + (size_t)l * D * D; K = D; ldw = D; N = D; WT = (bf16*)(wl + WO_A); ldt = 2 * D; koff = D; }
    else if ((r -= WI_SQ) < WI_SQ) { W = w_b + (size_t)l * D * D; K = D; ldw = D; N = D; WT = (bf16*)(wl + WO_A); ldt = 2 * D; }
    else if ((r -= WI_SQ) < WI_SQ) { W = w_out + (size_t)l * D * D; K = D; ldw = D; N = D; WT = (bf16*)(wl + WO_OUT); ldt = D; }
    else if ((r -= WI_SQ) < WI_FF) { W = w_gate + (size_t)l * D * FF; K = D; ldw = FF; N = FF; WT = (bf16*)(wl + WO_G); ldt = D; }
    else if ((r -= WI_FF) < WI_FF) { W = w_up + (size_t)l * D * FF; K = D; ldw = FF; N = FF; WT = (bf16*)(wl + WO_U); ldt = D; }
    else { r -= WI_FF; W = w_down + (size_t)l * FF * D; K = FF; ldw = D; N = D; WT = (bf16*)(wl + WO_D); ldt = FF; }
    (void)K;
    const int nblk = N / 64, kb = r / nblk, nb = r % nblk, k0 = 64 * kb, n0 = 64 * nb;
    const int s0 = (map == 1 && n0 >= 6144) ? n0 + 8 : n0;
    d.rope = (map == 1 && n0 >= 6144 && n0 < 10240) ? 1 : 0;
    d.src = W + (size_t)(k0 + (lane >> 4)) * ldw + s0 + 4 * (lane & 15); d.dst = WT + (size_t)n0 * ldt + koff + k0; d.ldt = ldt;
    return ldw;
}
#define WITEM_ISSUE(d, ldw, v) do { _Pragma("unroll") for (int i_ = 0; i_ < 16; ++i_) v[i_] = __builtin_nontemporal_load((const f32x4*)((d).src + (size_t)(4 * i_) * (ldw))); } while (0)
__device__ __forceinline__ void witem_finish(const WItem& d, const f32x4 (&v)[16], LAS float* scr, int lane) {
    const int r4 = lane >> 4, cq = lane & 15;
#pragma unroll
    for (int i = 0; i < 16; ++i) { LAS float* p = scr + (4 * i + r4) * 65 + 4 * cq; p[0] = v[i].x; p[1] = v[i].y; p[2] = v[i].z; p[3] = v[i].w; }
    LDS_WAIT(); asm volatile("" ::: "memory");
    const int c = lane & 7;
#pragma unroll
    for (int j = 0; j < 8; ++j) { const int n = (lane >> 3) + 8 * j; const int pn = (d.rope && n < 16) ? (n >> 1) + 8 * (n & 1) : n; const LAS float* s = scr + (8 * c) * 65 + pn;
        v4u o; o.x = pg8::cvt_pk_bf16(s[0 * 65], s[1 * 65]); o.y = pg8::cvt_pk_bf16(s[2 * 65], s[3 * 65]); o.z = pg8::cvt_pk_bf16(s[4 * 65], s[5 * 65]); o.w = pg8::cvt_pk_bf16(s[6 * 65], s[7 * 65]);
        *(GAS v4u*)(d.dst + (size_t)n * d.ldt + 8 * c) = o; }
    LDS_WAIT(); asm volatile("" ::: "memory");
}
__device__ __forceinline__ void wconv_item(const float* w_in, const float* w_a, const float* w_b, const float* w_out, const float* w_gate, const float* w_up, const float* w_down,
                                           unsigned char* ws, int l, int r, LAS float* scr, int lane) {
    WItem d; const int ldw = witem_desc(w_in, w_a, w_b, w_out, w_gate, w_up, w_down, ws, l, r, lane, d); f32x4 v[16]; WITEM_ISSUE(d, ldw, v); witem_finish(d, v, scr, lane);
}
struct Args; typedef const __attribute__((address_space(4))) Args* CArgs0;
__device__ __forceinline__ void p0_prologue(Frame& F, const __attribute__((address_space(4))) Args* Ap) {
    const __attribute__((address_space(4))) Args& A = *Ap;
    LAS float* scr = (LAS float*)(F.lds + F.wave * 16640);
    const int gw = F.vcu * NWAVES + F.wave, NGW = F.G * NWAVES;
    unsigned char* ws = A.ws;
    for (int it = gw; it < WI_IN; it += NGW) wconv_item(A.in[9], A.in[17], A.in[18], A.in[19], A.in[20], A.in[21], A.in[24], ws, 0, it, scr, F.lane);
    for (int it = gw; it < 1536; it += NGW) adaln_item(A.in[1], A.in[3], ws, 0, it, F.lane);
    { const int gt = (F.vcu * NWAVES + F.wave) * 64 + F.lane, NGT = NGW * 64; const int* pos = (const int*)A.in[2];
      float* rc = (float*)(ws + WS_ROPE); float* rs = rc + S * 8;
      for (int i = gt; i < S * 8; i += NGT) { const int row = i >> 3, j = i & 7; const double ang = (double)pos[row] * A.inv[j];
        const double rev = ang * 0.15915494309189535; const double fr = rev - __builtin_floor(rev); const float a = (float)(fr * 6.283185307179586);
        rc[i] = __cosf(a); rs[i] = __sinf(a); }
      float* wg = (float*)(ws + WS_WG); const float* win = A.in[9];
      for (int i = gt; i < DEPTH * 8 * D; i += NGT) { const int l = i / (8 * D), g = (i / D) & 7, k = i % D; wg[i] = win[((size_t)l * D + k) * NIN_SRC + 6144 + g]; } }
}
__device__ __forceinline__ void p0b_mod_reduce(Frame& F, const __attribute__((address_space(4))) Args* Ap, int l) {
    const __attribute__((address_space(4))) Args& A = *Ap;
    const int gt = (F.vcu * NWAVES + F.wave) * 64 + F.lane, NGT = F.G * NWAVES * 64;
    const float* modp = (const float*)(A.ws + WS_MODP); float* mod = (float*)(A.ws + WS_MOD); const float* bada = A.in[4];
    for (int i = l * 6 * D + gt; i < (l + 1) * 6 * D; i += NGT) { float s = bada[i];
#pragma unroll 8
        for (int kp = 0; kp < 32; ++kp) s += modp[(size_t)kp * (DEPTH * 6 * D) + i];
        mod[i] = s; }
}

template <bool RES, bool NORM, bool GATES>
__device__ __forceinline__ void row_phase(Frame& F, const float* xin, float* xout, const bf16* Y, const float* gt, const float* gpost,
                                          const float* gpre, const float* sc, const float* sh, bf16* hout, const float* wg, const float* bi, const float* bfg, float* gout) {
    LAS f32x4* VA = (LAS f32x4*)F.lds; LAS f32x4* VB = VA + 512; LAS f32x4* VC = VA + 1024; LAS float* wl = (LAS float*)(F.lds + 24576);
    { const int i = F.tid;
      if (RES) VA[i] = ((const f32x4*)gt)[i] * ((const f32x4*)gpost)[i];
      if (NORM) { VB[i] = ((const f32x4*)gpre)[i] * (((const f32x4*)sc)[i] + 1.0f); VC[i] = ((const f32x4*)sh)[i]; }
      if (GATES) { for (int k = F.tid; k < 8 * D / 4; k += NWAVES * 64) ((LAS f32x4*)wl)[k] = ((const f32x4*)wg)[k]; }
      __syncthreads(); }
    const int gw = F.vcu * NWAVES + F.wave, NGW = F.G * NWAVES;
    f32x4 x0[8], y0[8], x1[8], y1[8];
#define RP_LOAD(X, Yv, row) do { const f32x4* xr_ = (const f32x4*)(xin + (size_t)(row) * D) + F.lane; const unsigned long long* yr_ = (const unsigned long long*)(Y + (size_t)(row) * D) + F.lane; \
        _Pragma("unroll") for (int j = 0; j < 8; ++j) { X[j] = xr_[64 * j]; if (RES) { const unsigned long long yb_ = yr_[64 * j]; Yv[j] = (f32x4){bflo((unsigned)yb_), bfhi((unsigned)yb_), bflo((unsigned)(yb_ >> 32)), bfhi((unsigned)(yb_ >> 32))}; } } } while (0)
#define RP_PROC(X, Yv, row) do { \
        if (RES) { float ss = 0.f; _Pragma("unroll") for (int j = 0; j < 8; ++j) ss += dot4(Yv[j], Yv[j]); \
            const float rstd = 1.0f / sqrtf(wave_sum(ss) * (1.0f / D) + EPS); f32x4* xo = (f32x4*)(xout + (size_t)(row) * D) + F.lane; \
            _Pragma("unroll") for (int j = 0; j < 8; ++j) { X[j] = X[j] + (Yv[j] * rstd) * VA[F.lane + 64 * j]; xo[64 * j] = X[j]; __builtin_amdgcn_sched_barrier(0); } } \
        if (NORM) { float ss = 0.f; _Pragma("unroll") for (int j = 0; j < 8; ++j) ss += dot4(X[j], X[j]); \
            const float rstd = 1.0f / sqrtf(wave_sum(ss) * (1.0f / D) + EPS); GAS unsigned long long* o8 = (GAS unsigned long long*)(hout + (size_t)(row) * D) + F.lane; \
            _Pragma("unroll") for (int j = 0; j < 8; ++j) { const f32x4 h = (X[j] * rstd) * VB[F.lane + 64 * j] + VC[F.lane + 64 * j]; X[j] = h; \
                o8[64 * j] = (unsigned long long)pg8::cvt_pk_bf16(h.x, h.y) | ((unsigned long long)pg8::cvt_pk_bf16(h.z, h.w) << 32); __builtin_amdgcn_sched_barrier(0); } \
            if (GATES) { float d[8]; \
                _Pragma("unroll") for (int g = 0; g < 8; ++g) { float a = 0.f; \
                    _Pragma("unroll") for (int j = 0; j < 8; ++j) a += dot4(X[j], ((const LAS f32x4*)(wl + g * D))[F.lane + 64 * j]); \
                    d[g] = wave_sum(a); __builtin_amdgcn_sched_barrier(0); } \
                if (F.lane == 0) { *(f32x4*)(gout + (size_t)(row) * 8) = (f32x4){d[0] + bi[0], d[1] + bi[1], d[2] + bi[2], d[3] + bi[3]}; \
                                   *(f32x4*)(gout + (size_t)(row) * 8 + 4) = (f32x4){d[4] + bfg[0], d[5] + bfg[1], d[6] + bfg[2], d[7] + bfg[3]}; } } } } while (0)
    int row = gw;
    if (row < S) RP_LOAD(x0, y0, row);
    for (; row < S; row += 2 * NGW) {
        const int r1 = row + NGW, r2 = row + 2 * NGW;
        if (r1 < S) RP_LOAD(x1, y1, r1);
        RP_PROC(x0, y0, row);
        if (r2 < S) RP_LOAD(x0, y0, r2);
        if (r1 < S) RP_PROC(x1, y1, r1);
    }
#undef RP_LOAD
#undef RP_PROC
    __syncthreads();
}

__device__ __forceinline__ void tile_put(LAS unsigned char* T, int s, int cc, v4u v) { *(LAS v4u*)(T + s * 256 + ((cc ^ ((s >> 3) & 7)) << 4)) = v; }
__device__ __forceinline__ void tile_transpose_store(const LAS unsigned char* T, bf16* dst  , int lane) {
    const int drow = lane >> 3, c8 = lane & 7;
#pragma unroll 4
    for (int j = 0; j < 16; ++j) { const LAS unsigned char* p = T + (8 * c8) * 256 + ((j ^ c8) << 4) + 2 * drow; unsigned h[8];
#pragma unroll
        for (int q = 0; q < 8; ++q) h[q] = *(const LAS unsigned short*)(p + q * 256);
        *(v4u*)(dst + (size_t)(8 * j + drow) * 64 + 8 * c8) = (v4u){h[0] | (h[1] << 16), h[2] | (h[3] << 16), h[4] | (h[5] << 16), h[6] | (h[7] << 16)}; }
}
__device__ __forceinline__ void prep_conv_item(int it, int lane, LAS unsigned char* T, const bf16* QKM, bf16* QKC, bf16* KT, const float* cw, const float* cb) {
    const int c = it >> 4, cg = it & 15, rg = lane >> 4, cc = lane & 15, c0 = cg * 128 + 8 * cc, r0 = 64 * c + 16 * rg;
    float w[4][8], b[8];
#pragma unroll
    for (int k = 0; k < 4; ++k) { const f32x4 a = *(const f32x4*)(cw + k * 2048 + c0), bb = *(const f32x4*)(cw + k * 2048 + c0 + 4); w[k][0] = a.x; w[k][1] = a.y; w[k][2] = a.z; w[k][3] = a.w; w[k][4] = bb.x; w[k][5] = bb.y; w[k][6] = bb.z; w[k][7] = bb.w; }
    { const f32x4 a = *(const f32x4*)(cb + c0), bb = *(const f32x4*)(cb + c0 + 4); b[0] = a.x; b[1] = a.y; b[2] = a.z; b[3] = a.w; b[4] = bb.x; b[5] = bb.y; b[6] = bb.z; b[7] = bb.w; }
    float xm3[8], xm2[8], xm1[8], x0[8], o[8];
    const v4u z = (v4u){0u, 0u, 0u, 0u};
    unpk8(r0 >= 3 ? *(const v4u*)(QKM + (size_t)(r0 - 3) * 2048 + c0) : z, xm3);
    unpk8(r0 >= 2 ? *(const v4u*)(QKM + (size_t)(r0 - 2) * 2048 + c0) : z, xm2);
    unpk8(r0 >= 1 ? *(const v4u*)(QKM + (size_t)(r0 - 1) * 2048 + c0) : z, xm1);
    const float qs = (c0 < 1024) ? 0.0625f : 1.0f;
#pragma unroll 4
    for (int r = 0; r < 16; ++r) {
        unpk8(*(const v4u*)(QKM + (size_t)(r0 + r) * 2048 + c0), x0);
#pragma unroll
        for (int e = 0; e < 8; ++e) { const float y = b[e] + w[0][e] * xm3[e] + w[1][e] * xm2[e] + w[2][e] * xm1[e] + w[3][e] * x0[e]; o[e] = y * sigmf(y) * qs; xm3[e] = xm2[e]; xm2[e] = xm1[e]; xm1[e] = x0[e]; }
        const v4u ov = pk8(o);
        *(v4u*)(QKC + (size_t)(r0 + r) * 2048 + c0) = ov;
        if (cg >= 8) tile_put(T, 16 * rg + r, cc, ov);
    }
    if (cg >= 8) { LDS_WAIT(); asm volatile("" ::: "memory");
        const int kc = cg * 128 - 1024, hd = kc >> 8, d0 = kc & 255;
        tile_transpose_store(T, KT + (((size_t)c * 4 + hd) * 256 + d0) * 64, lane);
        LDS_WAIT(); asm volatile("" ::: "memory"); }
}
__device__ __forceinline__ void prep_vt_item(int it, int lane, LAS unsigned char* T, const bf16* VM, bf16* VT) {
    const int c = it >> 4, cg = it & 15, rg = lane >> 4, cc = lane & 15; v4u in[16];
#pragma unroll
    for (int r = 0; r < 16; ++r) in[r] = *(const v4u*)(VM + (size_t)(64 * c + 16 * rg + r) * 2048 + 128 * cg + 8 * cc);
#pragma unroll
    for (int r = 0; r < 16; ++r) tile_put(T, 16 * rg + r, cc, in[r]);
    LDS_WAIT(); asm volatile("" ::: "memory");
    const int hd = cg >> 2, v0 = (cg & 3) * 128;
    tile_transpose_store(T, VT + (((size_t)c * 4 + hd) * 512 + v0) * 64, lane);
    LDS_WAIT(); asm volatile("" ::: "memory");
}
__device__ __forceinline__ void prep_phase(Frame& F, const bf16* QKM, const bf16* VM, bf16* QKC, bf16* KT, bf16* VT, const float* cw, const float* cb) {
    if (blockIdx.x < 4) return;
    const int gw = ((int)blockIdx.x - 4) * NWAVES + F.wave, NGW = (F.G - 4) * NWAVES;
    LAS unsigned char* Tw = F.lds + F.wave * 16384;
    for (int it = gw; it < 4096; it += NGW) { if (it < 2048) prep_conv_item(it, F.lane, Tw, QKM, QKC, KT, cw, cb); else prep_vt_item(it - 2048, F.lane, Tw, VM, VT); }
}
__device__ __forceinline__ float logsig(float f) { return fminf(f, 0.f) - log1pf(__expf(-fabsf(f))); }
__device__ __forceinline__ void gate_scan(Frame& F, int hd, const float* GATES, float* MG, float* DEC) {
    LAS float* li = (LAS float*)F.lds; LAS float* lf = li + 128 * 65; LAS float* cm = lf + 128 * 65; LAS float* sb = cm + 128 * 65;
    for (int t = F.tid; t < S; t += NWAVES * 64) { const float* gp = GATES + (size_t)t * 8; const int k = (t >> 6) * 65 + (t & 63); li[k] = gp[hd]; lf[k] = logsig(gp[4 + hd]); }
    __syncthreads();
    const int c = F.tid;
    if (c < 128) { float b = 0.f, amax = -INFINITY;
        for (int s = 0; s < 64; ++s) { const int k = c * 65 + s; b += lf[k]; const float a = li[k] - b; amax = fmaxf(amax, a); lf[k] = b; li[k] = a; cm[k] = amax; }
        sb[c] = b; sb[128 + c] = b + amax; }
    __syncthreads();
    if (F.tid == 0) { float m = 0.f;
#pragma unroll 4
        for (int k4 = 0; k4 < 32; ++k4) { const f32x4 bl = *(const LAS f32x4*)(sb + 4 * k4), mx = *(const LAS f32x4*)(sb + 128 + 4 * k4); f32x4 mo;
            mo.x = m; m = fmaxf(bl.x + m, mx.x); mo.y = m; m = fmaxf(bl.y + m, mx.y); mo.z = m; m = fmaxf(bl.z + m, mx.z); mo.w = m; m = fmaxf(bl.w + m, mx.w);
            *(LAS f32x4*)(sb + 256 + 4 * k4) = mo; }
        sb[256 + 128] = m; }
    __syncthreads();
    float* mg = MG + (size_t)hd * 5 * S;
    for (int t = F.tid; t < S; t += NWAVES * 64) { const int cc = t >> 6, k = cc * 65 + (t & 63); const float mprev = sb[256 + cc], mnew = sb[256 + cc + 1], bL = sb[cc];
        const float b = lf[k], a = li[k], mt = b + fmaxf(mprev, cm[k]);
        mg[t] = b - mt; mg[S + t] = a; mg[2 * S + t] = __expf(b + mprev - mt); mg[3 * S + t] = __expf(-mt); mg[4 * S + t] = __expf(bL + a - mnew); }
    if (c < 128) DEC[hd * 128 + c] = __expf(sb[c] + sb[256 + c] - sb[256 + c + 1]);
    __syncthreads();
}

typedef float f32x16 __attribute__((ext_vector_type(16)));
constexpr int ML_QS = 0, ML_KS = 33792, ML_KT = 67584, ML_VT = 104448, ML_CB = 109056, ML_PS = 125952, ML_SC = 135168  , ML_DENP = 137856, ML_DQ = 138880, ML_NV = 139136, ML_VW = 140160, ML_END = 144768;
static_assert(ML_END <= LDSCTL_OFF, "mLSTM LDS map");
#define ML_SGB(mask, n) __builtin_amdgcn_sched_group_barrier(mask, n, 0)
#define ML_CHAIN_SCHED(N) do { ML_SGB(0x100, 8); _Pragma("unroll") for (int i_ = 0; i_ < (N) - 4; ++i_) { ML_SGB(0x008, 1); ML_SGB(0x100, 2); } ML_SGB(0x008, 4); } while (0)
template <int PV>
__device__ __forceinline__ void mlstm_p_producer(Frame& F, int hd, int par, const bf16* QKC, const float* MG, bf16* PG, float* DG, gu32* flag) {
    constexpr int PP_D = 3, PSC = ML_CB, PSCN = 128;
    LAS unsigned char* L = F.lds; const int tid = F.tid, lane = F.lane, wave = F.wave, r32 = lane & 31, hi = lane >> 5;
    const float* mgh = MG + (size_t)hd * 5 * S;
    const unsigned glo = (unsigned)(((tid >> 5) * 1024 + 8 * (tid & 31)) * 2);
    LAS unsigned char* const lst = L + ((tid >> 5) & 1) * ML_KS + (tid >> 6) * 528 + (tid & 31) * 16;
#define PP_LD(c, NI) do { const char* ub_ = (const char*)(QKC + (size_t)(64 * (c)) * 2048 + 256 * hd); \
        _Pragma("unroll") for (int i = 0; i < NI; ++i) rs[i] = *(const v4u*)(ub_ + (size_t)i * 24576 + glo); } while (0)
#define PP_ST(NI) do { _Pragma("unroll") for (int i = 0; i < NI; ++i) *(LAS v4u*)(lst + i * 3168) = rs[i]; } while (0)
    if (wave < 4) {
        v4u rs[11]; float rsc0 = 0.f;
        const float* const scp0 = mgh + (size_t)((tid >> 6) & 1) * S + (tid & 63);
        const int si = wave >> 1, ti = wave & 1, t = 32 * ti + r32;
        PP_LD(par, 11); rsc0 = scp0[64 * par];
        for (int k = 0; k < 64; ++k) { const int c = par + 2 * k;
            if (!(PV & 16)) PP_ST(11);
            if (tid < 128) ((LAS float*)(L + PSC))[(k & 1) * PSCN + tid] = rsc0;
            if (!(PV & 8) && k + 1 < 64) { PP_LD(c + 2, 11); rsc0 = scp0[64 * (c + 2)]; }
            __syncthreads();
            if (tid == 0 && k > PP_D) __hip_atomic_store(flag, (unsigned)(k - PP_D), RLX_AGENT);
            const LAS float* SC = (const LAS float*)(L + PSC) + (k & 1) * PSCN;
            f32x16 acc;
#pragma unroll
            for (int r = 0; r < 16; ++r) acc[r] = 0.f;
            const LAS unsigned char* ka = L + ML_KS + (32 * si + r32) * 528 + hi * 16; const LAS unsigned char* qb = L + ML_QS + (32 * ti + r32) * 528 + hi * 16;
            if (!(PV & 2)) {
#pragma unroll
                for (int kk = 0; kk < 16; ++kk) acc = __builtin_amdgcn_mfma_f32_32x32x16_bf16(*(const LAS bf16x8*)(ka + kk * 32), *(const LAS bf16x8*)(qb + kk * 32), acc, 0, 0, 0);
                ML_CHAIN_SCHED(16); }
            const float rt_ = SC[t]; float dsum = 0.f;
            if (!(PV & 64)) {
#pragma unroll
            for (int g = 0; g < 4; ++g) { const int s0 = 32 * si + 8 * g + 4 * hi; float p[4];
#pragma unroll
                for (int e = 0; e < 4; ++e) { const int s = s0 + e; const float wgt = (s <= t) ? __expf(rt_ + SC[64 + s]) : 0.f; p[e] = acc[4 * g + e] * wgt; dsum += p[e]; }
                *(LAS unsigned long long*)(L + ML_PS + t * 144 + s0 * 2) = (unsigned long long)pg8::cvt_pk_bf16(p[0], p[1]) | ((unsigned long long)pg8::cvt_pk_bf16(p[2], p[3]) << 32); } }
            ((LAS float*)(L + ML_DENP))[(si * 2 + hi) * 64 + t] = dsum;
            __syncthreads();
        }
    } else if (wave < 6) {
        v4u rs[10];
        PP_LD(par, 10);
        for (int k = 0; k < 64; ++k) { const int c = par + 2 * k;
            if (!(PV & 16)) PP_ST(10);
            if (!(PV & 8) && k + 1 < 64) PP_LD(c + 2, 10);
            __syncthreads();
            __syncthreads();
        }
    } else {
        const int l = tid - 384, t = l >> 1;
        for (int k = 0; k < 64; ++k) { const int c = par + 2 * k;
            __syncthreads();
            __syncthreads();
            if (!(PV & 32)) {
            const LAS v4u* sp = (const LAS v4u*)(L + ML_PS + t * 144 + (l & 1) * 64);
            bf16* gp = PG + (((size_t)hd * 128 + c) * 64 + t) * 64 + 32 * (l & 1);
#pragma unroll
            for (int kq = 0; kq < 4; ++kq) { const v4u pv = sp[kq]; asm volatile("global_store_dwordx4 %0, %1, off sc1" :: "v"(gp + 8 * kq), "v"(pv) : "memory"); }
            if (wave == 6) { const LAS float* dp = (const LAS float*)(L + ML_DENP);
                const float den = (dp[l] + dp[64 + l]) + (dp[128 + l] + dp[192 + l]);
                __hip_atomic_store((unsigned*)(DG + ((size_t)hd * 128 + c) * 64 + l), __float_as_uint(den), RLX_AGENT);
                asm volatile("s_waitcnt vmcnt(15)" ::: "memory"); }
            else asm volatile("s_waitcnt vmcnt(12)" ::: "memory");
            }
        }
    }
#undef PP_LD
#undef PP_ST
    asm volatile("s_waitcnt vmcnt(0)" ::: "memory");
    __syncthreads();
    if (tid == 0) __hip_atomic_store(flag, 64u, RLX_AGENT);
    __syncthreads();
}

template <int PV>
__device__ __forceinline__ void mlstm_n_producer(Frame& F, int hd, const bf16* QKC, const bf16* KTg, const float* MG, const float* DEC, float* DGN, gu32* flag) {
    constexpr int PP_D = 3, NSC = ML_CB, NSCN = 192;
    LAS unsigned char* L = F.lds; const int tid = F.tid, lane = F.lane, wave = F.wave, r32 = lane & 31, hi = lane >> 5;
    const float* mgh = MG + (size_t)hd * 5 * S;
    ((LAS float*)(L + ML_NV))[tid] = 0.f;
    if (wave < 4) {
        v4u rs[2][8]; float rsc[2];
        const unsigned glo = (unsigned)(((tid >> 5) * 2048 + 8 * (tid & 31)) * 2); LAS unsigned char* const lst = L + ML_QS + (tid >> 5) * 528 + (tid & 31) * 16;
        const float* const scp = tid < 64 ? mgh + (size_t)2 * S + tid : tid < 128 ? mgh + (size_t)4 * S + (tid - 64) : DEC + hd * 128; const int scstep = tid < 128 ? 64 : 1;
        const int tq = 16 * wave + (lane >> 2), dq4 = lane & 3;
#define PN_LD(c, P) do { const char* ub_ = (const char*)(QKC + (size_t)(64 * (c)) * 2048 + 256 * hd); \
        _Pragma("unroll") for (int i = 0; i < 8; ++i) rs[P][i] = *(const v4u*)(ub_ + (size_t)i * 32768 + glo); rsc[P] = scp[(c) * scstep]; } while (0)
#define PN_STEP_A(c, P) do { \
            if (!(PV & 16)) { _Pragma("unroll") for (int i = 0; i < 8; ++i) *(LAS v4u*)(lst + i * 4224) = rs[P][i]; } \
            if (tid <= 128) ((LAS float*)(L + NSC))[P * NSCN + tid] = rsc[P]; \
            if (!(PV & 8) && (c) + 2 < 128) PN_LD((c) + 2, P); \
            __syncthreads(); \
            if (tid == 0 && (c) > PP_D) __hip_atomic_store(flag, (unsigned)((c) - PP_D), RLX_AGENT); \
            if (!(PV & 1)) { const LAS unsigned char* qp = L + ML_QS + tq * 528 + dq4 * 128; const LAS float* nv = (const LAS float*)(L + ML_NV) + P * 256 + dq4 * 64; float a = 0.f; \
                _Pragma("unroll") for (int j = 0; j < 8; ++j) { float qf[8]; unpk8(*(const LAS v4u*)(qp + j * 16), qf); const f32x4 n0 = *(const LAS f32x4*)(nv + 8 * j), n1 = *(const LAS f32x4*)(nv + 8 * j + 4); \
                    a += ((qf[0] * n0.x + qf[1] * n0.y) + (qf[2] * n0.z + qf[3] * n0.w)) + ((qf[4] * n1.x + qf[5] * n1.y) + (qf[6] * n1.z + qf[7] * n1.w)); } \
                a += xor_lanes<1>(a); a += xor_lanes<2>(a); \
                if (dq4 == 0) ((LAS float*)(L + ML_DQ))[tq] = a; } \
            __syncthreads(); } while (0)
        PN_LD(0, 0); PN_LD(1, 1);
#pragma nounroll
        for (int c = 0; c < 128; c += 2) { PN_STEP_A(c, 0); PN_STEP_A(c + 1, 1); }
#undef PN_STEP_A
#undef PN_LD
    } else if (wave < 6) {
        v4u rkt[16]; f32x16 na[4];
#pragma unroll
        for (int j = 0; j < 4; ++j) {
#pragma unroll
            for (int r = 0; r < 16; ++r) na[j][r] = 0.f; }
        const int dn = 128 * (wave & 1) + r32;
#define PN_LDKT(c) do { _Pragma("unroll") for (int j = 0; j < 4; ++j) { _Pragma("unroll") for (int kk = 0; kk < 4; ++kk) \
        rkt[4 * j + kk] = *(const v4u*)(KTg + (((size_t)(c) * 4 + hd) * 256 + dn + 32 * j) * 64 + 16 * kk + 8 * hi); } } while (0)
        PN_LDKT(0);
        for (int c = 0; c < 128; ++c) {
            __syncthreads();
            const LAS float* SC = (const LAS float*)(L + NSC) + (c & 1) * NSCN;
            if (!(PV & 4)) {
            const float dcy = SC[128]; const LAS float* wsl = SC + 64 + 8 * hi;
#pragma unroll
            for (int j = 0; j < 4; ++j) {
#pragma unroll
                for (int r = 0; r < 16; ++r) na[j][r] *= dcy; }
#pragma unroll
            for (int kk = 0; kk < 4; ++kk) { const f32x4 w0 = *(const LAS f32x4*)(wsl + 16 * kk), w1 = *(const LAS f32x4*)(wsl + 16 * kk + 4);
                const v4u wp = (v4u){pg8::cvt_pk_bf16(w0.x, w0.y), pg8::cvt_pk_bf16(w0.z, w0.w), pg8::cvt_pk_bf16(w1.x, w1.y), pg8::cvt_pk_bf16(w1.z, w1.w)};
#pragma unroll
                for (int j = 0; j < 4; ++j) na[j] = __builtin_amdgcn_mfma_f32_32x32x16_bf16(__builtin_bit_cast(bf16x8, rkt[4 * j + kk]), __builtin_bit_cast(bf16x8, wp), na[j], 0, 0, 0); }
            if (r32 == 0) { LAS float* nv = (LAS float*)(L + ML_NV) + ((c + 1) & 1) * 256 + 128 * (wave & 1) + 4 * hi;
#pragma unroll
                for (int j = 0; j < 4; ++j) {
#pragma unroll
                    for (int g = 0; g < 4; ++g) *(LAS f32x4*)(nv + 32 * j + 8 * g) = (f32x4){na[j][4 * g], na[j][4 * g + 1], na[j][4 * g + 2], na[j][4 * g + 3]}; } }
            }
            if (!(PV & 8) && c + 1 < 128) PN_LDKT(c + 1);
            __syncthreads();
        }
#undef PN_LDKT
    } else {
        for (int c = 0; c < 128; ++c) {
            __syncthreads();
            __syncthreads();
            if (wave == 7 && !(PV & 32)) { const LAS float* SC = (const LAS float*)(L + NSC) + (c & 1) * NSCN;
                const float den = SC[lane] * ((const LAS float*)(L + ML_DQ))[lane];
                __hip_atomic_store((unsigned*)(DGN + ((size_t)hd * 128 + c) * 64 + lane), __float_as_uint(den), RLX_AGENT);
                asm volatile("s_waitcnt vmcnt(3)" ::: "memory"); }
        }
    }
    asm volatile("s_waitcnt vmcnt(0)" ::: "memory");
    __syncthreads();
    if (tid == 0) __hip_atomic_store(flag, 128u, RLX_AGENT);
    __syncthreads();
}

template <int VAR>
__device__ __forceinline__ void mlstm_unit(Frame& F, int hd, int vs, const bf16* QKC, const bf16* KTg, const bf16* VTg, const float* MG, const float* DEC, bf16* HM,
                                           const bf16* PG, const float* DG, gu32* flag) {
    LAS unsigned char* L = F.lds; const int tid = F.tid, lane = F.lane, wave = F.wave, r32 = lane & 31, hi = lane >> 5;
    for (int i = tid; i < (ML_PS - ML_CB) / 4; i += 512) ((LAS unsigned*)(L + ML_CB))[i] = 0u;
    f32x16 cacc;
#pragma unroll
    for (int r = 0; r < 16; ++r) cacc[r] = 0.f;
    const float* mgh = MG + (size_t)hd * 5 * S;
    v4u rq[2][4], rt[2][4], rv[2]; float rsc[2], rden[2]; unsigned long long rp0[2], rp1[2];
    const int sq = tid >> 5, dc = tid & 31;
    const int vv = tid >> 3, sc8 = tid & 7;
    const float* const scp = tid < 320 ? mgh + (size_t)(tid >> 6) * S + (tid & 63) : DEC + hd * 128; const int scstep = tid < 320 ? 64 : 1;
    const int vvc = vv & 31;
    unsigned pub0 = 0u, pub1 = 0u, pubn = 0u;
#define ML_NEED(c, P) do { if (pubn < (unsigned)((c) + 1)) { unsigned sp_ = 0u; do { pubn = (unsigned)__builtin_amdgcn_readfirstlane(__hip_atomic_load(flag + 16, RLX_AGENT)); if (pubn >= (unsigned)((c) + 1)) break; __builtin_amdgcn_s_sleep(4); } while (++sp_ < (1u << 16)); } \
        const unsigned nd_ = (unsigned)(((c) >> 1) + 1); if (pub##P < nd_) { unsigned sp_ = 0u; do { pub##P = (unsigned)__builtin_amdgcn_readfirstlane(__hip_atomic_load(flag + 8 * P, RLX_AGENT)); if (pub##P >= nd_) break; __builtin_amdgcn_s_sleep(4); } while (++sp_ < (1u << 16)); } } while (0)
#define ML_LOAD_Q(c, P) do { \
        _Pragma("unroll") for (int i = 0; i < 4; ++i) rq[P][i] = *(const v4u*)(QKC + (size_t)(64 * (c) + sq + 16 * i) * 2048 + 256 * hd + 8 * dc); \
        rsc[P] = scp[(c) * scstep]; } while (0)
#define ML_LOAD_TV(c, P) do { const int t0_ = 64 * (c); ML_NEED(c, P); \
        _Pragma("unroll") for (int i = 0; i < 4; ++i) rt[P][i] = *(const v4u*)(KTg + (((size_t)(c) * 4 + hd) * 256 + vv + 64 * i) * 64 + 8 * sc8); \
        { const unsigned long long* pp_ = (const unsigned long long*)(PG + (((size_t)hd * 128 + (c)) * 64 + vv) * 64 + 8 * sc8); rp0[P] = __hip_atomic_load(pp_, RLX_AGENT); rp1[P] = __hip_atomic_load(pp_ + 1, RLX_AGENT); } \
        rden[P] = __uint_as_float(__hip_atomic_load((const unsigned*)(DG + ((size_t)hd * 128 + (c)) * 64 + (tid & 63)), RLX_AGENT)) + __uint_as_float(__hip_atomic_load((const unsigned*)(DG + 262144 + ((size_t)hd * 128 + (c)) * 64 + (tid & 63)), RLX_AGENT)); \
        rv[P] = *(const v4u*)(VTg + (((size_t)(c) * 4 + hd) * 512 + 32 * vs + vvc) * 64 + 8 * sc8); (void)t0_; } while (0)
#define ML_STORE_Q(c, P) do { _Pragma("unroll") for (int i = 0; i < 4; ++i) *(LAS v4u*)(L + ML_QS + (sq + 16 * i) * 528 + dc * 16) = rq[P][i]; \
        if (tid <= 320) ((LAS float*)(L + ML_SC))[((c) & 1) * 336 + tid] = rsc[P]; } while (0)
#define ML_STORE_TV(P) do { _Pragma("unroll") for (int i = 0; i < 4; ++i) *(LAS v4u*)(L + ML_KT + (vv + 64 * i) * 144 + sc8 * 16) = rt[P][i]; \
        { LAS unsigned long long* ps_ = (LAS unsigned long long*)(L + ML_PS + vv * 144 + sc8 * 16); ps_[0] = rp0[P]; ps_[1] = rp1[P]; } \
        if (tid < 64) ((LAS float*)(L + ML_DENP))[tid] = rden[P]; \
        if (tid < 256) { *(LAS v4u*)(L + ML_VT + vv * 144 + sc8 * 16) = rv[P]; \
            const f32x4 w0_ = *(const LAS f32x4*)(L + ML_SC + (P * 336 + 256 + 8 * sc8) * 4), w1_ = *(const LAS f32x4*)(L + ML_SC + (P * 336 + 256 + 8 * sc8 + 4) * 4);     \
            float vf[8]; unpk8(rv[P], vf); vf[0] *= w0_.x; vf[1] *= w0_.y; vf[2] *= w0_.z; vf[3] *= w0_.w; vf[4] *= w1_.x; vf[5] *= w1_.y; vf[6] *= w1_.z; vf[7] *= w1_.w; \
            *(LAS v4u*)(L + ML_VW + vv * 144 + sc8 * 16) = pk8(vf); } } while (0)
#define ML_STEP(c, P) do { \
        if (!(VAR & 32)) ML_STORE_TV(P); \
        if (!(VAR & 16) && (c) + 2 < 128) ML_LOAD_TV((c) + 2, P); \
        const LAS float* SC = (const LAS float*)(L + ML_SC) + P * 336; \
        f32x16 hacc; \
        if (!(VAR & 4) && (wave == 4 || wave == 5 || wave < 2)) { \
            const int ti = wave & 1, kh = wave < 2 ? 1 : 0; \
            _Pragma("unroll") for (int r = 0; r < 16; ++r) hacc[r] = 0.f; \
            const LAS unsigned char* ca = L + ML_CB + r32 * 528 + hi * 16 + kh * 256; const LAS unsigned char* qb = L + ML_QS + (32 * ti + r32) * 528 + hi * 16 + kh * 256; \
            _Pragma("unroll") for (int kk = 0; kk < 8; ++kk) hacc = __builtin_amdgcn_mfma_f32_32x32x16_bf16(*(const LAS bf16x8*)(ca + kk * 32), *(const LAS bf16x8*)(qb + kk * 32), hacc, 0, 0, 0); \
            ML_CHAIN_SCHED(8); \
            if (wave < 2) { \
                _Pragma("unroll") for (int g = 0; g < 4; ++g) *(LAS f32x4*)(L + ML_KS + wave * 4096 + g * 1024 + lane * 16) = (f32x4){hacc[4 * g], hacc[4 * g + 1], hacc[4 * g + 2], hacc[4 * g + 3]}; } \
        } \
        __syncthreads(); \
        if (!(VAR & 64) && (wave == 4 || wave == 5)) { \
            const int ti = wave - 4, t = 32 * ti + r32; const float wi = SC[128 + t], nr = SC[192 + t]; \
            const float den = ((const LAS float*)(L + ML_DENP))[t];     \
            _Pragma("unroll") for (int g = 0; g < 4; ++g) { const f32x4 px = *(const LAS f32x4*)(L + ML_KS + ti * 4096 + g * 1024 + lane * 16); \
                hacc[4 * g] = (hacc[4 * g] + px.x) * wi; hacc[4 * g + 1] = (hacc[4 * g + 1] + px.y) * wi; hacc[4 * g + 2] = (hacc[4 * g + 2] + px.z) * wi; hacc[4 * g + 3] = (hacc[4 * g + 3] + px.w) * wi; } \
            const LAS unsigned char* va = L + ML_VT + r32 * 144 + hi * 16; const LAS unsigned char* pb = L + ML_PS + t * 144 + hi * 16; \
            __builtin_amdgcn_sched_barrier(0); \
            _Pragma("unroll") for (int kk = 0; kk < 4; ++kk) hacc = __builtin_amdgcn_mfma_f32_32x32x16_bf16(*(const LAS bf16x8*)(va + kk * 32), *(const LAS bf16x8*)(pb + kk * 32), hacc, 0, 0, 0); \
            ML_SGB(0x100, 8); ML_SGB(0x008, 4); __builtin_amdgcn_sched_barrier(0); \
            const float inv = 1.0f / fmaxf(fabsf(den), nr); \
            bf16* op = HM + (size_t)(64 * (c) + t) * 2048 + 512 * hd + 32 * vs + 4 * hi; \
            _Pragma("unroll") for (int g = 0; g < 4; ++g) *(unsigned long long*)(op + 8 * g) = (unsigned long long)pg8::cvt_pk_bf16(hacc[4 * g] * inv, hacc[4 * g + 1] * inv) | ((unsigned long long)pg8::cvt_pk_bf16(hacc[4 * g + 2] * inv, hacc[4 * g + 3] * inv) << 32); \
        } \
        if (!(VAR & 8)) { const float dcy = SC[320]; \
          _Pragma("unroll") for (int r = 0; r < 16; ++r) cacc[r] *= dcy; \
          const LAS unsigned char* ka = L + ML_KT + (32 * wave + r32) * 144 + hi * 16; const LAS unsigned char* vb = L + ML_VW + r32 * 144 + hi * 16; \
          __builtin_amdgcn_sched_barrier(0); \
          _Pragma("unroll") for (int kk = 0; kk < 4; ++kk) cacc = __builtin_amdgcn_mfma_f32_32x32x16_bf16(*(const LAS bf16x8*)(ka + kk * 32), *(const LAS bf16x8*)(vb + kk * 32), cacc, 0, 0, 0); \
          ML_SGB(0x100, 8); ML_SGB(0x008, 4); __builtin_amdgcn_sched_barrier(0); \
          _Pragma("unroll") for (int g = 0; g < 4; ++g) *(LAS unsigned long long*)(L + ML_CB + r32 * 528 + (32 * wave + 8 * g + 4 * hi) * 2) = (unsigned long long)pg8::cvt_pk_bf16(cacc[4 * g], cacc[4 * g + 1]) | ((unsigned long long)pg8::cvt_pk_bf16(cacc[4 * g + 2], cacc[4 * g + 3]) << 32); \
        } \
        if ((c) + 1 < 128) { if (!(VAR & 32)) ML_STORE_Q((c) + 1, 1 - P); if (!(VAR & 16) && (c) + 3 < 128) ML_LOAD_Q((c) + 3, 1 - P); } \
        __syncthreads(); } while (0)
    ML_LOAD_Q(0, 0); ML_LOAD_TV(0, 0); ML_LOAD_Q(1, 1); ML_LOAD_TV(1, 1);
    ML_STORE_Q(0, 0);
    ML_LOAD_Q(2, 0);
    __syncthreads();
#pragma nounroll
    for (int c = 0; c < 128; c += 2) { ML_STEP(c, 0); ML_STEP(c + 1, 1); }
#undef ML_STEP
#undef ML_NEED
#undef ML_LOAD_Q
#undef ML_LOAD_TV
#undef ML_STORE_Q
#undef ML_STORE_TV
}

__device__ __forceinline__ void post_phase(Frame& F, const bf16* HM, const bf16* OG, const bf16* O1, const bf16* O2, const float* gm, const float* gd, const float* lmb, float lam_init, bf16* AM, bf16* AB) {
    const float lam = expf(wave_sum(lmb[F.lane] * lmb[64 + F.lane])) - expf(wave_sum(lmb[128 + F.lane] * lmb[192 + F.lane])) + lam_init;
    const float omli = 1.0f - lam_init;
    LAS f32x4* GM = (LAS f32x4*)F.lds; LAS f32x4* GD = GM + 512;
    GM[F.tid] = ((const f32x4*)gm)[F.tid]; GD[F.tid] = ((const f32x4*)gd)[F.tid] * omli;
    __syncthreads();
    const int gw = F.vcu * NWAVES + F.wave, NGW = F.G * NWAVES;
    v4u a0[4][4], a1[4][4];
#define PP_LOAD(Bf, row) do { _Pragma("unroll") for (int j = 0; j < 4; ++j) { const size_t off = (size_t)(row) * 2048 + 8 * F.lane + 512 * j; \
        Bf[j][0] = *(const v4u*)(HM + off); Bf[j][1] = *(const v4u*)(OG + off); Bf[j][2] = *(const v4u*)(O1 + off); Bf[j][3] = *(const v4u*)(O2 + off); } } while (0)
#define PP_PROC(Bf, row) do { _Pragma("unroll") for (int j = 0; j < 4; ++j) { const size_t off = (size_t)(row) * 2048 + 8 * F.lane + 512 * j; \
        float h[8], og[8], o1[8], o2[8], o[8]; unpk8(Bf[j][0], h); unpk8(Bf[j][1], og); unpk8(Bf[j][2], o1); unpk8(Bf[j][3], o2); \
        const f32x4 ga0 = GM[2 * F.lane + 128 * j], ga1 = GM[2 * F.lane + 128 * j + 1], gb0 = GD[2 * F.lane + 128 * j], gb1 = GD[2 * F.lane + 128 * j + 1]; \
        const float ga[8] = {ga0.x, ga0.y, ga0.z, ga0.w, ga1.x, ga1.y, ga1.z, ga1.w}, gb[8] = {gb0.x, gb0.y, gb0.z, gb0.w, gb1.x, gb1.y, gb1.z, gb1.w}; \
        float ss = 0.f, sd = 0.f; \
        _Pragma("unroll") for (int e = 0; e < 8; ++e) { ss += h[e] * h[e]; o[e] = o1[e] - lam * o2[e]; sd += o[e] * o[e]; } \
        ss = wave_sum(ss); sd += xor_lanes<1>(sd); sd += xor_lanes<2>(sd); sd += xor_lanes<4>(sd); sd += xor_lanes<8>(sd); \
        const float rm = 1.0f / sqrtf(ss * (1.0f / 512.0f) + EPS), rd = 1.0f / sqrtf(sd * (1.0f / 128.0f) + EPS); \
        _Pragma("unroll") for (int e = 0; e < 8; ++e) { h[e] = og[e] * (h[e] * rm * ga[e]); o[e] = o[e] * rd * gb[e]; } \
        const size_t off2 = (size_t)(row) * 4096 + 8 * F.lane + 512 * j; *(v4u*)(AM + off2 + 2048) = pk8(h); *(v4u*)(AM + off2) = pk8(o); } } while (0)
    int row = gw;
    if (row < S) PP_LOAD(a0, row);
    for (; row < S; row += 2 * NGW) {
        const int r1 = row + NGW, r2 = row + 2 * NGW;
        if (r1 < S) PP_LOAD(a1, r1);
        PP_PROC(a0, row);
        if (r2 < S) PP_LOAD(a0, r2);
        if (r1 < S) PP_PROC(a1, r1);
    }
#undef PP_LOAD
#undef PP_PROC
    __syncthreads();
}

__device__ __forceinline__ void drain_copy_queue(Frame& F, const __attribute__((address_space(4))) Args* A, unsigned char* ws, gu32* qc, int l) {
    const int n_own = WI_LAYER - WI_IN, n_conv = n_own + (l + 1 < DEPTH ? WI_IN : 0), n_items = n_conv + (l + 1 < DEPTH ? 1536 : 0); LAS float* scr = (LAS float*)(F.lds + F.wave * 16640);
    static_assert((WI_LAYER - WI_IN) % 32 == 0 && WI_IN % 32 == 0 && 1536 % 32 == 0, "copy-queue groups");
    for (;;) {
        __syncthreads();
        if (F.tid == 0) F.MISC[0] = __hip_atomic_fetch_add(qc, 1u, RLX_AGENT);
        __syncthreads();
        const int base = (int)F.MISC[0] * 32;
        if (base >= n_items) break;
        if (base >= n_conv) {
#pragma unroll 1
            for (int j = 0; j < 4; ++j) adaln_item(A->in[1], A->in[3], ws, l + 1, base - n_conv + 8 * j + F.wave, F.lane);
        } else {
#define DCQ_DESC(j, d) witem_desc(A->in[9], A->in[17], A->in[18], A->in[19], A->in[20], A->in[21], A->in[24], ws, (base + 8 * (j) + F.wave) < n_own ? l : l + 1, \
                                  (base + 8 * (j) + F.wave) < n_own ? base + 8 * (j) + F.wave + WI_IN : base + 8 * (j) + F.wave - n_own, F.lane, d)
            WItem d0, d1; f32x4 va[16], vb[16];
            const int l0 = DCQ_DESC(0, d0); WITEM_ISSUE(d0, l0, va);
            const int l1 = DCQ_DESC(1, d1); WITEM_ISSUE(d1, l1, vb);
            witem_finish(d0, va, scr, F.lane);
            const int l2 = DCQ_DESC(2, d0); WITEM_ISSUE(d0, l2, va);
            witem_finish(d1, vb, scr, F.lane);
            const int l3 = DCQ_DESC(3, d1); WITEM_ISSUE(d1, l3, vb);
            witem_finish(d0, va, scr, F.lane);
            witem_finish(d1, vb, scr, F.lane);
#undef DCQ_DESC
        }
    }
}

typedef const __attribute__((address_space(4))) Args* CArgs;
__device__ __forceinline__ CArgs get_args() { CArgs p = (CArgs)__builtin_amdgcn_kernarg_segment_ptr(); asm volatile("" : "+s"(p)); return p; }
#define P8B(ws, i) ((bf16*)((ws) + WS_P8 + (size_t)(i) * P8_STRIDE))
__global__ void __launch_bounds__(NWAVES * 64, 2) trunk_fwd(Args args_unused) {
    extern __shared__ __attribute__((aligned(16))) unsigned char lds[];
    Frame F;
    F.lds = (LAS unsigned char*)lds; F.MISC = (volatile LAS unsigned*)(F.lds + MISC_OFF);
    F.tid = threadIdx.x; F.lane = F.tid & 63; F.wave = __builtin_amdgcn_readfirstlane(F.tid >> 6);
    F.G = gridDim.x; { const int bx = blockIdx.x; F.vcu = (F.G % 8 == 0) ? (bx % 8) * (F.G / 8) + bx / 8 : bx; }
    F.ctl = (gu32*)(get_args()->ws + WS_CTL);
#ifdef DBG_POISON
    for (int u = F.tid; u < LDSCTL_OFF / 4; u += NWAVES * 64) ((LAS unsigned*)F.lds)[u] = 0xAAAAAAAAu;
#endif
    for (int u = F.tid; u < (LDS_BYTES - LDSCTL_OFF) / 4; u += NWAVES * 64) ((LAS unsigned*)(F.lds + LDSCTL_OFF))[u] = 0u;
    __syncthreads();
#if MK_ONE_LAUNCH
    XcdBarrier bar = xcd_barrier_post((unsigned*)(F.ctl + CW_BAR), F.MISC + 8);
#define GRID_BAR() do { XcdBarrier b_ = bar; asm volatile("" : "+s"(b_.bar)); xcd_barrier(b_); } while (0)
#else
#define GRID_BAR() do { } while (0)
#endif
#ifdef PROF_K1
#ifndef PROF_SHIFT
#define PROF_SHIFT 0.5f
#endif
    LAS unsigned long long* pacc = (LAS unsigned long long*)(F.lds + LDSCTL_OFF);
    if (blockIdx.x == 0 && F.tid == 0) pacc[15] = rt();
#define PROF_MARK(k) do { if (blockIdx.x == 0 && F.wave == 0 && fresh_tid(0) == 0) { const unsigned long long t_ = rt(); pacc[k] += t_ - pacc[15]; pacc[15] = t_; } } while (0)
#else
#define PROF_MARK(k) do { } while (0)
#endif
    const int lo = get_args()->ph_lo, hi = get_args()->ph_hi;
#ifndef PH_MASK
#define PH_MASK 0xFFFFFFFFu
#endif
#define EN(k) ((PH_MASK >> (k)) & 1u)
#ifndef DUPMASK
#define DUPMASK 0u
#endif
#ifndef DUPMODE
#define DUPMODE 1
#endif
#define REPS(k) (1 + (int)((DUPMASK >> (k)) & 1u))
#define IN(k) (lo <= (k) && (k) < hi)
#define BOTH(k) (IN(k) && IN((k) + 1))
    if (EN(13) && IN(0)) {
#pragma nounroll
        for (int rep = 0; rep < REPS(13); ++rep) { p0_prologue(F, get_args()); if (BOTH(0) || rep + 1 < REPS(13)) GRID_BAR(); } PROF_MARK(13); }
    if (EN(14) && IN(1)) { p0b_mod_reduce(F, get_args(), 0); if (BOTH(1)) GRID_BAR(); PROF_MARK(14); }
#ifdef XBARS
#pragma nounroll
    for (int xb = 0; xb < XBARS; ++xb) GRID_BAR();
#endif

    for (int l = 0; l < DEPTH; ++l) {
        const int pb = 2 + NPH_LAYER * l;
        if (EN(0) && IN(pb + 0) && l == 0) { { CArgs A = get_args(); unsigned char* ws = A->ws; F.tid = fresh_tid(F.wave); F.lane = F.tid & 63; const float* mod = (const float*)(ws + WS_MOD);
                row_phase<false, true, true>(F, A->in[0], nullptr, nullptr, nullptr, nullptr, A->in[5], mod + D, mod, (bf16*)(ws + WS_H), (const float*)(ws + WS_WG), A->in[12], A->in[13], (float*)(ws + WS_GATES)); }
            if (BOTH(pb + 0)) GRID_BAR(); PROF_MARK(0); }
        if (EN(1) && IN(pb + 1))
#pragma nounroll
        for (int rep = 0; rep < REPS(1); ++rep) { CArgs A = get_args(); unsigned char* ws = A->ws; F.tid = fresh_tid(F.wave); F.lane = F.tid & 63; const float* ropeC = (const float*)(ws + WS_ROPE);
            pg8::Gemm g{(const bf16*)(ws + WS_H), (const bf16*)(ws + WS_W + (size_t)l * W_LAYER + WO_IN), S, NINP, D}; pg8::StaticOrder So; So.init(S, NINP, F.G, (int)blockIdx.x);
            pg8::EpiIn E{P8B(ws, 0), P8_STRIDE / 2, ropeC, ropeC + S * 8, attn_body::C2};
            pg8::gemm_phase<pg8::EpiIn, pg8::StaticOrder, true, true>(F.lds, g, So, E, F.wave);
            if (BOTH(pb + 1) || rep + 1 < REPS(1)) GRID_BAR(); PROF_MARK(1); }
        if (EN(2) && IN(pb + 2))
#pragma nounroll
        for (int rep = 0; rep < REPS(2); ++rep) { CArgs A = get_args(); unsigned char* ws = A->ws; F.tid = fresh_tid(F.wave); F.lane = F.tid & 63;
            prep_phase(F, P8B(ws, 0), P8B(ws, 1), (bf16*)(ws + WS_QKC), (bf16*)(ws + WS_KT), (bf16*)(ws + WS_VT), A->in[10] + (size_t)l * 4 * 2048, A->in[11] + (size_t)l * 2048);
            __syncthreads();
            if (blockIdx.x < 4) gate_scan(F, (int)blockIdx.x, (const float*)(ws + WS_GATES), (float*)(ws + WS_MG), (float*)(ws + WS_DEC));
            if (BOTH(pb + 2) || rep + 1 < REPS(2)) GRID_BAR(); PROF_MARK(2); }
        if (EN(3) && IN(pb + 3))
#pragma nounroll
        for (int rep = 0; rep < REPS(3); ++rep) { CArgs A = get_args(); unsigned char* ws = A->ws; F.tid = fresh_tid(F.wave); F.lane = F.tid & 63; __syncthreads();
            {
#ifndef PVAR
#define PVAR 0
#endif
#ifndef MLVAR
#define MLVAR 0
#endif
#ifndef TPROBE_REP
#define TPROBE_REP 0
#endif
#ifdef TPROBE_WG
            unsigned long long tp0_ = 0ull; if ((int)blockIdx.x == TPROBE_WG && l == TPROBE_L && rep == TPROBE_REP) tp0_ = rt();
#endif
            { const int ph = ((int)blockIdx.x - 128) >> 1, pp = ((int)blockIdx.x - 128) & 1, ch = (int)blockIdx.x >> 4; const bool dupml = DUPMODE == 1 || DUPMODE == 4;
              gu32* const pfl = F.ctl + CW_PF + 64 * (4 * l) + 32 * rep;
              if (rep == 0 && blockIdx.x >= 128 && blockIdx.x < 136) mlstm_p_producer<0>(F, ph, pp, (const bf16*)(ws + WS_QKC), (const float*)(ws + WS_MG), (bf16*)(ws + WS_PG), (float*)(ws + WS_DG), pfl + 64 * ph + 8 * pp);
              if (rep == 0 && blockIdx.x >= 136 && blockIdx.x < 140) mlstm_n_producer<0>(F, (int)blockIdx.x - 136, (const bf16*)(ws + WS_QKC), (const bf16*)(ws + WS_KT), (const float*)(ws + WS_MG), (const float*)(ws + WS_DEC), (float*)(ws + WS_DG) + 262144, pfl + 64 * ((int)blockIdx.x - 136) + 16);
              if (rep == 1 && (dupml || DUPMODE == 5) && blockIdx.x >= 128 && blockIdx.x < 136) mlstm_p_producer<PVAR>(F, ph, pp, (const bf16*)(ws + WS_QKC), (const float*)(ws + WS_MG), (bf16*)(ws + WS_PG), (float*)(ws + WS_DG), pfl + 64 * ph + 8 * pp);
              if (rep == 1 && (dupml || DUPMODE == 5) && blockIdx.x >= 136 && blockIdx.x < 140) mlstm_n_producer<PVAR>(F, (int)blockIdx.x - 136, (const bf16*)(ws + WS_QKC), (const bf16*)(ws + WS_KT), (const float*)(ws + WS_MG), (const float*)(ws + WS_DEC), (float*)(ws + WS_DG) + 262144, pfl + 64 * ((int)blockIdx.x - 136) + 16);
              if (rep == 0 && blockIdx.x < 64) mlstm_unit<0>(F, ch, (int)blockIdx.x & 15, (const bf16*)(ws + WS_QKC), (const bf16*)(ws + WS_KT), (const bf16*)(ws + WS_VT), (const float*)(ws + WS_MG), (const float*)(ws + WS_DEC), (bf16*)(ws + WS_HM),
                                            (const bf16*)(ws + WS_PG), (const float*)(ws + WS_DG), pfl + 64 * ch);
              if (rep == 1 && (dupml || DUPMODE == 3 || DUPMODE == 6) && blockIdx.x < 64) mlstm_unit<MLVAR>(F, ch, (int)blockIdx.x & 15, (const bf16*)(ws + WS_QKC), (const bf16*)(ws + WS_KT), (const bf16*)(ws + WS_VT), (const float*)(ws + WS_MG), (const float*)(ws + WS_DEC),
                                            (bf16*)(ws + ((MLVAR != 0 || PVAR != 0) ? WS_T : WS_HM)), (const bf16*)(ws + WS_PG), (const float*)(ws + WS_DG), pfl + 64 * ch - (dupml ? 0 : 32));
            }
#ifdef TPROBE_WG
            if ((int)blockIdx.x == TPROBE_WG && l == TPROBE_L && rep == TPROBE_REP && F.tid == 0) { const unsigned long long d_ = rt() - tp0_; __hip_atomic_store(F.ctl + 2040, (unsigned)d_, RLX_AGENT); }
#endif
            }
            if (blockIdx.x >= 64 && blockIdx.x < 64 + CONV_WGS && rep == 0) drain_copy_queue(F, A, ws, F.ctl + CW_Q + 64 * (8 + l), l);
            gu32* qh = F.ctl + CW_Q + 64 * (l + 4 * rep);
            const attn_body::bf16* Qb = (const attn_body::bf16*)P8B(ws, 3); const attn_body::bf16* Kb = (const attn_body::bf16*)P8B(ws, 4); const attn_body::bf16* Vb = (const attn_body::bf16*)P8B(ws, 5);
            attn_body::bf16* O1 = (attn_body::bf16*)(ws + WS_O1); attn_body::bf16* O2 = (attn_body::bf16*)(ws + WS_O2);
            for (;;) {
                __syncthreads();
                if (F.tid == 0) F.MISC[0] = __hip_atomic_fetch_add(qh, 1u, RLX_AGENT);
                __syncthreads();
                const unsigned idx = F.MISC[0];
                if (idx >= 1024u || (rep == 1 && (DUPMODE == 3 || DUPMODE == 4 || DUPMODE == 5))) break;
                const int qb = 31 - (int)(idx >> 5), bh = (int)(idx & 31u), hh = bh >> 1, cm = bh & 1;
                attn_body::attn_unit<8>(qb, Qb + hh * 128 + cm * 64, Kb + hh * 128 + cm * 64, Vb + hh * 128, (cm ? O2 : O1) + hh * 128, (char*)lds, F.wave);
            }
            if (BOTH(pb + 3) || rep + 1 < REPS(3)) GRID_BAR(); PROF_MARK(3); }
        if (EN(5) && IN(pb + 5))
#pragma nounroll
        for (int rep = 0; rep < REPS(5); ++rep) { CArgs A = get_args(); unsigned char* ws = A->ws; F.tid = fresh_tid(F.wave); F.lane = F.tid & 63;
            if (l + 1 < DEPTH && rep == 0) p0b_mod_reduce(F, A, l + 1);
            post_phase(F, (const bf16*)(ws + WS_HM), P8B(ws, 2), (const bf16*)(ws + WS_O1), (const bf16*)(ws + WS_O2), A->in[14] + (size_t)l * 2048, A->in[16] + (size_t)l * 2048, A->in[15] + (size_t)l * 256,
                       0.8f - 0.6f * expf(-0.3f * (float)l), (bf16*)(ws + WS_AM), (bf16*)(ws + WS_AB));
            if (BOTH(pb + 5) || rep + 1 < REPS(5)) GRID_BAR(); PROF_MARK(5); }
        if (EN(6) && IN(pb + 6))
#pragma nounroll
        for (int rep = 0; rep < REPS(6); ++rep) { CArgs A = get_args(); unsigned char* ws = A->ws; F.tid = fresh_tid(F.wave); F.lane = F.tid & 63; __syncthreads();
            pg8::Gemm g{(const bf16*)(ws + WS_AM), (const bf16*)(ws + WS_W + (size_t)l * W_LAYER + WO_A), S, D, 2 * D}; pg8::SplitK2Order So; So.base.init(S, D, F.G, (int)blockIdx.x);
            pg8::EpiMerge2 E{P8B(ws, 6), P8B(ws, 7), (bf16*)(ws + WS_MRG)};
            pg8::gemm_phase<pg8::EpiMerge2, pg8::SplitK2Order, true, true>(F.lds, g, So, E, F.wave);
            if (BOTH(pb + 6) || rep + 1 < REPS(6)) GRID_BAR(); PROF_MARK(6); }
        if (EN(7) && IN(pb + 7))
#pragma nounroll
        for (int rep = 0; rep < REPS(7); ++rep) { CArgs A = get_args(); unsigned char* ws = A->ws; F.tid = fresh_tid(F.wave); F.lane = F.tid & 63; __syncthreads();
            pg8::Gemm g{(const bf16*)(ws + WS_MRG), (const bf16*)(ws + WS_W + (size_t)l * W_LAYER + WO_OUT), S, D, D}; pg8::StaticOrder So; So.init(S, D, F.G, (int)blockIdx.x); pg8::EpiPlain E{(bf16*)(ws + WS_Y), D};
            pg8::gemm_phase<pg8::EpiPlain, pg8::StaticOrder, true, true>(F.lds, g, So, E, F.wave);
            if (BOTH(pb + 7) || rep + 1 < REPS(7)) GRID_BAR(); PROF_MARK(7); }
        if (EN(8) && IN(pb + 8))
#pragma nounroll
        for (int rep = 0; rep < REPS(8); ++rep) { CArgs A = get_args(); unsigned char* ws = A->ws; F.tid = fresh_tid(F.wave); F.lane = F.tid & 63; __syncthreads(); const float* mod = (const float*)(ws + WS_MOD) + (size_t)l * 6 * D;
            row_phase<true, true, false>(F, (l == 0 || rep == 1) ? (rep == 1 ? (const float*)(ws + WS_T) : A->in[0]) : (const float*)A->out, rep == 1 ? (float*)(ws + WS_T) : A->out, (const bf16*)(ws + WS_Y), mod + 2 * D, A->in[6] + (size_t)l * D, A->in[7] + (size_t)l * D, mod + 4 * D, mod + 3 * D, rep == 1 ? (bf16*)(ws + WS_AM) : (bf16*)(ws + WS_H), nullptr, nullptr, nullptr, nullptr);
            if (BOTH(pb + 8) || rep + 1 < REPS(8)) GRID_BAR(); PROF_MARK(8); }
        if (EN(9) && IN(pb + 9))
#pragma nounroll
        for (int rep = 0; rep < REPS(9); ++rep) { CArgs A = get_args(); unsigned char* ws = A->ws; F.tid = fresh_tid(F.wave); F.lane = F.tid & 63; __syncthreads();
            pg8::Gemm g{(const bf16*)(ws + WS_H), (const bf16*)(ws + WS_W + (size_t)l * W_LAYER + WO_G), S, FF, D}; pg8::StaticOrder So; So.init(S, FF, F.G, (int)blockIdx.x); pg8::EpiPlain E{(bf16*)(ws + WS_G), FF};
            pg8::gemm_phase<pg8::EpiPlain, pg8::StaticOrder, true, true>(F.lds, g, So, E, F.wave);
            if (BOTH(pb + 9) || rep + 1 < REPS(9)) GRID_BAR(); PROF_MARK(9); }
        if (EN(10) && IN(pb + 10))
#pragma nounroll
        for (int rep = 0; rep < REPS(10); ++rep) { CArgs A = get_args(); unsigned char* ws = A->ws; F.tid = fresh_tid(F.wave); F.lane = F.tid & 63; __syncthreads();
            pg8::Gemm g{(const bf16*)(ws + WS_H), (const bf16*)(ws + WS_W + (size_t)l * W_LAYER + WO_U), S, FF, D}; pg8::StaticOrder So; So.init(S, FF, F.G, (int)blockIdx.x);
            pg8::EpiUp E{(const bf16*)(ws + WS_G), (bf16*)(ws + WS_AFF), FF, A->in[22] + (size_t)l * 3 * FF, A->in[23] + (size_t)l * FF};
            pg8::gemm_phase<pg8::EpiUp, pg8::StaticOrder, true, true>(F.lds, g, So, E, F.wave);
            if (BOTH(pb + 10) || rep + 1 < REPS(10)) GRID_BAR(); PROF_MARK(10); }
        if (EN(11) && IN(pb + 11))
#pragma nounroll
        for (int rep = 0; rep < REPS(11); ++rep) { CArgs A = get_args(); unsigned char* ws = A->ws; F.tid = fresh_tid(F.wave); F.lane = F.tid & 63; __syncthreads();
            pg8::Gemm g{(const bf16*)(ws + WS_AFF), (const bf16*)(ws + WS_W + (size_t)l * W_LAYER + WO_D), S, D, FF}; pg8::StaticOrder So; So.init(S, D, F.G, (int)blockIdx.x); pg8::EpiPlain E{(bf16*)(ws + WS_Y), D};
            pg8::gemm_phase<pg8::EpiPlain, pg8::StaticOrder, true, true>(F.lds, g, So, E, F.wave);
            if (BOTH(pb + 11) || rep + 1 < REPS(11)) GRID_BAR(); PROF_MARK(11); }
        if (EN(12) && IN(pb + 12))
#pragma nounroll
        for (int rep = 0; rep < REPS(12); ++rep) { CArgs A = get_args(); unsigned char* ws = A->ws; F.tid = fresh_tid(F.wave); F.lane = F.tid & 63; __syncthreads(); const float* mod = (const float*)(ws + WS_MOD) + (size_t)l * 6 * D;
            if (l + 1 < DEPTH) { const float* modn = mod + 6 * D;
                row_phase<true, true, true>(F, A->out, A->out, (const bf16*)(ws + WS_Y), mod + 5 * D, A->in[8] + (size_t)l * D, A->in[5] + (size_t)(l + 1) * D, modn + D, modn, (bf16*)(ws + WS_H),
                                            (const float*)(ws + WS_WG) + (size_t)(l + 1) * 8 * D, A->in[12] + 4 * (l + 1), A->in[13] + 4 * (l + 1), (float*)(ws + WS_GATES)); }
            else row_phase<true, false, false>(F, A->out, A->out, (const bf16*)(ws + WS_Y), mod + 5 * D, A->in[8] + (size_t)l * D, nullptr, nullptr, nullptr, nullptr, nullptr, nullptr, nullptr, nullptr);
            if (BOTH(pb + 12) || rep + 1 < REPS(12)) GRID_BAR(); PROF_MARK(12); }
    }
#ifdef PROF_K1
    { gu32* pw = F.ctl + 2048;
      if (blockIdx.x == 0 && F.tid == 0) { unsigned long long tot = 0; for (int k = 0; k < 15; ++k) tot += pacc[k];
          const float p1 = 100.0f * (float)pacc[PROF_K1] / (float)tot, p2 = 100.0f * (float)pacc[PROF_K2] / (float)tot;
          __hip_atomic_store(pw, __float_as_uint(100.0f + 10.0f * floorf(p1 + PROF_SHIFT)), RLX_AGENT); __hip_atomic_store(pw + 1, __float_as_uint(1.0f + 0.05f * floorf(p2 + PROF_SHIFT)), RLX_AGENT); }
      GRID_BAR();
      const float Acode = __uint_as_float(__hip_atomic_load(pw, RLX_AGENT)), bsc = 1.0f + __uint_as_float(__hip_atomic_load(pw + 1, RLX_AGENT));
      float* o = get_args()->out; const size_t gt = (size_t)blockIdx.x * 512 + F.tid;
      for (size_t i = gt; i < (size_t)S * D; i += (size_t)F.G * 512) o[i] = (i == 0) ? Acode : o[i] * bsc; }
#endif
#ifdef TPROBE_WG
    if ((int)blockIdx.x == TPROBE_WG && F.tid == 0) { const unsigned d_ = __hip_atomic_load(F.ctl + 2040, RLX_AGENT); const unsigned long long t0_ = rt(); while (rt() - t0_ < 4ull * d_) __builtin_amdgcn_s_sleep(8); }
#endif
#undef IN
#undef BOTH
}

#ifdef DBG_CHK
__global__ void chk_kernel(const unsigned* ws, size_t nws, const unsigned* out, size_t nout, unsigned long long* slot) {
    unsigned long long acc = 0; const size_t gt = (size_t)blockIdx.x * blockDim.x + threadIdx.x, NT = (size_t)gridDim.x * blockDim.x;
    for (size_t i = gt; i < nws; i += NT) acc += (unsigned long long)ws[i] * (unsigned long long)((i & 1023) * 2 + 1);
    for (size_t i = gt; i < nout; i += NT) acc += (unsigned long long)out[i] * (unsigned long long)((i & 1023) * 2 + 1);
    for (int o = 32; o > 0; o >>= 1) acc += __shfl_xor(acc, o);
    if ((threadIdx.x & 63) == 0) atomicAdd(slot, acc);
}
__global__ void chk_final(const unsigned long long* chk, int nph, float* out, size_t nout) {
    __shared__ int code;
    if (threadIdx.x == 0) { int c = 99; for (int p = nph - 1; p >= 0; --p) if (chk[p] != chk[64 + p]) c = p + 1; code = c; }
    __syncthreads();
    const size_t gt = (size_t)blockIdx.x * blockDim.x + threadIdx.x, NT = (size_t)gridDim.x * blockDim.x;
    for (size_t i = gt; i < nout; i += NT) out[i] = (i == 0) ? 1000.0f * (float)code : 0.0f;
}
#endif
extern "C" void kernel_launch(void* const* d_in, const int* in_sizes, int n_in, void* d_out, int out_size, void* d_ws, size_t ws_size, hipStream_t stream) {
    static int grid = 0;
    if (grid == 0) {
        if (n_in != 25 || out_size != S * D || ws_size < WS_END) { fprintf(stderr, "kernel_launch: unexpected shapes (n_in %d, out %d, ws %zu); nothing launched\n", n_in, out_size, ws_size); grid = -1; return; }
        int dev = 0, cus = 0, per_cu = 0;
        if (hipGetDevice(&dev) != hipSuccess || hipDeviceGetAttribute(&cus, hipDeviceAttributeMultiprocessorCount, dev) != hipSuccess) { grid = -1; return; }
        if (hipFuncSetAttribute((const void*)trunk_fwd, hipFuncAttributeMaxDynamicSharedMemorySize, LDS_BYTES) != hipSuccess) { fprintf(stderr, "kernel_launch: hipFuncSetAttribute failed\n"); grid = -1; return; }
        if (hipOccupancyMaxActiveBlocksPerMultiprocessor(&per_cu, (const void*)trunk_fwd, NWAVES * 64, LDS_BYTES) != hipSuccess || per_cu < 1) fprintf(stderr, "kernel_launch: occupancy query reports %d\n", per_cu);
        (void)hipGetLastError();
        grid = cus;
        if (grid != 256) fprintf(stderr, "kernel_launch: %d CUs (built for 256)\n", grid);
    }
    if (grid < 0) return;
    if (hipMemsetAsync((char*)d_ws + WS_CTL, 0, CTL_ZERO_BYTES, stream) != hipSuccess) return;
    Args a{};
    for (int i = 0; i < 25; ++i) a.in[i] = (const float*)d_in[i];
    a.out = (float*)d_out; a.ws = (unsigned char*)d_ws;
    for (int j = 0; j < 8; ++j) a.inv[j] = pow(500000.0, -(double)j / 8.0);
    a.mode = 15;
#if MK_ONE_LAUNCH
    a.ph_lo = 0; a.ph_hi = NPH;
    hipLaunchKernelGGL(trunk_fwd, dim3(grid), dim3(NWAVES * 64), LDS_BYTES, stream, a);
#else
#ifdef DBG_CHK
    unsigned long long* chk = (unsigned long long*)((char*)d_ws + 65536);
    for (int run = 0; run < 2; ++run) {
    (void)hipMemsetAsync((char*)d_ws + CTL_ZERO_BYTES, 0xAA, WS_END - CTL_ZERO_BYTES, stream);
    (void)hipMemsetAsync(d_out, 0xAA, (size_t)S * D * 4, stream);
#endif
    for (int p = 0; p < NPH; ++p) {
        if (p >= 2 + NPH_LAYER && ((p - 2) % NPH_LAYER) == 0) continue;
#ifdef DBG_CHK
        if (p >= 2 + DBG_CHK * NPH_LAYER) continue;
#endif
        a.ph_lo = p; a.ph_hi = p + 1;
        hipLaunchKernelGGL(trunk_fwd, dim3(grid), dim3(NWAVES * 64), LDS_BYTES, stream, a);
#ifdef DBG_CHK
        hipLaunchKernelGGL(chk_kernel, dim3(2048), dim3(256), 0, stream, (const unsigned*)((char*)d_ws + CTL_ZERO_BYTES), (size_t)(WS_END - CTL_ZERO_BYTES) / 4, (const unsigned*)d_out, (size_t)S * D, chk + run * 64 + p);
#endif
    }
#ifdef DBG_CHK
    }
    hipLaunchKernelGGL(chk_final, dim3(1024), dim3(256), 0, stream, (const unsigned long long*)chk, 2 + DBG_CHK * NPH_LAYER, (float*)d_out, (size_t)S * D);
#endif
#endif
    const hipError_t le = hipPeekAtLastError();
    if (le != hipSuccess) fprintf(stderr, "kernel_launch: launch failed: %s\n", hipGetErrorName(le));
}
```

```cpp
#include <hip/hip_runtime.h>
#include <hip/hip_bf16.h>
#include <cstdio>
#include <cstdint>
#include <cmath>
__device__ __forceinline__ int fresh_tid(int wave) { int l_; asm volatile("v_mbcnt_lo_u32_b32 %0, -1, 0\n\tv_mbcnt_hi_u32_b32 %0, -1, %0" : "=v"(l_)); return l_ + 64 * wave; }
namespace pg8 {
#define PG8_LAS __attribute__((address_space(3)))
typedef unsigned short bf16_t;
typedef short bf16x8 __attribute__((ext_vector_type(8)));
typedef float f32x4 __attribute__((ext_vector_type(4)));
typedef unsigned u32x4 __attribute__((ext_vector_type(4)));
constexpr int BM = 256, BK = 64, HALF = 128, HTB = HALF * BK * 2  , STAGE_BYTES = 8 * HTB, NXCD = 8, WGM = 8;

__host__ __device__ __forceinline__ int lds_byte(int r, int c) { const int st = (r >> 4) * 2 + (c >> 5), rr = r & 15, cc = c & 31, ob = rr * 64 + cc * 2; return st * 1024 + (ob ^ (((ob >> 9) & 1) << 5)); }
__host__ __device__ __forceinline__ void stage_rc(int b, int& R, int& C) { const int st = b / 1024, sb = b % 1024, swz = sb ^ (((sb >> 9) & 1) << 5); R = (st >> 1) * 16 + swz / 64; C = (st & 1) * 32 + (swz % 64) / 2; }
__host__ __device__ __forceinline__ int perm32(int rho) { const int n = rho >> 4, i = rho & 15; return 8 * (i >> 2) + 4 * n + (i & 3); }

struct Unit { int pm, pn, kh; };
struct Gemm { const bf16_t* A; const bf16_t* Bt; int M, N, K; };

struct StaticOrder {
    int nM, nN, nwg, G, c;
    __host__ __device__ void init(int M, int N, int G_, int c_) { nM = M / BM; nN = N / BM; nwg = nM * nN; G = G_; c = c_; }
    __host__ __device__ bool next(int i, Unit& u) const {
        const long L = (long)i * G + c; if (L >= nwg) return false;
        int wgid = (int)L; { const int q = nwg / NXCD, r = nwg % NXCD, xcd = wgid % NXCD, off = wgid / NXCD; wgid = (xcd < r ? xcd * (q + 1) : r * (q + 1) + (xcd - r) * q) + off; }
        const int nig = WGM * nN, gid = wgid / nig, fm = gid * WGM, gsz = (nM - fm) < WGM ? (nM - fm) : WGM;
        u.pm = fm + ((wgid % nig) % gsz); u.pn = (wgid % nig) / gsz; u.kh = 0; return true;
    }
    __device__ __forceinline__ void a_ready(const Unit&) const {}
    __device__ __forceinline__ void done(const Unit&) const {}
};

struct SplitK2Order { StaticOrder base;
    __device__ __forceinline__ bool next(int i, Unit& u) const { if (!base.next(i >> 1, u)) return false; u.kh = i & 1; return true; }
    __device__ __forceinline__ void a_ready(const Unit&) const {}
    __device__ __forceinline__ void done(const Unit&) const {} };

typedef float cvt_f32x2_t __attribute__((ext_vector_type(2))); typedef __bf16 cvt_bf16x2_t __attribute__((ext_vector_type(2)));
__device__ __forceinline__ unsigned cvt_pk_bf16(float lo, float hi) { cvt_f32x2_t v = {lo, hi}; cvt_bf16x2_t b = __builtin_convertvector(v, cvt_bf16x2_t); return __builtin_bit_cast(unsigned, b); }
typedef float f32x2 __attribute__((ext_vector_type(2)));
__device__ __forceinline__ float sigm(float x) { return __builtin_amdgcn_rcpf(1.0f + __expf(-x)); }
__device__ __forceinline__ float bf_lo(unsigned u) { return __builtin_bit_cast(float, u << 16); }
__device__ __forceinline__ float bf_hi(unsigned u) { return __builtin_bit_cast(float, u & 0xffff0000u); }
__device__ __forceinline__ void unpack8(const u32x4 w, float (&f)[8]) { f[0] = bf_lo(w.x); f[1] = bf_hi(w.x); f[2] = bf_lo(w.y); f[3] = bf_hi(w.y); f[4] = bf_lo(w.z); f[5] = bf_hi(w.z); f[6] = bf_lo(w.w); f[7] = bf_hi(w.w); }
__device__ __forceinline__ u32x4 pack8(const float (&f)[8]) { u32x4 w; w.x = cvt_pk_bf16(f[0], f[1]); w.y = cvt_pk_bf16(f[2], f[3]); w.z = cvt_pk_bf16(f[4], f[5]); w.w = cvt_pk_bf16(f[6], f[7]); return w; }

struct EpiIn {
    static constexpr bool PERM = true, AFTER_DRAIN = false, HAS_MID = false;
    bf16_t* base; size_t split_stride; const float* ropeC; const float* ropeS; float qscale;
    __device__ __forceinline__ void operator()(const f32x4 (&acc)[2][2][4][2], const Unit& u, int wr, int wc, int fr, int fq) const {
        const int t = u.pn >> 3; bf16_t* O = base + (size_t)t * split_stride;
        const int row0 = u.pm * BM + wr * 64 + fr, col0 = (u.pn & 7) * BM + wc * 32 + 8 * fq;
        const bool sg = (t == 2) || (t >= 6), rope = (t == 3 || t == 4) && ((wc & 1) == 0) && (fq < 2);
        const float sc = (t == 3) ? qscale : 1.f;
#pragma unroll
        for (int ai = 0; ai < 2; ++ai)
#pragma unroll
            for (int m = 0; m < 4; ++m) { const int row = row0 + ai * HALF + m * 16; bf16_t* rowp = O + (size_t)row * 2048 + col0;
                f32x4 cs = (f32x4){1.f, 1.f, 1.f, 1.f}, sn = (f32x4){0.f, 0.f, 0.f, 0.f};
                if (rope) { cs = *(const f32x4*)(ropeC + (size_t)row * 8 + 4 * fq); sn = *(const f32x4*)(ropeS + (size_t)row * 8 + 4 * fq); }
#pragma unroll
                for (int bj = 0; bj < 2; ++bj) { f32x4 v0 = acc[ai][bj][m][0], v1 = acc[ai][bj][m][1];
                    if (sg) { v0 = (f32x4){sigm(v0[0]), sigm(v0[1]), sigm(v0[2]), sigm(v0[3])}; v1 = (f32x4){sigm(v1[0]), sigm(v1[1]), sigm(v1[2]), sigm(v1[3])}; }
                    if (rope) { const f32x4 a = v0, b = v1;
                        v0[0] = a[0] * cs[0] - a[1] * sn[0]; v0[1] = a[1] * cs[0] + a[0] * sn[0]; v0[2] = a[2] * cs[1] - a[3] * sn[1]; v0[3] = a[3] * cs[1] + a[2] * sn[1];
                        v1[0] = b[0] * cs[2] - b[1] * sn[2]; v1[1] = b[1] * cs[2] + b[0] * sn[2]; v1[2] = b[2] * cs[3] - b[3] * sn[3]; v1[3] = b[3] * cs[3] + b[2] * sn[3]; }
                    v0 = v0 * sc; v1 = v1 * sc; u32x4 w; w.x = cvt_pk_bf16(v0[0], v0[1]); w.y = cvt_pk_bf16(v0[2], v0[3]); w.z = cvt_pk_bf16(v1[0], v1[1]); w.w = cvt_pk_bf16(v1[2], v1[3]);
                    *(u32x4*)(rowp + bj * HALF) = w; } }
    }
};
struct EpiPlain {
    static constexpr bool PERM = true, AFTER_DRAIN = false, HAS_MID = false;
    bf16_t* O; int ldc;
    __device__ __forceinline__ void operator()(const f32x4 (&acc)[2][2][4][2], const Unit& u, int wr, int wc, int fr, int fq) const {
        const int row0 = u.pm * BM + wr * 64 + fr, col0 = u.pn * BM + wc * 32 + 8 * fq;
#pragma unroll
        for (int ai = 0; ai < 2; ++ai)
#pragma unroll
            for (int m = 0; m < 4; ++m) { bf16_t* rowp = O + (size_t)(row0 + ai * HALF + m * 16) * ldc + col0;
#pragma unroll
                for (int bj = 0; bj < 2; ++bj) { const f32x4 v0 = acc[ai][bj][m][0], v1 = acc[ai][bj][m][1]; u32x4 w; w.x = cvt_pk_bf16(v0[0], v0[1]); w.y = cvt_pk_bf16(v0[2], v0[3]); w.z = cvt_pk_bf16(v1[0], v1[1]); w.w = cvt_pk_bf16(v1[2], v1[3]);
                    *(u32x4*)(rowp + bj * HALF) = w; } }
    }
};
struct EpiUp {
    static constexpr bool PERM = true, AFTER_DRAIN = false, HAS_MID = false;
    const bf16_t* G; bf16_t* O; int ldc; const float* cw; const float* cb;
    __device__ __forceinline__ void operator()(const f32x4 (&acc)[2][2][4][2], const Unit& u, int wr, int wc, int fr, int fq) const {
        const int row0 = u.pm * BM + wr * 64 + fr, col0 = u.pn * BM + wc * 32 + 8 * fq;
#pragma unroll
        for (int bj = 0; bj < 2; ++bj) { const int c = col0 + bj * HALF;
            float w0[8], w1[8], w2[8], bb[8];
            { const f32x4 a = *(const f32x4*)(cw + c), b = *(const f32x4*)(cw + c + 4); w0[0] = a[0]; w0[1] = a[1]; w0[2] = a[2]; w0[3] = a[3]; w0[4] = b[0]; w0[5] = b[1]; w0[6] = b[2]; w0[7] = b[3]; }
            { const f32x4 a = *(const f32x4*)(cw + ldc + c), b = *(const f32x4*)(cw + ldc + c + 4); w1[0] = a[0]; w1[1] = a[1]; w1[2] = a[2]; w1[3] = a[3]; w1[4] = b[0]; w1[5] = b[1]; w1[6] = b[2]; w1[7] = b[3]; }
            { const f32x4 a = *(const f32x4*)(cw + 2 * ldc + c), b = *(const f32x4*)(cw + 2 * ldc + c + 4); w2[0] = a[0]; w2[1] = a[1]; w2[2] = a[2]; w2[3] = a[3]; w2[4] = b[0]; w2[5] = b[1]; w2[6] = b[2]; w2[7] = b[3]; }
            { const f32x4 a = *(const f32x4*)(cb + c), b = *(const f32x4*)(cb + c + 4); bb[0] = a[0]; bb[1] = a[1]; bb[2] = a[2]; bb[3] = a[3]; bb[4] = b[0]; bb[5] = b[1]; bb[6] = b[2]; bb[7] = b[3]; }
#pragma unroll
            for (int ai = 0; ai < 2; ++ai)
#pragma unroll
                for (int m = 0; m < 4; ++m) { const int row = row0 + ai * HALF + m * 16; const bf16_t* gp = G + (size_t)row * ldc + c;
                    const u32x4 z = (u32x4){0u, 0u, 0u, 0u};
                    const u32x4 r0 = *(const u32x4*)gp, r1 = row >= 1 ? *(const u32x4*)(gp - ldc) : z, r2 = row >= 2 ? *(const u32x4*)(gp - 2 * ldc) : z;
                    float g0[8], g1[8], g2[8], o[8]; unpack8(r0, g0); unpack8(r1, g1); unpack8(r2, g2);
                    const f32x4 v0 = acc[ai][bj][m][0], v1 = acc[ai][bj][m][1]; const float av[8] = {v0[0], v0[1], v0[2], v0[3], v1[0], v1[1], v1[2], v1[3]};
#pragma unroll
                    for (int e = 0; e < 8; ++e) { const float gc = bb[e] + w0[e] * g2[e] + w1[e] * g1[e] + w2[e] * g0[e]; o[e] = gc * sigm(gc) * av[e]; }
                    *(u32x4*)(O + (size_t)row * ldc + c) = pack8(o); } }
    }
};
struct EpiMerge2 {
    static constexpr bool PERM = true, AFTER_DRAIN = false, HAS_MID = true;
    const bf16_t* Ga; const bf16_t* Gb; bf16_t* O;
    __device__ __forceinline__ void mid(f32x4 (&acc)[2][2][4][2], const Unit& u, int wr, int wc, int fr, int fq) const {
        const int row0 = u.pm * BM + wr * 64 + fr, col0 = u.pn * BM + wc * 32 + 8 * fq;
#pragma unroll
        for (int ai = 0; ai < 2; ++ai)
#pragma unroll
            for (int m = 0; m < 4; ++m) { const size_t off = (size_t)(row0 + ai * HALF + m * 16) * 2048 + col0;
#pragma unroll
                for (int bj = 0; bj < 2; ++bj) { float ga[8], gb[8]; unpack8(*(const u32x4*)(Ga + off + bj * HALF), ga); unpack8(*(const u32x4*)(Gb + off + bj * HALF), gb);
                    f32x4 r0 = (f32x4){gb[0] * __builtin_amdgcn_rcpf(ga[0]), gb[1] * __builtin_amdgcn_rcpf(ga[1]), gb[2] * __builtin_amdgcn_rcpf(ga[2]), gb[3] * __builtin_amdgcn_rcpf(ga[3])};
                    f32x4 r1 = (f32x4){gb[4] * __builtin_amdgcn_rcpf(ga[4]), gb[5] * __builtin_amdgcn_rcpf(ga[5]), gb[6] * __builtin_amdgcn_rcpf(ga[6]), gb[7] * __builtin_amdgcn_rcpf(ga[7])};
                    acc[ai][bj][m][0] = acc[ai][bj][m][0] * r0; acc[ai][bj][m][1] = acc[ai][bj][m][1] * r1; }
                }
    }
    __device__ __forceinline__ void operator()(const f32x4 (&acc)[2][2][4][2], const Unit& u, int wr, int wc, int fr, int fq) const {
        const int row0 = u.pm * BM + wr * 64 + fr, col0 = u.pn * BM + wc * 32 + 8 * fq;
#pragma unroll
        for (int ai = 0; ai < 2; ++ai)
#pragma unroll
            for (int m = 0; m < 4; ++m) { const size_t off = (size_t)(row0 + ai * HALF + m * 16) * 2048 + col0;
#pragma unroll
                for (int bj = 0; bj < 2; ++bj) { float g[8]; unpack8(*(const u32x4*)(Ga + off + bj * HALF), g); const f32x4 v0 = acc[ai][bj][m][0], v1 = acc[ai][bj][m][1];
                    float o[8] = {v0[0] * g[0], v0[1] * g[1], v0[2] * g[2], v0[3] * g[3], v1[0] * g[4], v1[1] * g[5], v1[2] * g[6], v1[3] * g[7]};
                    *(u32x4*)(O + off + bj * HALF) = pack8(o); } }
    }
};
struct EpiF32 {
    static constexpr bool PERM = false, AFTER_DRAIN = false, HAS_MID = false;
    float* Y; int ldc;
    __device__ __forceinline__ void operator()(const f32x4 (&acc)[2][2][4][2], const Unit& u, int wr, int wc, int fr, int fq) const {
        const int row0 = u.pm * BM + wr * 64 + fr, col0 = u.pn * BM + wc * 32 + 4 * fq;
#pragma unroll
        for (int ai = 0; ai < 2; ++ai)
#pragma unroll
            for (int m = 0; m < 4; ++m) { float* rowp = Y + (size_t)(row0 + ai * HALF + m * 16) * ldc + col0;
#pragma unroll
                for (int bj = 0; bj < 2; ++bj)
#pragma unroll
                    for (int n = 0; n < 2; ++n) *(f32x4*)(rowp + bj * HALF + n * 16) = acc[ai][bj][m][n]; }
    }
};

template <class Epi, class Sched, bool ALIGN_EPI = false, bool SP2 = false>
__device__ __forceinline__ void gemm_phase(PG8_LAS unsigned char* lds, const Gemm g, const Sched& S, const Epi& E, const int wave_id) {
    const int tid = fresh_tid(wave_id), wid = __builtin_amdgcn_readfirstlane(tid >> 6), lane = tid & 63, wr = wid >> 2, wc = wid & 3, fr = lane & 15, fq = lane >> 4;
    const int K = g.K, nt = (Epi::HAS_MID ? K / 2 : K) / BK;
    unsigned voffA[2], voffB[2];
#pragma unroll
    for (int i = 0; i < 2; ++i) { int R, C; stage_rc(tid * 16 + i * 8192, R, C); const int Rb = Epi::PERM ? ((R & ~31) + perm32(R & 31)) : R;
        voffA[i] = (unsigned)(R * K + C) * 2u; voffB[i] = (unsigned)(Rb * K + C) * 2u; }
    const size_t kstep = (size_t)(BK * 2);
    const size_t hstep = (size_t)HALF * K * 2;
    const size_t tstep = 2 * hstep;
    const unsigned ldsw = (unsigned)wid * 1024u;
    const int aoff = lds_byte(wr * 64 + fr, fq * 8), boff = lds_byte(wc * 32 + fr, fq * 8);
#define PG8_SA(b, h) (((b) * 2 + (h)) * HTB)
#define PG8_SB(b, h) ((4 + (b) * 2 + (h)) * HTB)
#define PG8_STAGE(bufoff, gbase, voff) do { _Pragma("unroll") for (int _i = 0; _i < 2; ++_i) \
        __builtin_amdgcn_global_load_lds((const unsigned*)((const char*)(gbase) + (voff)[_i]), (PG8_LAS unsigned*)(lds + (bufoff) + ldsw + _i * 8192), 16, 0, 0); } while (0)
#define PG8_LDA(dst, b, h) do { _Pragma("unroll") for (int m = 0; m < 4; ++m) _Pragma("unroll") for (int k = 0; k < 2; ++k) dst[m][k] = *(const PG8_LAS bf16x8*)(lds + PG8_SA(b, h) + aoff + m * 2048 + k * 1024); } while (0)
#define PG8_LDB(dst, b, h) do { _Pragma("unroll") for (int n = 0; n < 2; ++n) _Pragma("unroll") for (int k = 0; k < 2; ++k) dst[n][k] = *(const PG8_LAS bf16x8*)(lds + PG8_SB(b, h) + boff + n * 2048 + k * 1024); } while (0)
#define PG8_MMA(ai, bj, At, Bt) do { __builtin_amdgcn_s_setprio(1); _Pragma("unroll") for (int m = 0; m < 4; ++m) _Pragma("unroll") for (int n = 0; n < 2; ++n) _Pragma("unroll") for (int k = 0; k < 2; ++k) \
        acc[ai][bj][m][n] = __builtin_amdgcn_mfma_f32_16x16x32_bf16(Bt[n][k], At[m][k], acc[ai][bj][m][n], 0, 0, 0); __builtin_amdgcn_s_setprio(0); } while (0)
#define PG8_WAIT_V(n) asm volatile("s_waitcnt vmcnt(" #n ")" ::: "memory")
#define PG8_WAIT_L(n) asm volatile("s_waitcnt lgkmcnt(" #n ")" ::: "memory")
#define PG8_BAR __builtin_amdgcn_s_barrier()
#define PG8_SCHED __builtin_amdgcn_sched_barrier(0)
    Unit cur, nxt; int ui = 0;
    if (!S.next(0, cur)) return;
    f32x4 acc[2][2][4][2];
#pragma unroll
    for (int a = 0; a < 2; ++a)
#pragma unroll
        for (int b = 0; b < 2; ++b)
#pragma unroll
            for (int m = 0; m < 4; ++m)
#pragma unroll
                for (int n = 0; n < 2; ++n) acc[a][b][m][n] = (f32x4){0.f, 0.f, 0.f, 0.f};
    bf16x8 At[4][2], B0[2][2], B1[2][2];
    const char* cA = (const char*)g.A + (size_t)cur.pm * tstep + (size_t)cur.kh * K; const char* cB = (const char*)g.Bt + (size_t)cur.pn * tstep + (size_t)cur.kh * K;
    S.a_ready(cur);
    if constexpr (SP2) {
        PG8_STAGE(PG8_SB(0, 0), cB, voffB); PG8_STAGE(PG8_SB(0, 1), cB + hstep, voffB); PG8_STAGE(PG8_SA(0, 0), cA, voffA); PG8_STAGE(PG8_SA(0, 1), cA + hstep, voffA);
        if (wr == 1) PG8_BAR;
        PG8_WAIT_V(2); PG8_BAR;
        PG8_STAGE(PG8_SB(1, 0), cB + kstep, voffB); PG8_STAGE(PG8_SA(1, 0), cA + kstep, voffA); PG8_STAGE(PG8_SB(1, 1), cB + hstep + kstep, voffB);
        PG8_WAIT_V(6); PG8_BAR;
    } else {
        PG8_STAGE(PG8_SB(0, 0), cB, voffB); PG8_STAGE(PG8_SA(0, 0), cA, voffA); PG8_STAGE(PG8_SB(0, 1), cB + hstep, voffB); PG8_STAGE(PG8_SA(0, 1), cA + hstep, voffA);
        if (wr == 1) PG8_BAR;
        PG8_WAIT_V(4); PG8_BAR;
        PG8_STAGE(PG8_SB(1, 0), cB + kstep, voffB); PG8_STAGE(PG8_SA(1, 0), cA + kstep, voffA); PG8_STAGE(PG8_SB(1, 1), cB + hstep + kstep, voffB);
        PG8_WAIT_V(6); PG8_BAR;
    }
    for (;;) {
        const bool has_next = S.next(ui + 1, nxt);
        const char* nA = has_next ? (const char*)g.A + (size_t)nxt.pm * tstep + (size_t)nxt.kh * K : cA; const char* nB = has_next ? (const char*)g.Bt + (size_t)nxt.pn * tstep + (size_t)nxt.kh * K : cB;
        for (int t = 0; t < nt; t += 2) {
            const bool last = (t == nt - 2);
            const char* a1 = cA + (size_t)(t + 1) * kstep;
            const char* a2 = last ? nA : cA + (size_t)(t + 2) * kstep; const char* b2 = last ? nB : cB + (size_t)(t + 2) * kstep;
            const char* a3 = a2 + kstep; const char* b3 = b2 + kstep;
            if (last && has_next) S.a_ready(nxt);
            if constexpr (SP2) {
            PG8_LDB(B0, 0, 0); PG8_LDB(B1, 0, 1); PG8_SCHED; PG8_LDA(At, 0, 0); PG8_STAGE(PG8_SA(1, 1), a1 + hstep, voffA);
            PG8_WAIT_V(8); PG8_WAIT_L(0); PG8_BAR; PG8_MMA(0, 0, At, B0); PG8_MMA(0, 1, At, B1); PG8_BAR; PG8_SCHED;
            PG8_LDA(At, 0, 1); PG8_STAGE(PG8_SB(0, 0), b2, voffB); PG8_STAGE(PG8_SB(0, 1), b2 + hstep, voffB); PG8_STAGE(PG8_SA(0, 0), a2, voffA);
            PG8_WAIT_V(8); PG8_WAIT_L(0); PG8_BAR; PG8_MMA(1, 0, At, B0); PG8_MMA(1, 1, At, B1); PG8_BAR; PG8_SCHED;
            PG8_LDB(B0, 1, 0); PG8_LDB(B1, 1, 1); PG8_SCHED; PG8_LDA(At, 1, 0); PG8_STAGE(PG8_SA(0, 1), a2 + hstep, voffA);
            PG8_WAIT_V(8); PG8_WAIT_L(0); PG8_BAR; PG8_MMA(0, 0, At, B0); PG8_MMA(0, 1, At, B1); PG8_BAR; PG8_SCHED;
            PG8_LDA(At, 1, 1); PG8_STAGE(PG8_SB(1, 0), b3, voffB); PG8_STAGE(PG8_SB(1, 1), b3 + hstep, voffB); PG8_STAGE(PG8_SA(1, 0), a3, voffA);
            PG8_WAIT_V(8); PG8_WAIT_L(0); PG8_BAR; PG8_MMA(1, 0, At, B0); PG8_MMA(1, 1, At, B1); PG8_BAR; PG8_SCHED;
            } else {
            PG8_LDB(B0, 0, 0); PG8_SCHED; PG8_LDA(At, 0, 0); PG8_STAGE(PG8_SA(1, 1), a1 + hstep, voffA);
            PG8_WAIT_L(8); PG8_BAR; PG8_WAIT_L(0); PG8_MMA(0, 0, At, B0); PG8_BAR; PG8_SCHED;
            PG8_LDB(B1, 0, 1); PG8_STAGE(PG8_SB(0, 0), b2, voffB);
            PG8_BAR; PG8_WAIT_L(0); PG8_MMA(0, 1, At, B1); PG8_BAR;
            PG8_LDA(At, 0, 1); PG8_STAGE(PG8_SA(0, 0), a2, voffA);
            PG8_BAR; PG8_WAIT_L(0); PG8_MMA(1, 0, At, B0); PG8_BAR; PG8_SCHED;
            PG8_STAGE(PG8_SB(0, 1), b2 + hstep, voffB);
            PG8_WAIT_V(6); PG8_BAR; PG8_MMA(1, 1, At, B1); PG8_BAR;
            PG8_LDB(B0, 1, 0); PG8_SCHED; PG8_LDA(At, 1, 0); PG8_STAGE(PG8_SA(0, 1), a2 + hstep, voffA);
            PG8_WAIT_L(8); PG8_BAR; PG8_WAIT_L(0); PG8_MMA(0, 0, At, B0); PG8_BAR; PG8_SCHED;
            PG8_LDB(B1, 1, 1); PG8_STAGE(PG8_SB(1, 0), b3, voffB);
            PG8_BAR; PG8_WAIT_L(0); PG8_MMA(0, 1, At, B1); PG8_BAR;
            PG8_LDA(At, 1, 1); PG8_STAGE(PG8_SA(1, 0), a3, voffA);
            PG8_BAR; PG8_WAIT_L(0); PG8_MMA(1, 0, At, B0); PG8_BAR; PG8_SCHED;
            PG8_STAGE(PG8_SB(1, 1), b3 + hstep, voffB);
            PG8_WAIT_V(6); PG8_BAR; PG8_MMA(1, 1, At, B1); PG8_BAR;
            }
        }
        if constexpr (ALIGN_EPI) { if (wr == 0) PG8_BAR; }
        bool keep = false;
        if constexpr (Epi::HAS_MID) { keep = (cur.kh == 0); if (keep) E.mid(acc, cur, wr, wc, fr, fq); else E(acc, cur, wr, wc, fr, fq); S.done(cur); }
        else if constexpr (!Epi::AFTER_DRAIN) { E(acc, cur, wr, wc, fr, fq); S.done(cur); }
        if (!has_next) break;
        if (!keep)
#pragma unroll
        for (int a = 0; a < 2; ++a)
#pragma unroll
            for (int b = 0; b < 2; ++b)
#pragma unroll
                for (int m = 0; m < 4; ++m)
#pragma unroll
                    for (int n = 0; n < 2; ++n) acc[a][b][m][n] = (f32x4){0.f, 0.f, 0.f, 0.f};
        cur = nxt; cA = nA; cB = nB; ++ui;
        if constexpr (ALIGN_EPI) { if (wr == 1) PG8_BAR; }
    }
    PG8_WAIT_V(0);
    if constexpr (!ALIGN_EPI) { if (wr == 0) PG8_BAR; }
    PG8_BAR;
    if constexpr (Epi::AFTER_DRAIN) { E.fused(acc, cur, wr, wc, fr, fq, lds, wid, lane); S.done(cur); }
#undef PG8_SA
#undef PG8_SB
#undef PG8_STAGE
#undef PG8_LDA
#undef PG8_LDB
#undef PG8_MMA
#undef PG8_WAIT_V
#undef PG8_WAIT_L
#undef PG8_BAR
#undef PG8_SCHED
}
}
namespace attn_body {
using bf16=__hip_bfloat16;
using bf16x8=__attribute__((ext_vector_type(8)))short;
using s16x4=__attribute__((ext_vector_type(4)))short;
using f32x16=__attribute__((ext_vector_type(16)))float;
using u32x4=__attribute__((ext_vector_type(4)))unsigned;
constexpr int SEQ=8192,D=64,DM=2048;
constexpr int NW=8,QBLK=32,QB=QBLK*NW,KVBLK=64,NQB=SEQ/QB;
constexpr int ATTN_PITCH=DM, ATTN_UNIT_ROWS=QB;
__device__ __forceinline__ int crow(int r,int hi){return (r&3)+8*(r>>2)+4*hi;}
#define SBAR() __builtin_amdgcn_sched_barrier(0)
__device__ __forceinline__ void cmask(f32x16&p0,f32x16&p1,int jb,int wid){
  const float NEG=-INFINITY;
  if(jb>(wid>>1)){
    #pragma unroll
    for(int r=0;r<16;++r){p0[r]=NEG;p1[r]=NEG;}
  }
}

constexpr int NSLOT=3, SLOTB=8192;
constexpr int LDS_K=0, LDS_V=NSLOT*SLOTB, LDS_WS=3*NSLOT*SLOTB, LDS_OST=LDS_WS+NW*64*4, LDS_QS=LDS_OST+NW*4096, LDS_BYTES=LDS_QS+NW*4608;
constexpr float C2=0.125f*1.4426950408889634f;
__device__ __forceinline__ void glds16(const void*gsrc,unsigned lds_dst){unsigned keep;
  asm volatile("s_mov_b32 %0, m0\n\ts_mov_b32 m0, %2\n\ts_nop 0\n\tglobal_load_lds_dwordx4 %1, off\n\ts_mov_b32 m0, %0":"=&s"(keep):"v"(gsrc),"s"(lds_dst):"memory");}
__device__ __forceinline__ float max3f(float a,float b,float c){float r;asm("v_max3_f32 %0, %1, %2, %3":"=v"(r):"v"(a),"v"(b),"v"(c));return r;}
__device__ __forceinline__ float max2f(float a,float b){float r;asm("v_max_f32_e32 %0, %1, %2":"=v"(r):"v"(a),"v"(b));return r;}
__device__ __forceinline__ float fadd_s(float a,float b){float r;asm("v_add_f32_e32 %0, %1, %2":"=v"(r):"v"(a),"v"(b));return r;}
__device__ __forceinline__ float fsub_s(float a,float b){float r;asm("v_sub_f32_e32 %0, %1, %2":"=v"(r):"v"(a),"v"(b));return r;}
typedef float f32x2_t __attribute__((ext_vector_type(2))); typedef __bf16 bf16x2_t __attribute__((ext_vector_type(2)));
__device__ __forceinline__ unsigned cvtpk_s(float lo,float hi){f32x2_t v={lo,hi};bf16x2_t b=__builtin_convertvector(v,bf16x2_t);return __builtin_bit_cast(unsigned,b);}
#define WAIT_BAR(N) asm volatile("s_waitcnt vmcnt(" #N ") lgkmcnt(0)\n\ts_barrier":::"memory")

__device__ __forceinline__ void qkt(f32x16&p0,f32x16&p1,const char*Kslot,const bf16x8*qr,int r32,int hi){ const f32x16 negm=f32x16{};
  const char*kb=Kslot+hi*1024+r32*16;
  #pragma unroll
  for(int d0=0;d0<4;++d0){
    const bf16x8 b0=*reinterpret_cast<const bf16x8*>(kb+d0*2048);
    const bf16x8 b1=*reinterpret_cast<const bf16x8*>(kb+d0*2048+512);
    if(d0==0){p0=__builtin_amdgcn_mfma_f32_32x32x16_bf16(b0,qr[0],negm,0,0,0);p1=__builtin_amdgcn_mfma_f32_32x32x16_bf16(b1,qr[0],negm,0,0,0);}
    else{p0=__builtin_amdgcn_mfma_f32_32x32x16_bf16(b0,qr[d0],p0,0,0,0);p1=__builtin_amdgcn_mfma_f32_32x32x16_bf16(b1,qr[d0],p1,0,0,0);}}
}
typedef __attribute__((address_space(3))) const char* lds_cptr;
typedef short v4i16_t __attribute__((ext_vector_type(4)));
__device__ __forceinline__ void kload8(bf16x8*kf,lds_cptr kp){
  kf[0]=*(const __attribute__((address_space(3))) bf16x8*)(kp);      kf[1]=*(const __attribute__((address_space(3))) bf16x8*)(kp+512);
  kf[2]=*(const __attribute__((address_space(3))) bf16x8*)(kp+2048); kf[3]=*(const __attribute__((address_space(3))) bf16x8*)(kp+2560);
  kf[4]=*(const __attribute__((address_space(3))) bf16x8*)(kp+4096); kf[5]=*(const __attribute__((address_space(3))) bf16x8*)(kp+4608);
  kf[6]=*(const __attribute__((address_space(3))) bf16x8*)(kp+6144); kf[7]=*(const __attribute__((address_space(3))) bf16x8*)(kp+6656);
}
__device__ __forceinline__ void kload2(bf16x8*kf,lds_cptr kp,int j){ kf[2*j]=*(const __attribute__((address_space(3))) bf16x8*)(kp+j*2048); kf[2*j+1]=*(const __attribute__((address_space(3))) bf16x8*)(kp+j*2048+512); }
__device__ __forceinline__ s16x4 vtr(lds_cptr p){ return __builtin_bit_cast(s16x4,__builtin_amdgcn_ds_read_tr16_b64_v4i16((__attribute__((address_space(3))) v4i16_t*)p)); }
__device__ __forceinline__ float rowmax(const f32x16&p0,const f32x16&p1){
  float a=max3f(p0[0],p0[1],p1[0]),b=max3f(p0[2],p0[3],p1[1]);a=max3f(a,p1[2],p1[3]);
  #pragma unroll
  for(int r=4;r<16;r+=4){a=max3f(a,p0[r],p0[r+1]);b=max3f(b,p0[r+2],p0[r+3]);a=max3f(a,p1[r],p1[r+1]);b=max3f(b,p1[r+2],p1[r+3]);}
  const float m=max2f(a,b);
  auto rr=__builtin_amdgcn_permlane32_swap(__float_as_uint(m),__float_as_uint(m),false,false);
  return max2f(__uint_as_float(rr[0]),__uint_as_float(rr[1]));
}
__device__ __forceinline__ void pv(f32x16*o,int vb,bf16x8 pa0,bf16x8 pa1,bf16x8 pa2,bf16x8 pa3){
  #pragma unroll
  for(int d0=0;d0<2;++d0){s16x4 lo[4],hi[4];
    #pragma unroll
    for(int ks=0;ks<4;++ks){
      asm volatile("ds_read_b64_tr_b16 %0,%1 offset:%c2":"=&v"(lo[ks]):"v"(vb),"i"(d0*4096+ks*1024):"memory");
      asm volatile("ds_read_b64_tr_b16 %0,%1 offset:%c2":"=&v"(hi[ks]):"v"(vb),"i"(d0*4096+ks*1024+512):"memory");}
    asm volatile("s_waitcnt lgkmcnt(0)":::"memory");SBAR();
    #define PK(k) (bf16x8){lo[k][0],lo[k][1],lo[k][2],lo[k][3],hi[k][0],hi[k][1],hi[k][2],hi[k][3]}
    o[d0]=__builtin_amdgcn_mfma_f32_32x32x16_bf16(pa0,PK(0),o[d0],0,0,0);
    o[d0]=__builtin_amdgcn_mfma_f32_32x32x16_bf16(pa1,PK(1),o[d0],0,0,0);
    o[d0]=__builtin_amdgcn_mfma_f32_32x32x16_bf16(pa2,PK(2),o[d0],0,0,0);
    o[d0]=__builtin_amdgcn_mfma_f32_32x32x16_bf16(pa3,PK(3),o[d0],0,0,0);
    #undef PK
  }
}

#ifndef ATTN_STORE16
#define ATTN_STORE16(p,v) (*(u32x4*)(p)=(v))
#endif
template<int THRL> __device__ __forceinline__ void attn_unit(int qb,const bf16*Qh,const bf16*__restrict__ Kh,const bf16*__restrict__ Vh,bf16*Oh,char*shm,const int wave_id){
  const int tid=fresh_tid(wave_id),lane=tid&63,r32=lane&31,hi=lane>>5; const int wid=__builtin_amdgcn_readfirstlane(tid>>6);
  const int q0=qb*QB;
  const bf16*Qw=Qh+(long)(q0+wid*QBLK)*DM;
  const unsigned lds0=(unsigned)(uintptr_t)shm;
  float*wsf=(float*)(shm+LDS_WS)+wid*64;
  const bf16*ksrc=Kh+(long)lane*DM+wid*8;
  const bf16*vsrc=Vh+(long)(16*(wid&3)+(lane>>2))*DM+(wid>>2)*32+(lane&3)*8;
  const unsigned kdst=lds0+LDS_K+wid*1024, vdst=lds0+LDS_V+wid*1024;
  #define DMA_K(t,slot) glds16(ksrc+(long)(t)*KVBLK*DM,(unsigned)__builtin_amdgcn_readfirstlane(kdst+(slot)))
  #define DMA_V(t,slot) do{ glds16(vsrc+(long)(t)*KVBLK*DM,(unsigned)__builtin_amdgcn_readfirstlane(vdst+2*(slot))); glds16(vsrc+64+(long)(t)*KVBLK*DM,(unsigned)__builtin_amdgcn_readfirstlane(vdst+2*(slot)+SLOTB)); }while(0)
  const int vb0=(int)(lds0+LDS_V)+((lane>>4)&1)*32+(lane&3)*8+(4*hi+((lane&15)>>2))*64;
  const char*Kbase=shm+LDS_K; bf16x8 kf[8];
  const lds_cptr shm3=(lds_cptr)shm; const lds_cptr kp0=shm3+LDS_K+hi*1024+r32*16; const lds_cptr vp0=shm3+LDS_V+((lane>>4)&1)*32+(lane&3)*8+(4*hi+((lane&15)>>2))*64;
  const int NT=(q0+QB)/KVBLK;
  DMA_K(0,0);DMA_V(0,0);DMA_K(1,SLOTB);
  bf16x8 qr[4];
  #pragma unroll
  for(int d0=0;d0<4;++d0)qr[d0]=*reinterpret_cast<const bf16x8*>(&Qw[(long)r32*DM+d0*16+hi*8]);
  const lds_cptr qpk=(lds_cptr)shm+LDS_QS+wid*4608+r32*144+hi*16;
  #pragma unroll
  for(int d0=0;d0<4;++d0)*(__attribute__((address_space(3))) bf16x8*)(qpk+d0*32)=qr[d0];
  #define QF(d) (*(const __attribute__((address_space(3))) bf16x8*)(qpk+(d)*32))
  float mhat=0.f,l_reg=0.f;f32x16 o[4];o[0]=f32x16{};o[1]=f32x16{};o[2]=f32x16{};o[3]=f32x16{};const f32x16 zacc=f32x16{};
  #define CMASK(P0,P1,t) do{int jb_=(t)-(NT-4); if(jb_>=0)cmask(P0,P1,jb_,wid);}while(0)
  bool resc=false;
  #define START(P0,P1) do{ const float rm=rowmax(P0,P1); resc=false; \
    { const float dl=rm; mhat=fadd_s(mhat,dl); \
      _Pragma("unroll") for(int r=0;r<16;++r){P0[r]=fsub_s(P0[r],dl);P1[r]=fsub_s(P1[r],dl);} \
      } \
    _Pragma("unroll") for(int r=0;r<16;++r)P0[r]=__builtin_amdgcn_exp2f(P0[r]); }while(0)
  #define RESC() do{ if(resc){ asm volatile("s_waitcnt lgkmcnt(0)":::"memory"); \
      _Pragma("unroll") for(int d_=0;d_<4;++d_) _Pragma("unroll") for(int r=0;r<16;++r)o[d_][r]*=wsf[crow(r,hi)]; } }while(0)
  f32x16 pA0,pA1,pB0,pB1;
  int sl_prev=0,sl_cur=0,sl_next=SLOTB;
  #define ROT() do{sl_prev=sl_cur;sl_cur=sl_next;sl_next=(sl_next==(NSLOT-1)*SLOTB)?0:sl_next+SLOTB;}while(0)
  if(wid>=4)__builtin_amdgcn_s_setprio(1);
  DMA_K(2,2*SLOTB);
  WAIT_BAR(3);
  qkt(pA0,pA1,Kbase,qr,r32,hi);asm volatile("s_nop 15\n\ts_nop 7":"+v"(pA0),"+v"(pA1));CMASK(pA0,pA1,0);
  START(pA0,pA1);
  _Pragma("unroll") for(int r=0;r<16;++r)pA1[r]=__builtin_amdgcn_exp2f(pA1[r]);
  WAIT_BAR(0);
  DMA_K(3,0);DMA_V(1,SLOTB);
  ROT();
  kload8(kf,kp0+sl_cur);
  WAIT_BAR(3);
  s16x4 vlo[8],vhi[8]; u32x4 pw0,pw1,pw2,pw3;
  #define PKW(P,B) cvtpk_s(P[B],P[B+1])
  #define PAF(k) __builtin_bit_cast(bf16x8,pw##k)
  #define VFR(i) (bf16x8){vlo[i][0],vlo[i][1],vlo[i][2],vlo[i][3],vhi[i][0],vhi[i][1],vhi[i][2],vhi[i][3]}
  #define PIN(x) asm volatile("":"+v"(x))
  #define MX3(a,b,c) __builtin_fmaxf(__builtin_fmaxf((a),(b)),(c))
  #define GAPA(MF,A0,A1,A2,A3,W0,W1,PW) do{ MF; sacc+=A0; sacc+=A1; sacc+=A2; sacc+=A3; PIN(sacc); W0; W1; PIN(PW); SBAR(); }while(0)
  #define EX(v) __builtin_amdgcn_exp2f(v)
  #define GAPB(MF,X,B) do{ MF; X[B]=EX(X[B]); X[B+1]=EX(X[B+1]); X[B+2]=EX(X[B+2]); X[B+3]=EX(X[B+3]); PIN(X); SBAR(); }while(0)
  #define VRD(i) do{ vlo[i]=vtr(vp_+(((i)>>2)*4096+((i)&3)*1024)); vhi[i]=vtr(vp_+(((i)>>2)*4096+((i)&3)*1024+512)); }while(0)
  #define VRD2(i) do{ vlo[i]=vtr(vp_+(8192+((i)>>2)*4096+((i)&3)*1024)); vhi[i]=vtr(vp_+(8192+((i)>>2)*4096+((i)&3)*1024+512)); }while(0)
  #define GAPB2(MF,X,B,RD) do{ MF; RD; X[B]=EX(X[B]); X[B+1]=EX(X[B+1]); PIN(X); SBAR(); }while(0)
  #define KRD(G,j) do{ if(G){ kload2(kf,kp0+sl_next,j); SBAR(); } }while(0)
  #define STEP(C0,C1,P0,P1,t,GK,GV,GL) do{ SBAR(); \
    const lds_cptr vp_=vp0+2*sl_prev; \
    VRD(0); SBAR(); float sacc=(P0[0]+P0[1]); \
    GAPA(C0=__builtin_amdgcn_mfma_f32_32x32x16_bf16(kf[0],QF(0),zacc,0,0,0), P0[2],P0[3],P0[4],P0[5],     pw0[0]=PKW(P0,0), pw0[1]=PKW(P0,2), pw0); \
    VRD(4); SBAR(); GAPA(C1=__builtin_amdgcn_mfma_f32_32x32x16_bf16(kf[1],QF(0),zacc,0,0,0), P0[6],P0[7],P0[8],P0[9],     pw0[2]=PKW(P0,4), pw0[3]=PKW(P0,6), pw0); \
    VRD(1); SBAR(); GAPA(C0=__builtin_amdgcn_mfma_f32_32x32x16_bf16(kf[2],QF(1),C0,0,0,0),   P0[10],P0[11],P0[12],P0[13], pw1[0]=PKW(P0,8), pw1[1]=PKW(P0,10), pw1); \
    VRD(5); SBAR(); GAPA(C1=__builtin_amdgcn_mfma_f32_32x32x16_bf16(kf[3],QF(1),C1,0,0,0),   P0[14],P0[15],P1[0],P1[1],   pw1[2]=PKW(P0,12),pw1[3]=PKW(P0,14), pw1); \
    VRD(2); SBAR(); GAPA(C0=__builtin_amdgcn_mfma_f32_32x32x16_bf16(kf[4],QF(2),C0,0,0,0),   P1[2],P1[3],P1[4],P1[5],     pw2[0]=PKW(P1,0), pw2[1]=PKW(P1,2), pw2); \
    VRD(6); SBAR(); GAPA(C1=__builtin_amdgcn_mfma_f32_32x32x16_bf16(kf[5],QF(2),C1,0,0,0),   P1[6],P1[7],P1[8],P1[9],     pw2[2]=PKW(P1,4), pw2[3]=PKW(P1,6), pw2); \
    VRD(3); SBAR(); GAPA(C0=__builtin_amdgcn_mfma_f32_32x32x16_bf16(kf[6],QF(3),C0,0,0,0),   P1[10],P1[11],P1[12],P1[13], pw3[0]=PKW(P1,8), pw3[1]=PKW(P1,10), pw3); \
    VRD(7); SBAR(); GAPA(C1=__builtin_amdgcn_mfma_f32_32x32x16_bf16(kf[7],QF(3),C1,0,0,0),   P1[14],P1[15],0.f,0.f,       pw3[2]=PKW(P1,12),pw3[3]=PKW(P1,14), pw3); \
    l_reg+=sacc; \
    if(GK){DMA_K((t)+3,sl_cur);} if(GV){DMA_V((t)+1,sl_next);} \
    _Pragma("unroll") for(int r=0;r<16;++r){C0[r]-=mhat;C1[r]-=mhat;} \
    CMASK(C0,C1,t); \
    { float a=MX3(C0[0],C0[1],C1[0]),b=MX3(C0[2],C0[3],C1[1]); a=MX3(a,C1[2],C1[3]); \
      _Pragma("unroll") for(int r=4;r<16;r+=4){a=MX3(a,C0[r],C0[r+1]);b=MX3(b,C0[r+2],C0[r+3]);a=MX3(a,C1[r],C1[r+1]);b=MX3(b,C1[r+2],C1[r+3]);} \
      float rm=__builtin_fmaxf(a,b); { auto rr=__builtin_amdgcn_permlane32_swap(__float_as_uint(rm),__float_as_uint(rm),false,false); rm=__builtin_fmaxf(__uint_as_float(rr[0]),__uint_as_float(rr[1])); } \
      resc=false; \
      if(__builtin_expect(__any(rm>(float)THRL),0)){ const float dl=__builtin_fmaxf(rm,0.f); mhat+=dl; \
        _Pragma("unroll") for(int r=0;r<16;++r){C0[r]-=dl;C1[r]-=dl;} \
        const float f=__builtin_amdgcn_exp2f(-dl); l_reg*=f; if(hi==0)wsf[r32]=f; resc=true; } } \
    SBAR(); \
    GAPB2(o[0]=__builtin_amdgcn_mfma_f32_32x32x16_bf16(PAF(0),VFR(0),o[0],0,0,0), C0,0, VRD2(0)); \
    GAPB2(o[1]=__builtin_amdgcn_mfma_f32_32x32x16_bf16(PAF(0),VFR(4),o[1],0,0,0), C0,2, VRD2(4)); \
    KRD(GL,0); GAPB2(o[0]=__builtin_amdgcn_mfma_f32_32x32x16_bf16(PAF(1),VFR(1),o[0],0,0,0), C0,4, VRD2(1)); \
    KRD(GL,1); GAPB2(o[1]=__builtin_amdgcn_mfma_f32_32x32x16_bf16(PAF(1),VFR(5),o[1],0,0,0), C0,6, VRD2(5)); \
    KRD(GL,2); GAPB2(o[0]=__builtin_amdgcn_mfma_f32_32x32x16_bf16(PAF(2),VFR(2),o[0],0,0,0), C0,8, VRD2(2)); \
    KRD(GL,3); GAPB2(o[1]=__builtin_amdgcn_mfma_f32_32x32x16_bf16(PAF(2),VFR(6),o[1],0,0,0), C0,10, VRD2(6)); \
    GAPB2(o[0]=__builtin_amdgcn_mfma_f32_32x32x16_bf16(PAF(3),VFR(3),o[0],0,0,0), C0,12, VRD2(3)); \
    GAPB2(o[1]=__builtin_amdgcn_mfma_f32_32x32x16_bf16(PAF(3),VFR(7),o[1],0,0,0), C0,14, VRD2(7)); \
    GAPB2(o[2]=__builtin_amdgcn_mfma_f32_32x32x16_bf16(PAF(0),VFR(0),o[2],0,0,0), C1,0, (void)0); \
    GAPB2(o[3]=__builtin_amdgcn_mfma_f32_32x32x16_bf16(PAF(0),VFR(4),o[3],0,0,0), C1,2, (void)0); \
    GAPB2(o[2]=__builtin_amdgcn_mfma_f32_32x32x16_bf16(PAF(1),VFR(1),o[2],0,0,0), C1,4, (void)0); \
    GAPB2(o[3]=__builtin_amdgcn_mfma_f32_32x32x16_bf16(PAF(1),VFR(5),o[3],0,0,0), C1,6, (void)0); \
    GAPB2(o[2]=__builtin_amdgcn_mfma_f32_32x32x16_bf16(PAF(2),VFR(2),o[2],0,0,0), C1,8, (void)0); \
    GAPB2(o[3]=__builtin_amdgcn_mfma_f32_32x32x16_bf16(PAF(2),VFR(6),o[3],0,0,0), C1,10, (void)0); \
    GAPB2(o[2]=__builtin_amdgcn_mfma_f32_32x32x16_bf16(PAF(3),VFR(3),o[2],0,0,0), C1,12, (void)0); \
    GAPB2(o[3]=__builtin_amdgcn_mfma_f32_32x32x16_bf16(PAF(3),VFR(7),o[3],0,0,0), C1,14, (void)0); \
    }while(0)
  int t=1;
  #undef CMASK
  #define CMASK(P0,P1,t) do{}while(0)
  for(;t+5<NT;t+=2){
    STEP(pB0,pB1,pA0,pA1,t,true,true,true);     WAIT_BAR(3); RESC(); ROT();
    STEP(pA0,pA1,pB0,pB1,t+1,true,true,true);   WAIT_BAR(3); RESC(); ROT();
  }
  #undef CMASK
  #define CMASK(P0,P1,t) do{int jb_=(t)-(NT-4); if(jb_>=0)cmask(P0,P1,jb_,wid);}while(0)
  #define ENDW(tt) do{ if((tt)+3<NT){WAIT_BAR(3);} else if((tt)+2<NT){WAIT_BAR(2);} else {WAIT_BAR(0);} }while(0)
  for(;t+1<NT;t+=2){
    STEP(pB0,pB1,pA0,pA1,t,(t+3<NT),(t+1<NT),(t+1<NT));       ENDW(t);   RESC(); ROT();
    STEP(pA0,pA1,pB0,pB1,t+1,(t+4<NT),(t+2<NT),(t+2<NT));     ENDW(t+1); RESC(); ROT();
  }
  STEP(pB0,pB1,pA0,pA1,NT-1,false,false,false); RESC();
  { float sacc=pB0[0]+pB0[1]; _Pragma("unroll") for(int r=2;r<16;++r)sacc+=pB0[r]; _Pragma("unroll") for(int r=0;r<16;++r)sacc+=pB1[r]; l_reg+=sacc;
    pw0=(u32x4){PKW(pB0,0),PKW(pB0,2),PKW(pB0,4),PKW(pB0,6)};pw1=(u32x4){PKW(pB0,8),PKW(pB0,10),PKW(pB0,12),PKW(pB0,14)};pw2=(u32x4){PKW(pB1,0),PKW(pB1,2),PKW(pB1,4),PKW(pB1,6)};pw3=(u32x4){PKW(pB1,8),PKW(pB1,10),PKW(pB1,12),PKW(pB1,14)};
    SBAR(); pv(o,vb0+2*sl_cur,PAF(0),PAF(1),PAF(2),PAF(3)); pv(o+2,vb0+2*sl_cur+8192,PAF(0),PAF(1),PAF(2),PAF(3)); }
  #undef PKW
  #undef PAF
  #undef VFR
  #undef PIN
  #undef MX3
  #undef GAPA
  #undef GAPB
  #undef GAPB2
  #undef QF
  #undef VRD2
  #undef EX
  #undef VRD
  #undef KRD
  #undef STEP
  #undef ENDW
  {auto rr=__builtin_amdgcn_permlane32_swap(__float_as_uint(l_reg),__float_as_uint(l_reg),false,false);l_reg=__uint_as_float(rr[0])+__uint_as_float(rr[1]);}
  if(hi==0)wsf[32+r32]=l_reg;asm volatile("s_waitcnt lgkmcnt(0)":::"memory");
  float rli[16];
  #pragma unroll
  for(int r=0;r<16;++r)rli[r]=__builtin_amdgcn_rcpf(wsf[32+crow(r,hi)]);
  bf16*Ow=Oh+(long)(q0+wid*QBLK)*DM;
  { bf16*stg=(bf16*)(shm+LDS_OST)+wid*2048;
    #pragma unroll
    for(int hf=0;hf<2;++hf){
      #pragma unroll
      for(int r=0;r<16;++r){const int orow=crow(r,hi);
        #pragma unroll
        for(int d0=0;d0<2;++d0)stg[orow*64+d0*32+r32]=__float2bfloat16(o[2*hf+d0][r]*rli[r]);}
      asm volatile("s_waitcnt lgkmcnt(0)":::"memory");
      #pragma unroll
      for(int i=0;i<4;++i){const int row=i*8+(lane>>3),ch=lane&7; const u32x4 v=*(const u32x4*)(stg+row*64+ch*8); ATTN_STORE16(Ow+(long)row*DM+hf*64+ch*8,v);}
      asm volatile("s_waitcnt lgkmcnt(0)":::"memory"); } }
  __builtin_amdgcn_s_setprio(0);
  asm volatile("s_waitcnt lgkmcnt(0)\n\ts_barrier":::"memory");
  #undef DMA_K
  #undef DMA_V
  #undef CMASK
  #undef START
  #undef RESC
  #undef ROT
}
constexpr int ATTN_LDS_BYTES=LDS_BYTES;
#undef SBAR
#undef WAIT_BAR
}
#define GAS __attribute__((address_space(1)))
#define LAS __attribute__((address_space(3)))
typedef unsigned short bf16;
typedef unsigned v4u __attribute__((ext_vector_type(4)));
typedef float f32x4 __attribute__((ext_vector_type(4)));
typedef short bf16x8 __attribute__((ext_vector_type(8)));
typedef GAS unsigned gu32;
typedef GAS unsigned long long gu64;
#define RLX_AGENT __ATOMIC_RELAXED, __HIP_MEMORY_SCOPE_AGENT
#define LDS_WAIT() asm volatile("s_waitcnt lgkmcnt(0)" ::: "memory")
#define VM_WAIT() asm volatile("s_waitcnt vmcnt(0)" ::: "memory")
__device__ __forceinline__ unsigned long long rt() { return __builtin_amdgcn_s_memrealtime(); }
__device__ __forceinline__ unsigned f2bf(float f) { unsigned u = __builtin_bit_cast(unsigned, f); return (u + 0x7fffu + ((u >> 16) & 1u)) >> 16; }
__device__ __forceinline__ unsigned pk2(float lo, float hi) { return f2bf(lo) | (f2bf(hi) << 16); }

#define XB_TMO      128
#define XB_XCNT(j)  (256  + 64 * (j))
#define XB_XSUB(j)  (1280 + 64 * (j))
#define XB_XGEN(j)  (2304 + 64 * (j))
#define XB_TOP      3328
#define XB_TOPGEN   3392
#define XCD_BAR_WORDS 3456
#define XB_SPIN_CAP (1u << 18)

__device__ __forceinline__ unsigned xb_ld(unsigned* p)              { return __hip_atomic_load(p, __ATOMIC_RELAXED, __HIP_MEMORY_SCOPE_AGENT); }
__device__ __forceinline__ unsigned xb_add(unsigned* p, unsigned v) { return __hip_atomic_fetch_add(p, v, __ATOMIC_RELAXED, __HIP_MEMORY_SCOPE_AGENT); }
__device__ __forceinline__ unsigned xb_xcc_id() { return (unsigned)__builtin_amdgcn_s_getreg((3 << 11) | 20) & 0xFu; }
#define XB_SPIN(cond, bar) do { unsigned _sp = 0; while (cond) { __builtin_amdgcn_s_sleep(1); \
    if ((++_sp & 255u) == 0u) { if (xb_ld(&(bar)[XB_TMO])) break; if (_sp > XB_SPIN_CAP) { atomicAdd(&(bar)[XB_TMO], 1u); break; } } } } while (0)

struct XcdBarrier {
    unsigned* bar; unsigned x;
    volatile LAS unsigned* st;
};

__device__ __forceinline__ XcdBarrier xcd_barrier_post(unsigned* bar, volatile LAS unsigned* st) {
    XcdBarrier b; b.bar = bar; b.x = xb_xcc_id(); b.st = st;
    if (threadIdx.x == 0) (void)xb_add(&bar[XB_XCNT(b.x)], 1u);
    return b;
}
__device__ __forceinline__ void xcd_barrier_complete(unsigned* bar, unsigned x, unsigned& nloc, unsigned& nx) {
    const unsigned G = gridDim.x * gridDim.y * gridDim.z;
    unsigned sum, cnt, mine, sp = 0u;
    for (;;) {
        sum = 0u; cnt = 0u; mine = 0u;
#pragma unroll
        for (unsigned j = 0; j < 16; ++j) { const unsigned c = xb_ld(&bar[XB_XCNT(j)]); sum += c; cnt += (c > 0u) ? 1u : 0u; mine = (j == x) ? c : mine; }
        if (sum == G) break;
        __builtin_amdgcn_s_sleep(1);
        if ((++sp & 255u) == 0u) { if (xb_ld(&bar[XB_TMO])) break; if (sp > XB_SPIN_CAP) { atomicAdd(&bar[XB_TMO], 1u); break; } }
    }
    nloc = mine > 0u ? mine : 1u; nx = cnt > 0u ? cnt : 1u;
}

__device__ __forceinline__ void xcd_barrier(const XcdBarrier& b) {
    asm volatile("s_waitcnt vmcnt(0)" ::: "memory");
    __syncthreads();
    if (threadIdx.x == 0) {
        unsigned* bar = b.bar;
        __builtin_amdgcn_s_waitcnt(0);
        unsigned nloc = b.st[0], nx = b.st[1];
        if (nloc == 0u) { xcd_barrier_complete(bar, b.x, nloc, nx); b.st[0] = nloc; b.st[1] = nx; }
        const unsigned old = xb_add(&bar[XB_XSUB(b.x)], 1u);
        const unsigned gen = old / nloc;
        if (old + 1u == (gen + 1u) * nloc) {
            __builtin_amdgcn_fence(__ATOMIC_RELEASE, "agent");
            asm volatile("s_waitcnt vmcnt(0)" ::: "memory");
            const unsigned og = xb_add(&bar[XB_TOP], 1u);
            const unsigned tg = og / nx;
            if (og + 1u == (tg + 1u) * nx) xb_add(&bar[XB_TOPGEN], 1u);
            else XB_SPIN(xb_ld(&bar[XB_TOPGEN]) == tg, bar);
            __builtin_amdgcn_fence(__ATOMIC_ACQUIRE, "agent");
            xb_add(&bar[XB_XGEN(b.x)], 1u);
            asm volatile("s_waitcnt vmcnt(0)" ::: "memory");
        } else {
            XB_SPIN(xb_ld(&bar[XB_XGEN(b.x)]) == gen, bar);
            __builtin_amdgcn_fence(__ATOMIC_ACQUIRE, "agent");
            asm volatile("s_waitcnt vmcnt(0)" ::: "memory");
        }
    }
    __syncthreads();
}
constexpr int S = 8192, D = 2048, NINP = 16384, NIN_SRC = 16392, FF = 5632, DEPTH = 4, NWAVES = 8;
constexpr float EPS = 1e-6f;
constexpr int NPH_LAYER = 13, NPH = 2 + DEPTH * NPH_LAYER;
#ifndef MK_ONE_LAUNCH
#define MK_ONE_LAUNCH 1
#endif
#ifndef CONV_WGS
#define CONV_WGS 64
#endif
constexpr size_t MiB = 1u << 20;
constexpr size_t WS_CTL = 0, CTL_ZERO_BYTES = 1 * MiB;
constexpr size_t WS_MOD = 1 * MiB;
constexpr size_t WS_ROPE = 2 * MiB;
constexpr size_t WS_WG = 3 * MiB;
constexpr size_t WS_GATES = 4 * MiB;
constexpr size_t WS_MG = 5 * MiB;
constexpr size_t WS_DEC = 5 * MiB + 768 * 1024;
constexpr size_t WS_MODP = 8 * MiB;
constexpr size_t WS_W = 16 * MiB, W_LAYER = 154 * MiB;
constexpr size_t WO_IN = 0, WO_A = 64 * MiB, WO_B = 72 * MiB, WO_OUT = 80 * MiB, WO_G = 88 * MiB, WO_U = 110 * MiB, WO_D = 132 * MiB;
constexpr size_t WS_H = 640 * MiB;
constexpr size_t WS_P8 = 672 * MiB, P8_STRIDE = 32 * MiB;
constexpr size_t WS_QKC = 928 * MiB, WS_HM = 960 * MiB, WS_O1 = 992 * MiB, WS_O2 = 1024 * MiB, WS_AM = 1056 * MiB, WS_AB = 1088 * MiB;
constexpr size_t WS_T = 1120 * MiB, WS_MRG = 1184 * MiB, WS_Y = 1216 * MiB, WS_G = 1280 * MiB, WS_AFF = 1368 * MiB, WS_KT = 1456 * MiB, WS_VT = 1472 * MiB, WS_PG = 1504 * MiB, WS_DG = 1508 * MiB, WS_END = 1512 * MiB;
constexpr int CW_BAR = 4096, CW_Q = 8192, CW_PF = 20480;
constexpr int LDS_BYTES = 147456, LDSCTL_OFF = LDS_BYTES - 512, MISC_OFF = LDSCTL_OFF + 320;

struct Frame { LAS unsigned char* lds; volatile LAS unsigned* MISC; gu32* ctl; int tid, lane, wave, vcu, G; };

template <int O> __device__ __forceinline__ float xor_lanes(float v) { static_assert(O >= 1 && O <= 16, "xor within 32 lanes"); return __uint_as_float((unsigned)__builtin_amdgcn_ds_swizzle((int)__float_as_uint(v), (O << 10) | 0x1f)); }
__device__ __forceinline__ float add_halves(float v) { auto rr = __builtin_amdgcn_permlane32_swap(__float_as_uint(v), __float_as_uint(v), false, false); return __uint_as_float(rr[0]) + __uint_as_float(rr[1]); }
__device__ __forceinline__ float wave_sum(float v) {
    v += xor_lanes<1>(v); v += xor_lanes<2>(v); v += xor_lanes<4>(v); v += xor_lanes<8>(v); v += xor_lanes<16>(v);
    return add_halves(v);
}
__device__ __forceinline__ float dot4(f32x4 a, f32x4 b) { return (a.x * b.x + a.y * b.y) + (a.z * b.z + a.w * b.w); }
__device__ __forceinline__ float bflo(unsigned u) { return __builtin_bit_cast(float, u << 16); }
__device__ __forceinline__ float bfhi(unsigned u) { return __builtin_bit_cast(float, u & 0xffff0000u); }
__device__ __forceinline__ void unpk8(const v4u w, float (&f)[8]) { f[0] = bflo(w.x); f[1] = bfhi(w.x); f[2] = bflo(w.y); f[3] = bfhi(w.y); f[4] = bflo(w.z); f[5] = bfhi(w.z); f[6] = bflo(w.w); f[7] = bfhi(w.w); }
__device__ __forceinline__ v4u pk8(const float (&f)[8]) { v4u w; w.x = pg8::cvt_pk_bf16(f[0], f[1]); w.y = pg8::cvt_pk_bf16(f[2], f[3]); w.z = pg8::cvt_pk_bf16(f[4], f[5]); w.w = pg8::cvt_pk_bf16(f[6], f[7]); return w; }
__device__ __forceinline__ float sigmf(float x) { return __builtin_amdgcn_rcpf(1.0f + __expf(-x)); }

struct Args { const float* in[25]; float* out; unsigned char* ws; double inv[8]; int ph_lo, ph_hi, mode, pad; };

constexpr int WI_IN = (D / 64) * (NINP / 64), WI_SQ = (D / 64) * (D / 64), WI_FF = (D / 64) * (FF / 64), WI_DN = (FF / 64) * (D / 64), WI_LAYER = WI_IN + 3 * WI_SQ + 2 * WI_FF + WI_DN;
__device__ __forceinline__ void adaln_item(const float* c, const float* wada, unsigned char* ws, int l, int rem, int lane) {
    const int jg = rem >> 5, kp = rem & 31, k0 = 64 * kp; float* modp = (float*)(ws + WS_MODP);
    const float cv = c[k0 + lane]; const float ca = cv * sigmf(cv);
    const float* wp = wada + ((size_t)l * D + k0) * (6 * D) + 256 * jg + 4 * lane;
    f32x4 acc = (f32x4){0.f, 0.f, 0.f, 0.f};
#pragma unroll 16
    for (int kk = 0; kk < 64; ++kk) { const f32x4 w = __builtin_nontemporal_load((const f32x4*)(wp + (size_t)kk * (6 * D))); const float a = __uint_as_float((unsigned)__builtin_amdgcn_readlane((int)__float_as_uint(ca), kk)); acc += w * a; }
    *(f32x4*)(modp + ((size_t)kp * DEPTH + l) * (6 * D) + 256 * jg + 4 * lane) = acc;
}
struct WItem { const float* src; bf16* dst; int ldt; int rope; };
__device__ __forceinline__ int witem_desc(const float* w_in, const float* w_a, const float* w_b, const float* w_out, const float* w_gate, const float* w_up, const float* w_down,
                                          unsigned char* ws, int l, int r, int lane, WItem& d) {
    unsigned char* wl = ws + WS_W + (size_t)l * W_LAYER; const float* W; bf16* WT; int K, ldw, N, ldt, koff = 0, map = 0;
    if (r < WI_IN) { W = w_in + (size_t)l * D * NIN_SRC; K = D; ldw = NIN_SRC; N = NINP; WT = (bf16*)(wl + WO_IN); ldt = D; map = 1; }
    else if ((r -= WI_IN) < WI_SQ) { W = w_a + (size_t)l * D * D; K = D; ldw = D; N = D; WT = (bf16*)(wl + WO_A); ldt = 2 * D; koff = D; }
    else if ((r -= WI_SQ) < WI_SQ) { W = w_b + (size_t)l * D * D; K = D; ldw = D; N = D; WT = (bf16*)(wl + WO_A); ldt = 2 * D; }
    else if ((r -= WI_SQ) < WI_SQ) { W = w_out + (size_t)l * D * D; K = D; ldw = D; N = D; WT = (bf16*)(wl + WO_OUT); ldt = D; }
    else if ((r -= WI_SQ) < WI_FF) { W = w_gate + (size_t)l * D * FF; K = D; ldw = FF; N = FF; WT = (bf16*)(wl + WO_G); ldt = D; }
    else if ((r -= WI_FF) < WI_FF) { W = w_up + (size_t)l * D * FF; K = D; ldw = FF; N = FF; WT = (bf16*)(wl + WO_U); ldt = D; }
    else { r -= WI_FF; W = w_down + (size_t)l * FF * D; K = FF; ldw = D; N = D; WT = (bf16*)(wl + WO_D); ldt = FF; }
    (void)K;
    const int nblk = N / 64, kb = r / nblk, nb = r % nblk, k0 = 64 * kb, n0 = 64 * nb;
    const int s0 = (map == 1 && n0 >= 6144) ? n0 + 8 : n0;
    d.rope = (map == 1 && n0 >= 6144 && n0 < 10240) ? 1 : 0;
    d.src = W + (size_t)(k0 + (lane >> 4)) * ldw + s0 + 4 * (lane & 15); d.dst = WT + (size_t)n0 * ldt + koff + k0; d.ldt = ldt;
    return ldw;
}
#define WITEM_ISSUE(d, ldw, v) do { _Pragma("unroll") for (int i_ = 0; i_ < 16; ++i_) v[i_] = __builtin_nontemporal_load((const f32x4*)((d).src + (size_t)(4 * i_) * (ldw))); } while (0)
__device__ __forceinline__ void witem_finish(const WItem& d, const f32x4 (&v)[16], LAS float* scr, int lane) {
    const int r4 = lane >> 4, cq = lane & 15;
#pragma unroll
    for (int i = 0; i < 16; ++i) { LAS float* p = scr + (4 * i + r4) * 65 + 4 * cq; p[0] = v[i].x; p[1] = v[i].y; p[2] = v[i].z; p[3] = v[i].w; }
    LDS_WAIT(); asm volatile("" ::: "memory");
    const int c = lane & 7;
#pragma unroll
    for (int j = 0; j < 8; ++j) { const int n = (lane >> 3) + 8 * j; const int pn = (d.rope && n < 16) ? (n >> 1) + 8 * (n & 1) : n; const LAS float* s = scr + (8 * c) * 65 + pn;
        v4u o; o.x = pg8::cvt_pk_bf16(s[0 * 65], s[1 * 65]); o.y = pg8::cvt_pk_bf16(s[2 * 65], s[3 * 65]); o.z = pg8::cvt_pk_bf16(s[4 * 65], s[5 * 65]); o.w = pg8::cvt_pk_bf16(s[6 * 65], s[7 * 65]);
        *(GAS v4u*)(d.dst + (size_t)n * d.ldt + 8 * c) = o; }
    LDS_WAIT(); asm volatile("" ::: "memory");
}
__device__ __forceinline__ void wconv_item(const float* w_in, const float* w_a, const float* w_b, const float* w_out, const float* w_gate, const float* w_up, const float* w_down,
                                           unsigned char* ws, int l, int r, LAS float* scr, int lane) {
    WItem d; const int ldw = witem_desc(w_in, w_a, w_b, w_out, w_gate, w_up, w_down, ws, l, r, lane, d); f32x4 v[16]; WITEM_ISSUE(d, ldw, v); witem_finish(d, v, scr, lane);
}
struct Args; typedef const __attribute__((address_space(4))) Args* CArgs0;
__device__ __forceinline__ void p0_prologue(Frame& F, const __attribute__((address_space(4))) Args* Ap) {
    const __attribute__((address_space(4))) Args& A = *Ap;
    LAS float* scr = (LAS float*)(F.lds + F.wave * 16640);
    const int gw = F.vcu * NWAVES + F.wave, NGW = F.G * NWAVES;
    unsigned char* ws = A.ws;
    for (int it = gw; it < WI_IN; it += NGW) wconv_item(A.in[9], A.in[17], A.in[18], A.in[19], A.in[20], A.in[21], A.in[24], ws, 0, it, scr, F.lane);
    for (int it = gw; it < 1536; it += NGW) adaln_item(A.in[1], A.in[3], ws, 0, it, F.lane);
    { const int gt = (F.vcu * NWAVES + F.wave) * 64 + F.lane, NGT = NGW * 64; const int* pos = (const int*)A.in[2];
      float* rc = (float*)(ws + WS_ROPE); float* rs = rc + S * 8;
      for (int i = gt; i < S * 8; i += NGT) { const int row = i >> 3, j = i & 7; const double ang = (double)pos[row] * A.inv[j];
        const double rev = ang * 0.15915494309189535; const double fr = rev - __builtin_floor(rev); const float a = (float)(fr * 6.283185307179586);
        rc[i] = __cosf(a); rs[i] = __sinf(a); }
      float* wg = (float*)(ws + WS_WG); const float* win = A.in[9];
      for (int i = gt; i < DEPTH * 8 * D; i += NGT) { const int l = i / (8 * D), g = (i / D) & 7, k = i % D; wg[i] = win[((size_t)l * D + k) * NIN_SRC + 6144 + g]; } }
}
__device__ __forceinline__ void p0b_mod_reduce(Frame& F, const __attribute__((address_space(4))) Args* Ap, int l) {
    const __attribute__((address_space(4))) Args& A = *Ap;
    const int gt = (F.vcu * NWAVES + F.wave) * 64 + F.lane, NGT = F.G * NWAVES * 64;
    const float* modp = (const float*)(A.ws + WS_MODP); float* mod = (float*)(A.ws + WS_MOD); const float* bada = A.in[4];
    for (int i = l * 6 * D + gt; i < (l + 1) * 6 * D; i += NGT) { float s = bada[i];
#pragma unroll 8
        for (int kp = 0; kp < 32; ++kp) s += modp[(size_t)kp * (DEPTH * 6 * D) + i];
        mod[i] = s; }
}

template <bool RES, bool NORM, bool GATES>
__device__ __forceinline__ void row_phase(Frame& F, const float* xin, float* xout, const bf16* Y, const float* gt, const float* gpost,
                                          const float* gpre, const float* sc, const float* sh, bf16* hout, const float* wg, const float* bi, const float* bfg, float* gout) {
    LAS f32x4* VA = (LAS f32x4*)F.lds; LAS f32x4* VB = VA + 512; LAS f32x4* VC = VA + 1024; LAS float* wl = (LAS float*)(F.lds + 24576);
    { const int i = F.tid;
      if (RES) VA[i] = ((const f32x4*)gt)[i] * ((const f32x4*)gpost)[i];
      if (NORM) { VB[i] = ((const f32x4*)gpre)[i] * (((const f32x4*)sc)[i] + 1.0f); VC[i] = ((const f32x4*)sh)[i]; }
      if (GATES) { for (int k = F.tid; k < 8 * D / 4; k += NWAVES * 64) ((LAS f32x4*)wl)[k] = ((const f32x4*)wg)[k]; }
      __syncthreads(); }
    const int gw = F.vcu * NWAVES + F.wave, NGW = F.G * NWAVES;
    f32x4 x0[8], y0[8], x1[8], y1[8];
#define RP_LOAD(X, Yv, row) do { const f32x4* xr_ = (const f32x4*)(xin + (size_t)(row) * D) + F.lane; const unsigned long long* yr_ = (const unsigned long long*)(Y + (size_t)(row) * D) + F.lane; \
        _Pragma("unroll") for (int j = 0; j < 8; ++j) { X[j] = xr_[64 * j]; if (RES) { const unsigned long long yb_ = yr_[64 * j]; Yv[j] = (f32x4){bflo((unsigned)yb_), bfhi((unsigned)yb_), bflo((unsigned)(yb_ >> 32)), bfhi((unsigned)(yb_ >> 32))}; } } } while (0)
#define RP_PROC(X, Yv, row) do { \
        if (RES) { float ss = 0.f; _Pragma("unroll") for (int j = 0; j < 8; ++j) ss += dot4(Yv[j], Yv[j]); \
            const float rstd = 1.0f / sqrtf(wave_sum(ss) * (1.0f / D) + EPS); f32x4* xo = (f32x4*)(xout + (size_t)(row) * D) + F.lane; \
            _Pragma("unroll") for (int j = 0; j < 8; ++j) { X[j] = X[j] + (Yv[j] * rstd) * VA[F.lane + 64 * j]; xo[64 * j] = X[j]; __builtin_amdgcn_sched_barrier(0); } } \
        if (NORM) { float ss = 0.f; _Pragma("unroll") for (int j = 0; j < 8; ++j) ss += dot4(X[j], X[j]); \
            const float rstd = 1.0f / sqrtf(wave_sum(ss) * (1.0f / D) + EPS); GAS unsigned long long* o8 = (GAS unsigned long long*)(hout + (size_t)(row) * D) + F.lane; \
            _Pragma("unroll") for (int j = 0; j < 8; ++j) { const f32x4 h = (X[j] * rstd) * VB[F.lane + 64 * j] + VC[F.lane + 64 * j]; X[j] = h; \
                o8[64 * j] = (unsigned long long)pg8::cvt_pk_bf16(h.x, h.y) | ((unsigned long long)pg8::cvt_pk_bf16(h.z, h.w) << 32); __builtin_amdgcn_sched_barrier(0); } \
            if (GATES) { float d[8]; \
                _Pragma("unroll") for (int g = 0; g < 8; ++g) { float a = 0.f; \
                    _Pragma("unroll") for (int j = 0; j < 8; ++j) a += dot4(X[j], ((const LAS f32x4*)(wl + g * D))[F.lane + 64 * j]); \
                    d[g] = wave_sum(a); __builtin_amdgcn_sched_barrier(0); } \
                if (F.lane == 0) { *(f32x4*)(gout + (size_t)(row) * 8) = (f32x4){d[0] + bi[0], d[1] + bi[1], d[2] + bi[2], d[3] + bi[3]}; \
                                   *(f32x4*)(gout + (size_t)(row) * 8 + 4) = (f32x4){d[4] + bfg[0], d[5] + bfg[1], d[6] + bfg[2], d[7] + bfg[3]}; } } } } while (0)
    int row = gw;
    if (row < S) RP_LOAD(x0, y0, row);
    for (; row < S; row += 2 * NGW) {
        const int r1 = row + NGW, r2 = row + 2 * NGW;
        if (r1 < S) RP_LOAD(x1, y1, r1);
        RP_PROC(x0, y0, row);
        if (r2 < S) RP_LOAD(x0, y0, r2);
        if (r1 < S) RP_PROC(x1, y1, r1);
    }
#undef RP_LOAD
#undef RP_PROC
    __syncthreads();
}

__device__ __forceinline__ void tile_put(LAS unsigned char* T, int s, int cc, v4u v) { *(LAS v4u*)(T + s * 256 + ((cc ^ ((s >> 3) & 7)) << 4)) = v; }
__device__ __forceinline__ void tile_transpose_store(const LAS unsigned char* T, bf16* dst  , int lane) {
    const int drow = lane >> 3, c8 = lane & 7;
#pragma unroll 4
    for (int j = 0; j < 16; ++j) { const LAS unsigned char* p = T + (8 * c8) * 256 + ((j ^ c8) << 4) + 2 * drow; unsigned h[8];
#pragma unroll
        for (int q = 0; q < 8; ++q) h[q] = *(const LAS unsigned short*)(p + q * 256);
        *(v4u*)(dst + (size_t)(8 * j + drow) * 64 + 8 * c8) = (v4u){h[0] | (h[1] << 16), h[2] | (h[3] << 16), h[4] | (h[5] << 16), h[6] | (h[7] << 16)}; }
}
__device__ __forceinline__ void prep_conv_item(int it, int lane, LAS unsigned char* T, const bf16* QKM, bf16* QKC, bf16* KT, const float* cw, const float* cb) {
    const int c = it >> 4, cg = it & 15, rg = lane >> 4, cc = lane & 15, c0 = cg * 128 + 8 * cc, r0 = 64 * c + 16 * rg;
    float w[4][8], b[8];
#pragma unroll
    for (int k = 0; k < 4; ++k) { const f32x4 a = *(const f32x4*)(cw + k * 2048 + c0), bb = *(const f32x4*)(cw + k * 2048 + c0 + 4); w[k][0] = a.x; w[k][1] = a.y; w[k][2] = a.z; w[k][3] = a.w; w[k][4] = bb.x; w[k][5] = bb.y; w[k][6] = bb.z; w[k][7] = bb.w; }
    { const f32x4 a = *(const f32x4*)(cb + c0), bb = *(const f32x4*)(cb + c0 + 4); b[0] = a.x; b[1] = a.y; b[2] = a.z; b[3] = a.w; b[4] = bb.x; b[5] = bb.y; b[6] = bb.z; b[7] = bb.w; }
    float xm3[8], xm2[8], xm1[8], x0[8], o[8];
    const v4u z = (v4u){0u, 0u, 0u, 0u};
    unpk8(r0 >= 3 ? *(const v4u*)(QKM + (size_t)(r0 - 3) * 2048 + c0) : z, xm3);
    unpk8(r0 >= 2 ? *(const v4u*)(QKM + (size_t)(r0 - 2) * 2048 + c0) : z, xm2);
    unpk8(r0 >= 1 ? *(const v4u*)(QKM + (size_t)(r0 - 1) * 2048 + c0) : z, xm1);
    const float qs = (c0 < 1024) ? 0.0625f : 1.0f;
#pragma unroll 4
    for (int r = 0; r < 16; ++r) {
        unpk8(*(const v4u*)(QKM + (size_t)(r0 + r) * 2048 + c0), x0);
#pragma unroll
        for (int e = 0; e < 8; ++e) { const float y = b[e] + w[0][e] * xm3[e] + w[1][e] * xm2[e] + w[2][e] * xm1[e] + w[3][e] * x0[e]; o[e] = y * sigmf(y) * qs; xm3[e] = xm2[e]; xm2[e] = xm1[e]; xm1[e] = x0[e]; }
        const v4u ov = pk8(o);
        *(v4u*)(QKC + (size_t)(r0 + r) * 2048 + c0) = ov;
        if (cg >= 8) tile_put(T, 16 * rg + r, cc, ov);
    }
    if (cg >= 8) { LDS_WAIT(); asm volatile("" ::: "memory");
        const int kc = cg * 128 - 1024, hd = kc >> 8, d0 = kc & 255;
        tile_transpose_store(T, KT + (((size_t)c * 4 + hd) * 256 + d0) * 64, lane);
        LDS_WAIT(); asm volatile("" ::: "memory"); }
}
__device__ __forceinline__ void prep_vt_item(int it, int lane, LAS unsigned char* T, const bf16* VM, bf16* VT) {
    const int c = it >> 4, cg = it & 15, rg = lane >> 4, cc = lane & 15; v4u in[16];
#pragma unroll
    for (int r = 0; r < 16; ++r) in[r] = *(const v4u*)(VM + (size_t)(64 * c + 16 * rg + r) * 2048 + 128 * cg + 8 * cc);
#pragma unroll
    for (int r = 0; r < 16; ++r) tile_put(T, 16 * rg + r, cc, in[r]);
    LDS_WAIT(); asm volatile("" ::: "memory");
    const int hd = cg >> 2, v0 = (cg & 3) * 128;
    tile_transpose_store(T, VT + (((size_t)c * 4 + hd) * 512 + v0) * 64, lane);
    LDS_WAIT(); asm volatile("" ::: "memory");
}
__device__ __forceinline__ void prep_phase(Frame& F, const bf16* QKM, const bf16* VM, bf16* QKC, bf16* KT, bf16* VT, const float* cw, const float* cb) {
    if (blockIdx.x < 4) return;
    const int gw = ((int)blockIdx.x - 4) * NWAVES + F.wave, NGW = (F.G - 4) * NWAVES;
    LAS unsigned char* Tw = F.lds + F.wave * 16384;
    for (int it = gw; it < 4096; it += NGW) { if (it < 2048) prep_conv_item(it, F.lane, Tw, QKM, QKC, KT, cw, cb); else prep_vt_item(it - 2048, F.lane, Tw, VM, VT); }
}
__device__ __forceinline__ float logsig(float f) { return fminf(f, 0.f) - log1pf(__expf(-fabsf(f))); }
__device__ __forceinline__ void gate_scan(Frame& F, int hd, const float* GATES, float* MG, float* DEC) {
    LAS float* li = (LAS float*)F.lds; LAS float* lf = li + 128 * 65; LAS float* cm = lf + 128 * 65; LAS float* sb = cm + 128 * 65;
    for (int t = F.tid; t < S; t += NWAVES * 64) { const float* gp = GATES + (size_t)t * 8; const int k = (t >> 6) * 65 + (t & 63); li[k] = gp[hd]; lf[k] = logsig(gp[4 + hd]); }
    __syncthreads();
    const int c = F.tid;
    if (c < 128) { float b = 0.f, amax = -INFINITY;
        for (int s = 0; s < 64; ++s) { const int k = c * 65 + s; b += lf[k]; const float a = li[k] - b; amax = fmaxf(amax, a); lf[k] = b; li[k] = a; cm[k] = amax; }
        sb[c] = b; sb[128 + c] = b + amax; }
    __syncthreads();
    if (F.tid == 0) { float m = 0.f;
#pragma unroll 4
        for (int k4 = 0; k4 < 32; ++k4) { const f32x4 bl = *(const LAS f32x4*)(sb + 4 * k4), mx = *(const LAS f32x4*)(sb + 128 + 4 * k4); f32x4 mo;
            mo.x = m; m = fmaxf(bl.x + m, mx.x); mo.y = m; m = fmaxf(bl.y + m, mx.y); mo.z = m; m = fmaxf(bl.z + m, mx.z); mo.w = m; m = fmaxf(bl.w + m, mx.w);
            *(LAS f32x4*)(sb + 256 + 4 * k4) = mo; }
        sb[256 + 128] = m; }
    __syncthreads();
    float* mg = MG + (size_t)hd * 5 * S;
    for (int t = F.tid; t < S; t += NWAVES * 64) { const int cc = t >> 6, k = cc * 65 + (t & 63); const float mprev = sb[256 + cc], mnew = sb[256 + cc + 1], bL = sb[cc];
        const float b = lf[k], a = li[k], mt = b + fmaxf(mprev, cm[k]);
        mg[t] = b - mt; mg[S + t] = a; mg[2 * S + t] = __expf(b + mprev - mt); mg[3 * S + t] = __expf(-mt); mg[4 * S + t] = __expf(bL + a - mnew); }
    if (c < 128) DEC[hd * 128 + c] = __expf(sb[c] + sb[256 + c] - sb[256 + c + 1]);
    __syncthreads();
}

typedef float f32x16 __attribute__((ext_vector_type(16)));
constexpr int ML_QS = 0, ML_KS = 33792, ML_KT = 67584, ML_VT = 104448, ML_CB = 109056, ML_PS = 125952, ML_SC = 135168  , ML_DENP = 137856, ML_DQ = 138880, ML_NV = 139136, ML_VW = 140160, ML_END = 144768;
static_assert(ML_END <= LDSCTL_OFF, "mLSTM LDS map");
#define ML_SGB(mask, n) __builtin_amdgcn_sched_group_barrier(mask, n, 0)
#define ML_CHAIN_SCHED(N) do { ML_SGB(0x100, 8); _Pragma("unroll") for (int i_ = 0; i_ < (N) - 4; ++i_) { ML_SGB(0x008, 1); ML_SGB(0x100, 2); } ML_SGB(0x008, 4); } while (0)
template <int PV>
__device__ __forceinline__ void mlstm_p_producer(Frame& F, int hd, int par, const bf16* QKC, const bf16* KTg, const float* MG, const float* DEC, bf16* PG, float* DG, gu32* flag) {
    constexpr int PP_D = 3, PSC = ML_CB, PSCN = 400;
    LAS unsigned char* L = F.lds; const int tid = F.tid, lane = F.lane, wave = F.wave, r32 = lane & 31, hi = lane >> 5;
    const float* mgh = MG + (size_t)hd * 5 * S;
    ((LAS float*)(L + ML_NV))[tid] = 0.f;
    const int k0 = -par;
    if (wave < 4) {
        const unsigned glo = (unsigned)(((tid >> 5) * 1024 + 8 * (tid & 31)) * 2);
        LAS unsigned char* const lst = L + ((tid >> 5) & 1) * ML_KS + (tid >> 6) * 528 + (tid & 31) * 16;
        v4u rs[16]; float rsc0 = 0.f, rsc1 = 0.f, rsc2 = 0.f;
        const float* const scp0 = mgh + (size_t)(tid >> 6) * S + (tid & 63);
        const float* const scp1 = tid < 64 ? mgh + (size_t)4 * S + tid : DEC + hd * 128; const int scstep1 = tid < 64 ? 64 : 1;
        const int si = wave >> 1, ti = wave & 1, t = 32 * ti + r32;
#define PP_LDA(c) do { if ((c) >= 0) { const char* ub_ = (const char*)(QKC + (size_t)(64 * (c)) * 2048 + 256 * hd); \
            _Pragma("unroll") for (int i = 0; i < 16; ++i) rs[i] = *(const v4u*)(ub_ + (size_t)i * 16384 + glo); \
            rsc0 = scp0[64 * (c)]; rsc1 = scp1[(c) * scstep1]; } if ((c) + 1 < 128) rsc2 = scp1[((c) + 1) * scstep1]; } while (0)
        PP_LDA(par + 2 * k0);
        for (int k = k0; k < 64; ++k) { const int c = par + 2 * k;
            if (!(PV & 16) && c >= 0) {
#pragma unroll
                for (int i = 0; i < 16; ++i) *(LAS v4u*)(lst + i * 2112) = rs[i]; }
            { LAS float* SCw = (LAS float*)(L + PSC) + (k & 1) * PSCN; SCw[tid] = rsc0; if (tid <= 64) { SCw[256 + tid] = rsc1; SCw[324 + tid] = rsc2; } }
            if (!(PV & 8) && k + 1 < 64) PP_LDA(c + 2);
            __syncthreads();
            if (tid == 0 && k > PP_D) __hip_atomic_store(flag, (unsigned)(k - PP_D), RLX_AGENT);
            if (c >= 0) {
            const LAS float* SC = (const LAS float*)(L + PSC) + (k & 1) * PSCN;
            f32x16 acc;
#pragma unroll
            for (int r = 0; r < 16; ++r) acc[r] = 0.f;
            const LAS unsigned char* ka = L + ML_KS + (32 * si + r32) * 528 + hi * 16; const LAS unsigned char* qb = L + ML_QS + (32 * ti + r32) * 528 + hi * 16;
            if (!(PV & 2)) {
#pragma unroll
                for (int kk = 0; kk < 16; ++kk) acc = __builtin_amdgcn_mfma_f32_32x32x16_bf16(*(const LAS bf16x8*)(ka + kk * 32), *(const LAS bf16x8*)(qb + kk * 32), acc, 0, 0, 0);
                ML_CHAIN_SCHED(16); }
            const float rt_ = SC[t]; float dsum = 0.f;
            if (!(PV & 64)) {
#pragma unroll
            for (int g = 0; g < 4; ++g) { const int s0 = 32 * si + 8 * g + 4 * hi; float p[4];
#pragma unroll
                for (int e = 0; e < 4; ++e) { const int s = s0 + e; const float wgt = (s <= t) ? __expf(rt_ + SC[64 + s]) : 0.f; p[e] = acc[4 * g + e] * wgt; dsum += p[e]; }
                *(LAS unsigned long long*)(L + ML_PS + t * 144 + s0 * 2) = (unsigned long long)pg8::cvt_pk_bf16(p[0], p[1]) | ((unsigned long long)pg8::cvt_pk_bf16(p[2], p[3]) << 32); } }
            ((LAS float*)(L + ML_DENP))[(si * 2 + hi) * 64 + t] = dsum;
            }
            __syncthreads();
        }
#undef PP_LDA
    } else if (wave < 6) {
        v4u rkx[16], rky[16]; f32x16 na[4];
#pragma unroll
        for (int j = 0; j < 4; ++j) {
#pragma unroll
            for (int r = 0; r < 16; ++r) na[j][r] = 0.f; }
        const int dn = 128 * (wave & 1) + r32;
#define PP_LDKT(R, c) do { _Pragma("unroll") for (int j = 0; j < 4; ++j) { _Pragma("unroll") for (int kk = 0; kk < 4; ++kk) \
        R[4 * j + kk] = *(const v4u*)(KTg + (((size_t)(c) * 4 + hd) * 256 + dn + 32 * j) * 64 + 16 * kk + 8 * hi); } } while (0)
#define PP_NUPD(R, wp_, dcy_) do { const float dc_ = (dcy_); const LAS float* wsl_ = (wp_) + 8 * hi; \
            _Pragma("unroll") for (int j = 0; j < 4; ++j) { _Pragma("unroll") for (int r = 0; r < 16; ++r) na[j][r] *= dc_; } \
            _Pragma("unroll") for (int kk = 0; kk < 4; ++kk) { const f32x4 w0 = *(const LAS f32x4*)(wsl_ + 16 * kk), w1 = *(const LAS f32x4*)(wsl_ + 16 * kk + 4); \
                const v4u wp = (v4u){pg8::cvt_pk_bf16(w0.x, w0.y), pg8::cvt_pk_bf16(w0.z, w0.w), pg8::cvt_pk_bf16(w1.x, w1.y), pg8::cvt_pk_bf16(w1.z, w1.w)}; \
                _Pragma("unroll") for (int j = 0; j < 4; ++j) na[j] = __builtin_amdgcn_mfma_f32_32x32x16_bf16(__builtin_bit_cast(bf16x8, R[4 * j + kk]), __builtin_bit_cast(bf16x8, wp), na[j], 0, 0, 0); } } while (0)
        { const int c0 = par + 2 * k0; if (c0 >= 0) PP_LDKT(rkx, c0); PP_LDKT(rky, c0 + 1); }
        for (int k = k0; k < 64; ++k) { const int c = par + 2 * k;
            __syncthreads();
            const LAS float* SC = (const LAS float*)(L + PSC) + (k & 1) * PSCN;
            if (!(PV & 4)) {
                if (c >= 0) PP_NUPD(rkx, SC + 256, SC[320]);
                if (!(PV & 8) && k + 1 < 64) PP_LDKT(rkx, c + 2);
                if (c + 1 < 128) PP_NUPD(rky, SC + 324, SC[388]);
                if (!(PV & 8) && k + 1 < 64 && c + 3 < 128) PP_LDKT(rky, c + 3);
                if (r32 == 0) { LAS float* nv = (LAS float*)(L + ML_NV) + ((k + 1) & 1) * 256 + 128 * (wave & 1) + 4 * hi;
#pragma unroll
                    for (int j = 0; j < 4; ++j) {
#pragma unroll
                        for (int g = 0; g < 4; ++g) *(LAS f32x4*)(nv + 32 * j + 8 * g) = (f32x4){na[j][4 * g], na[j][4 * g + 1], na[j][4 * g + 2], na[j][4 * g + 3]}; } } }
            __syncthreads();
        }
#undef PP_NUPD
#undef PP_LDKT
    } else {
        const int tq = 32 * (wave & 1) + r32, l = tid - 384, t = l >> 1;
        for (int k = k0; k < 64; ++k) { const int c = par + 2 * k;
            __syncthreads();
            const LAS float* SC = (const LAS float*)(L + PSC) + (k & 1) * PSCN;
            if (!(PV & 1) && c >= 0) { const LAS unsigned char* qp = L + ML_QS + tq * 528 + hi * 256; const LAS float* nv = (const LAS float*)(L + ML_NV) + (k & 1) * 256 + hi * 128; float a = 0.f;
#pragma unroll
              for (int j = 0; j < 16; ++j) { float qf[8]; unpk8(*(const LAS v4u*)(qp + j * 16), qf); const f32x4 n0 = *(const LAS f32x4*)(nv + 8 * j), n1 = *(const LAS f32x4*)(nv + 8 * j + 4);
                  a += ((qf[0] * n0.x + qf[1] * n0.y) + (qf[2] * n0.z + qf[3] * n0.w)) + ((qf[4] * n1.x + qf[5] * n1.y) + (qf[6] * n1.z + qf[7] * n1.w)); }
              a = add_halves(a);
              if (hi == 0) ((LAS float*)(L + ML_DQ))[tq] = a; }
            __syncthreads();
            if (!(PV & 32) && c >= 0) {
            const LAS v4u* sp = (const LAS v4u*)(L + ML_PS + t * 144 + (l & 1) * 64);
            bf16* gp = PG + (((size_t)hd * 128 + c) * 64 + t) * 64 + 32 * (l & 1);
#pragma unroll
            for (int kq = 0; kq < 4; ++kq) { const v4u pv = sp[kq]; asm volatile("global_store_dwordx4 %0, %1, off sc1" :: "v"(gp + 8 * kq), "v"(pv) : "memory"); }
            if (wave == 6) { const LAS float* dp = (const LAS float*)(L + ML_DENP);
                const float den = SC[128 + l] * ((const LAS float*)(L + ML_DQ))[l] + ((dp[l] + dp[64 + l]) + (dp[128 + l] + dp[192 + l]));
                __hip_atomic_store((unsigned*)(DG + ((size_t)hd * 128 + c) * 64 + l), __float_as_uint(den), RLX_AGENT);
                asm volatile("s_waitcnt vmcnt(15)" ::: "memory"); }
            else asm volatile("s_waitcnt vmcnt(12)" ::: "memory");
            }
        }
    }
    asm volatile("s_waitcnt vmcnt(0)" ::: "memory");
    __syncthreads();
    if (tid == 0) __hip_atomic_store(flag, 64u, RLX_AGENT);
    __syncthreads();
}

template <int VAR>
__device__ __forceinline__ void mlstm_unit(Frame& F, int hd, int vs, const bf16* QKC, const bf16* KTg, const bf16* VTg, const float* MG, const float* DEC, bf16* HM,
                                           const bf16* PG, const float* DG, gu32* flag) {
    LAS unsigned char* L = F.lds; const int tid = F.tid, lane = F.lane, wave = F.wave, r32 = lane & 31, hi = lane >> 5;
    for (int i = tid; i < (ML_PS - ML_CB) / 4; i += 512) ((LAS unsigned*)(L + ML_CB))[i] = 0u;
    f32x16 cacc;
#pragma unroll
    for (int r = 0; r < 16; ++r) cacc[r] = 0.f;
    const float* mgh = MG + (size_t)hd * 5 * S;
    v4u rq[2][4], rt[2][4], rv[2]; float rsc[2], rden[2]; unsigned long long rp0[2], rp1[2];
    const int sq = tid >> 5, dc = tid & 31;
    const int vv = tid >> 3, sc8 = tid & 7;
    const float* const scp = tid < 320 ? mgh + (size_t)(tid >> 6) * S + (tid & 63) : DEC + hd * 128; const int scstep = tid < 320 ? 64 : 1;
    const int vvc = vv & 31;
    unsigned pub0 = 0u, pub1 = 0u;
#define ML_NEED(c, P) do { const unsigned nd_ = (unsigned)(((c) >> 1) + 1); if (pub##P < nd_) { unsigned sp_ = 0u; do { pub##P = (unsigned)__builtin_amdgcn_readfirstlane(__hip_atomic_load(flag + 8 * P, RLX_AGENT)); if (pub##P >= nd_) break; __builtin_amdgcn_s_sleep(4); } while (++sp_ < (1u << 16)); } } while (0)
#define ML_LOAD_Q(c, P) do { \
        _Pragma("unroll") for (int i = 0; i < 4; ++i) rq[P][i] = *(const v4u*)(QKC + (size_t)(64 * (c) + sq + 16 * i) * 2048 + 256 * hd + 8 * dc); \
        rsc[P] = scp[(c) * scstep]; } while (0)
#define ML_LOAD_TV(c, P) do { const int t0_ = 64 * (c); ML_NEED(c, P); \
        _Pragma("unroll") for (int i = 0; i < 4; ++i) rt[P][i] = *(const v4u*)(KTg + (((size_t)(c) * 4 + hd) * 256 + vv + 64 * i) * 64 + 8 * sc8); \
        { const unsigned long long* pp_ = (const unsigned long long*)(PG + (((size_t)hd * 128 + (c)) * 64 + vv) * 64 + 8 * sc8); rp0[P] = __hip_atomic_load(pp_, RLX_AGENT); rp1[P] = __hip_atomic_load(pp_ + 1, RLX_AGENT); } \
        rden[P] = __uint_as_float(__hip_atomic_load((const unsigned*)(DG + ((size_t)hd * 128 + (c)) * 64 + (tid & 63)), RLX_AGENT)); \
        rv[P] = *(const v4u*)(VTg + (((size_t)(c) * 4 + hd) * 512 + 32 * vs + vvc) * 64 + 8 * sc8); (void)t0_; } while (0)
#define ML_STORE_Q(c, P) do { _Pragma("unroll") for (int i = 0; i < 4; ++i) *(LAS v4u*)(L + ML_QS + (sq + 16 * i) * 528 + dc * 16) = rq[P][i]; \
        if (tid <= 320) ((LAS float*)(L + ML_SC))[((c) & 1) * 336 + tid] = rsc[P]; } while (0)
#define ML_STORE_TV(P) do { _Pragma("unroll") for (int i = 0; i < 4; ++i) *(LAS v4u*)(L + ML_KT + (vv + 64 * i) * 144 + sc8 * 16) = rt[P][i]; \
        { LAS unsigned long long* ps_ = (LAS unsigned long long*)(L + ML_PS + vv * 144 + sc8 * 16); ps_[0] = rp0[P]; ps_[1] = rp1[P]; } \
        if (tid < 64) ((LAS float*)(L + ML_DENP))[tid] = rden[P]; \
        if (tid < 256) { *(LAS v4u*)(L + ML_VT + vv * 144 + sc8 * 16) = rv[P]; \
            const f32x4 w0_ = *(const LAS f32x4*)(L + ML_SC + (P * 336 + 256 + 8 * sc8) * 4), w1_ = *(const LAS f32x4*)(L + ML_SC + (P * 336 + 256 + 8 * sc8 + 4) * 4);     \
            float vf[8]; unpk8(rv[P], vf); vf[0] *= w0_.x; vf[1] *= w0_.y; vf[2] *= w0_.z; vf[3] *= w0_.w; vf[4] *= w1_.x; vf[5] *= w1_.y; vf[6] *= w1_.z; vf[7] *= w1_.w; \
            *(LAS v4u*)(L + ML_VW + vv * 144 + sc8 * 16) = pk8(vf); } } while (0)
#define ML_STEP(c, P) do { \
        if (!(VAR & 32)) ML_STORE_TV(P); \
        if (!(VAR & 16) && (c) + 2 < 128) ML_LOAD_TV((c) + 2, P); \
        const LAS float* SC = (const LAS float*)(L + ML_SC) + P * 336; \
        f32x16 hacc; \
        if (!(VAR & 4) && (wave == 4 || wave == 5 || wave < 2)) { \
            const int ti = wave & 1, kh = wave < 2 ? 1 : 0; \
            _Pragma("unroll") for (int r = 0; r < 16; ++r) hacc[r] = 0.f; \
            const LAS unsigned char* ca = L + ML_CB + r32 * 528 + hi * 16 + kh * 256; const LAS unsigned char* qb = L + ML_QS + (32 * ti + r32) * 528 + hi * 16 + kh * 256; \
            _Pragma("unroll") for (int kk = 0; kk < 8; ++kk) hacc = __builtin_amdgcn_mfma_f32_32x32x16_bf16(*(const LAS bf16x8*)(ca + kk * 32), *(const LAS bf16x8*)(qb + kk * 32), hacc, 0, 0, 0); \
            ML_CHAIN_SCHED(8); \
            if (wave < 2) { \
                _Pragma("unroll") for (int g = 0; g < 4; ++g) *(LAS f32x4*)(L + ML_KS + wave * 4096 + g * 1024 + lane * 16) = (f32x4){hacc[4 * g], hacc[4 * g + 1], hacc[4 * g + 2], hacc[4 * g + 3]}; } \
        } \
        __syncthreads(); \
        if (!(VAR & 64) && (wave == 4 || wave == 5)) { \
            const int ti = wave - 4, t = 32 * ti + r32; const float wi = SC[128 + t], nr = SC[192 + t]; \
            const float den = ((const LAS float*)(L + ML_DENP))[t];     \
            _Pragma("unroll") for (int g = 0; g < 4; ++g) { const f32x4 px = *(const LAS f32x4*)(L + ML_KS + ti * 4096 + g * 1024 + lane * 16); \
                hacc[4 * g] = (hacc[4 * g] + px.x) * wi; hacc[4 * g + 1] = (hacc[4 * g + 1] + px.y) * wi; hacc[4 * g + 2] = (hacc[4 * g + 2] + px.z) * wi; hacc[4 * g + 3] = (hacc[4 * g + 3] + px.w) * wi; } \
            const LAS unsigned char* va = L + ML_VT + r32 * 144 + hi * 16; const LAS unsigned char* pb = L + ML_PS + t * 144 + hi * 16; \
            __builtin_amdgcn_sched_barrier(0); \
            _Pragma("unroll") for (int kk = 0; kk < 4; ++kk) hacc = __builtin_amdgcn_mfma_f32_32x32x16_bf16(*(const LAS bf16x8*)(va + kk * 32), *(const LAS bf16x8*)(pb + kk * 32), hacc, 0, 0, 0); \
            ML_SGB(0x100, 8); ML_SGB(0x008, 4); __builtin_amdgcn_sched_barrier(0); \
            const float inv = 1.0f / fmaxf(fabsf(den), nr); \
            bf16* op = HM + (size_t)(64 * (c) + t) * 2048 + 512 * hd + 32 * vs + 4 * hi; \
            _Pragma("unroll") for (int g = 0; g < 4; ++g) *(unsigned long long*)(op + 8 * g) = (unsigned long long)pg8::cvt_pk_bf16(hacc[4 * g] * inv, hacc[4 * g + 1] * inv) | ((unsigned long long)pg8::cvt_pk_bf16(hacc[4 * g + 2] * inv, hacc[4 * g + 3] * inv) << 32); \
        } \
        if (!(VAR & 8)) { const float dcy = SC[320]; \
          _Pragma("unroll") for (int r = 0; r < 16; ++r) cacc[r] *= dcy; \
          const LAS unsigned char* ka = L + ML_KT + (32 * wave + r32) * 144 + hi * 16; const LAS unsigned char* vb = L + ML_VW + r32 * 144 + hi * 16; \
          __builtin_amdgcn_sched_barrier(0); \
          _Pragma("unroll") for (int kk = 0; kk < 4; ++kk) cacc = __builtin_amdgcn_mfma_f32_32x32x16_bf16(*(const LAS bf16x8*)(ka + kk * 32), *(const LAS bf16x8*)(vb + kk * 32), cacc, 0, 0, 0); \
          ML_SGB(0x100, 8); ML_SGB(0x008, 4); __builtin_amdgcn_sched_barrier(0); \
          _Pragma("unroll") for (int g = 0; g < 4; ++g) *(LAS unsigned long long*)(L + ML_CB + r32 * 528 + (32 * wave + 8 * g + 4 * hi) * 2) = (unsigned long long)pg8::cvt_pk_bf16(cacc[4 * g], cacc[4 * g + 1]) | ((unsigned long long)pg8::cvt_pk_bf16(cacc[4 * g + 2], cacc[4 * g + 3]) << 32); \
        } \
        if ((c) + 1 < 128) { if (!(VAR & 32)) ML_STORE_Q((c) + 1, 1 - P); if (!(VAR & 16) && (c) + 3 < 128) ML_LOAD_Q((c) + 3, 1 - P); } \
        __syncthreads(); } while (0)
    ML_LOAD_Q(0, 0); ML_LOAD_TV(0, 0); ML_LOAD_Q(1, 1); ML_LOAD_TV(1, 1);
    ML_STORE_Q(0, 0);
    ML_LOAD_Q(2, 0);
    __syncthreads();
#pragma nounroll
    for (int c = 0; c < 128; c += 2) { ML_STEP(c, 0); ML_STEP(c + 1, 1); }
#undef ML_STEP
#undef ML_NEED
#undef ML_LOAD_Q
#undef ML_LOAD_TV
#undef ML_STORE_Q
#undef ML_STORE_TV
}

__device__ __forceinline__ void post_phase(Frame& F, const bf16* HM, const bf16* OG, const bf16* O1, const bf16* O2, const float* gm, const float* gd, const float* lmb, float lam_init, bf16* AM, bf16* AB) {
    const float lam = expf(wave_sum(lmb[F.lane] * lmb[64 + F.lane])) - expf(wave_sum(lmb[128 + F.lane] * lmb[192 + F.lane])) + lam_init;
    const float omli = 1.0f - lam_init;
    LAS f32x4* GM = (LAS f32x4*)F.lds; LAS f32x4* GD = GM + 512;
    GM[F.tid] = ((const f32x4*)gm)[F.tid]; GD[F.tid] = ((const f32x4*)gd)[F.tid] * omli;
    __syncthreads();
    const int gw = F.vcu * NWAVES + F.wave, NGW = F.G * NWAVES;
    v4u a0[4][4], a1[4][4];
#define PP_LOAD(Bf, row) do { _Pragma("unroll") for (int j = 0; j < 4; ++j) { const size_t off = (size_t)(row) * 2048 + 8 * F.lane + 512 * j; \
        Bf[j][0] = *(const v4u*)(HM + off); Bf[j][1] = *(const v4u*)(OG + off); Bf[j][2] = *(const v4u*)(O1 + off); Bf[j][3] = *(const v4u*)(O2 + off); } } while (0)
#define PP_PROC(Bf, row) do { _Pragma("unroll") for (int j = 0; j < 4; ++j) { const size_t off = (size_t)(row) * 2048 + 8 * F.lane + 512 * j; \
        float h[8], og[8], o1[8], o2[8], o[8]; unpk8(Bf[j][0], h); unpk8(Bf[j][1], og); unpk8(Bf[j][2], o1); unpk8(Bf[j][3], o2); \
        const f32x4 ga0 = GM[2 * F.lane + 128 * j], ga1 = GM[2 * F.lane + 128 * j + 1], gb0 = GD[2 * F.lane + 128 * j], gb1 = GD[2 * F.lane + 128 * j + 1]; \
        const float ga[8] = {ga0.x, ga0.y, ga0.z, ga0.w, ga1.x, ga1.y, ga1.z, ga1.w}, gb[8] = {gb0.x, gb0.y, gb0.z, gb0.w, gb1.x, gb1.y, gb1.z, gb1.w}; \
        float ss = 0.f, sd = 0.f; \
        _Pragma("unroll") for (int e = 0; e < 8; ++e) { ss += h[e] * h[e]; o[e] = o1[e] - lam * o2[e]; sd += o[e] * o[e]; } \
        ss = wave_sum(ss); sd += xor_lanes<1>(sd); sd += xor_lanes<2>(sd); sd += xor_lanes<4>(sd); sd += xor_lanes<8>(sd); \
        const float rm = 1.0f / sqrtf(ss * (1.0f / 512.0f) + EPS), rd = 1.0f / sqrtf(sd * (1.0f / 128.0f) + EPS); \
        _Pragma("unroll") for (int e = 0; e < 8; ++e) { h[e] = og[e] * (h[e] * rm * ga[e]); o[e] = o[e] * rd * gb[e]; } \
        const size_t off2 = (size_t)(row) * 4096 + 8 * F.lane + 512 * j; *(v4u*)(AM + off2 + 2048) = pk8(h); *(v4u*)(AM + off2) = pk8(o); } } while (0)
    int row = gw;
    if (row < S) PP_LOAD(a0, row);
    for (; row < S; row += 2 * NGW) {
        const int r1 = row + NGW, r2 = row + 2 * NGW;
        if (r1 < S) PP_LOAD(a1, r1);
        PP_PROC(a0, row);
        if (r2 < S) PP_LOAD(a0, r2);
        if (r1 < S) PP_PROC(a1, r1);
    }
#undef PP_LOAD
#undef PP_PROC
    __syncthreads();
}

__device__ __forceinline__ void drain_copy_queue(Frame& F, const __attribute__((address_space(4))) Args* A, unsigned char* ws, gu32* qc, int l) {
    const int n_own = WI_LAYER - WI_IN, n_conv = n_own + (l + 1 < DEPTH ? WI_IN : 0), n_items = n_conv + (l + 1 < DEPTH ? 1536 : 0); LAS float* scr = (LAS float*)(F.lds + F.wave * 16640);
    static_assert((WI_LAYER - WI_IN) % 32 == 0 && WI_IN % 32 == 0 && 1536 % 32 == 0, "copy-queue groups");
    for (;;) {
        __syncthreads();
        if (F.tid == 0) F.MISC[0] = __hip_atomic_fetch_add(qc, 1u, RLX_AGENT);
        __syncthreads();
        const int base = (int)F.MISC[0] * 32;
        if (base >= n_items) break;
        if (base >= n_conv) {
#pragma unroll 1
            for (int j = 0; j < 4; ++j) adaln_item(A->in[1], A->in[3], ws, l + 1, base - n_conv + 8 * j + F.wave, F.lane);
        } else {
#define DCQ_DESC(j, d) witem_desc(A->in[9], A->in[17], A->in[18], A->in[19], A->in[20], A->in[21], A->in[24], ws, (base + 8 * (j) + F.wave) < n_own ? l : l + 1, \
                                  (base + 8 * (j) + F.wave) < n_own ? base + 8 * (j) + F.wave + WI_IN : base + 8 * (j) + F.wave - n_own, F.lane, d)
            WItem d0, d1; f32x4 va[16], vb[16];
            const int l0 = DCQ_DESC(0, d0); WITEM_ISSUE(d0, l0, va);
            const int l1 = DCQ_DESC(1, d1); WITEM_ISSUE(d1, l1, vb);
            witem_finish(d0, va, scr, F.lane);
            const int l2 = DCQ_DESC(2, d0); WITEM_ISSUE(d0, l2, va);
            witem_finish(d1, vb, scr, F.lane);
            const int l3 = DCQ_DESC(3, d1); WITEM_ISSUE(d1, l3, vb);
            witem_finish(d0, va, scr, F.lane);
            witem_finish(d1, vb, scr, F.lane);
#undef DCQ_DESC
        }
    }
}

typedef const __attribute__((address_space(4))) Args* CArgs;
__device__ __forceinline__ CArgs get_args() { CArgs p = (CArgs)__builtin_amdgcn_kernarg_segment_ptr(); asm volatile("" : "+s"(p)); return p; }
#define P8B(ws, i) ((bf16*)((ws) + WS_P8 + (size_t)(i) * P8_STRIDE))
__global__ void __launch_bounds__(NWAVES * 64, 2) trunk_fwd(Args args_unused) {
    extern __shared__ __attribute__((aligned(16))) unsigned char lds[];
    Frame F;
    F.lds = (LAS unsigned char*)lds; F.MISC = (volatile LAS unsigned*)(F.lds + MISC_OFF);
    F.tid = threadIdx.x; F.lane = F.tid & 63; F.wave = __builtin_amdgcn_readfirstlane(F.tid >> 6);
    F.G = gridDim.x; { const int bx = blockIdx.x; F.vcu = (F.G % 8 == 0) ? (bx % 8) * (F.G / 8) + bx / 8 : bx; }
    F.ctl = (gu32*)(get_args()->ws + WS_CTL);
#ifdef DBG_POISON
    for (int u = F.tid; u < LDSCTL_OFF / 4; u += NWAVES * 64) ((LAS unsigned*)F.lds)[u] = 0xAAAAAAAAu;
#endif
    for (int u = F.tid; u < (LDS_BYTES - LDSCTL_OFF) / 4; u += NWAVES * 64) ((LAS unsigned*)(F.lds + LDSCTL_OFF))[u] = 0u;
    __syncthreads();
#if MK_ONE_LAUNCH
    XcdBarrier bar = xcd_barrier_post((unsigned*)(F.ctl + CW_BAR), F.MISC + 8);
#define GRID_BAR() do { XcdBarrier b_ = bar; asm volatile("" : "+s"(b_.bar)); xcd_barrier(b_); } while (0)
#else
#define GRID_BAR() do { } while (0)
#endif
#ifdef PROF_K1
#ifndef PROF_SHIFT
#define PROF_SHIFT 0.5f
#endif
    LAS unsigned long long* pacc = (LAS unsigned long long*)(F.lds + LDSCTL_OFF);
    if (blockIdx.x == 0 && F.tid == 0) pacc[15] = rt();
#define PROF_MARK(k) do { if (blockIdx.x == 0 && F.wave == 0 && fresh_tid(0) == 0) { const unsigned long long t_ = rt(); pacc[k] += t_ - pacc[15]; pacc[15] = t_; } } while (0)
#else
#define PROF_MARK(k) do { } while (0)
#endif
    const int lo = get_args()->ph_lo, hi = get_args()->ph_hi;
#ifndef PH_MASK
#define PH_MASK 0xFFFFFFFFu
#endif
#define EN(k) ((PH_MASK >> (k)) & 1u)
#ifndef DUPMASK
#define DUPMASK 0u
#endif
#ifndef DUPMODE
#define DUPMODE 1
#endif
#define REPS(k) (1 + (int)((DUPMASK >> (k)) & 1u))
#define IN(k) (lo <= (k) && (k) < hi)
#define BOTH(k) (IN(k) && IN((k) + 1))
    if (EN(13) && IN(0)) {
#pragma nounroll
        for (int rep = 0; rep < REPS(13); ++rep) { p0_prologue(F, get_args()); if (BOTH(0) || rep + 1 < REPS(13)) GRID_BAR(); } PROF_MARK(13); }
    if (EN(14) && IN(1)) { p0b_mod_reduce(F, get_args(), 0); if (BOTH(1)) GRID_BAR(); PROF_MARK(14); }
#ifdef XBARS
#pragma nounroll
    for (int xb = 0; xb < XBARS; ++xb) GRID_BAR();
#endif

    for (int l = 0; l < DEPTH; ++l) {
        const int pb = 2 + NPH_LAYER * l;
        if (EN(0) && IN(pb + 0) && l == 0) { { CArgs A = get_args(); unsigned char* ws = A->ws; F.tid = fresh_tid(F.wave); F.lane = F.tid & 63; const float* mod = (const float*)(ws + WS_MOD);
                row_phase<false, true, true>(F, A->in[0], nullptr, nullptr, nullptr, nullptr, A->in[5], mod + D, mod, (bf16*)(ws + WS_H), (const float*)(ws + WS_WG), A->in[12], A->in[13], (float*)(ws + WS_GATES)); }
            if (BOTH(pb + 0)) GRID_BAR(); PROF_MARK(0); }
        if (EN(1) && IN(pb + 1))
#pragma nounroll
        for (int rep = 0; rep < REPS(1); ++rep) { CArgs A = get_args(); unsigned char* ws = A->ws; F.tid = fresh_tid(F.wave); F.lane = F.tid & 63; const float* ropeC = (const float*)(ws + WS_ROPE);
            pg8::Gemm g{(const bf16*)(ws + WS_H), (const bf16*)(ws + WS_W + (size_t)l * W_LAYER + WO_IN), S, NINP, D}; pg8::StaticOrder So; So.init(S, NINP, F.G, (int)blockIdx.x);
            pg8::EpiIn E{P8B(ws, 0), P8_STRIDE / 2, ropeC, ropeC + S * 8, attn_body::C2};
            pg8::gemm_phase<pg8::EpiIn, pg8::StaticOrder, true, true>(F.lds, g, So, E, F.wave);
            if (BOTH(pb + 1) || rep + 1 < REPS(1)) GRID_BAR(); PROF_MARK(1); }
        if (EN(2) && IN(pb + 2))
#pragma nounroll
        for (int rep = 0; rep < REPS(2); ++rep) { CArgs A = get_args(); unsigned char* ws = A->ws; F.tid = fresh_tid(F.wave); F.lane = F.tid & 63;
            prep_phase(F, P8B(ws, 0), P8B(ws, 1), (bf16*)(ws + WS_QKC), (bf16*)(ws + WS_KT), (bf16*)(ws + WS_VT), A->in[10] + (size_t)l * 4 * 2048, A->in[11] + (size_t)l * 2048);
            __syncthreads();
            if (blockIdx.x < 4) gate_scan(F, (int)blockIdx.x, (const float*)(ws + WS_GATES), (float*)(ws + WS_MG), (float*)(ws + WS_DEC));
            if (BOTH(pb + 2) || rep + 1 < REPS(2)) GRID_BAR(); PROF_MARK(2); }
        if (EN(3) && IN(pb + 3))
#pragma nounroll
        for (int rep = 0; rep < REPS(3); ++rep) { CArgs A = get_args(); unsigned char* ws = A->ws; F.tid = fresh_tid(F.wave); F.lane = F.tid & 63; __syncthreads();
            {
#ifndef PVAR
#define PVAR 0
#endif
#ifndef MLVAR
#define MLVAR 0
#endif
#ifndef TPROBE_REP
#define TPROBE_REP 0
#endif
#ifdef TPROBE_WG
            unsigned long long tp0_ = 0ull; if ((int)blockIdx.x == TPROBE_WG && l == TPROBE_L && rep == TPROBE_REP) tp0_ = rt();
#endif
            { const int ph = ((int)blockIdx.x - 128) >> 1, pp = ((int)blockIdx.x - 128) & 1, ch = (int)blockIdx.x >> 4; const bool dupml = DUPMODE == 1 || DUPMODE == 4;
              gu32* const pfl = F.ctl + CW_PF + 64 * (4 * l) + 32 * rep;
              if (rep == 0 && blockIdx.x >= 128 && blockIdx.x < 136) mlstm_p_producer<0>(F, ph, pp, (const bf16*)(ws + WS_QKC), (const bf16*)(ws + WS_KT), (const float*)(ws + WS_MG), (const float*)(ws + WS_DEC), (bf16*)(ws + WS_PG), (float*)(ws + WS_DG), pfl + 64 * ph + 8 * pp);
              if (rep == 1 && (dupml || DUPMODE == 5) && blockIdx.x >= 128 && blockIdx.x < 136) mlstm_p_producer<PVAR>(F, ph, pp, (const bf16*)(ws + WS_QKC), (const bf16*)(ws + WS_KT), (const float*)(ws + WS_MG), (const float*)(ws + WS_DEC), (bf16*)(ws + WS_PG), (float*)(ws + WS_DG), pfl + 64 * ph + 8 * pp);
              if (rep == 0 && blockIdx.x < 64) mlstm_unit<0>(F, ch, (int)blockIdx.x & 15, (const bf16*)(ws + WS_QKC), (const bf16*)(ws + WS_KT), (const bf16*)(ws + WS_VT), (const float*)(ws + WS_MG), (const float*)(ws + WS_DEC), (bf16*)(ws + WS_HM),
                                            (const bf16*)(ws + WS_PG), (const float*)(ws + WS_DG), pfl + 64 * ch);
              if (rep == 1 && (dupml || DUPMODE == 3 || DUPMODE == 6) && blockIdx.x < 64) mlstm_unit<MLVAR>(F, ch, (int)blockIdx.x & 15, (const bf16*)(ws + WS_QKC), (const bf16*)(ws + WS_KT), (const bf16*)(ws + WS_VT), (const float*)(ws + WS_MG), (const float*)(ws + WS_DEC),
                                            (bf16*)(ws + ((MLVAR != 0 || PVAR != 0) ? WS_T : WS_HM)), (const bf16*)(ws + WS_PG), (const float*)(ws + WS_DG), pfl + 64 * ch - (dupml ? 0 : 32));
            }
#ifdef TPROBE_WG
            if ((int)blockIdx.x == TPROBE_WG && l == TPROBE_L && rep == TPROBE_REP && F.tid == 0) { const unsigned long long d_ = rt() - tp0_; __hip_atomic_store(F.ctl + 2040, (unsigned)d_, RLX_AGENT); }
#endif
            }
            if (blockIdx.x >= 64 && blockIdx.x < 64 + CONV_WGS && rep == 0) drain_copy_queue(F, A, ws, F.ctl + CW_Q + 64 * (8 + l), l);
            gu32* qh = F.ctl + CW_Q + 64 * (l + 4 * rep);
            const attn_body::bf16* Qb = (const attn_body::bf16*)P8B(ws, 3); const attn_body::bf16* Kb = (const attn_body::bf16*)P8B(ws, 4); const attn_body::bf16* Vb = (const attn_body::bf16*)P8B(ws, 5);
            attn_body::bf16* O1 = (attn_body::bf16*)(ws + WS_O1); attn_body::bf16* O2 = (attn_body::bf16*)(ws + WS_O2);
            for (;;) {
                __syncthreads();
                if (F.tid == 0) F.MISC[0] = __hip_atomic_fetch_add(qh, 1u, RLX_AGENT);
                __syncthreads();
                const unsigned idx = F.MISC[0];
                if (idx >= 1024u || (rep == 1 && (DUPMODE == 3 || DUPMODE == 4 || DUPMODE == 5))) break;
                const int qb = 31 - (int)(idx >> 5), bh = (int)(idx & 31u), hh = bh >> 1, cm = bh & 1;
                attn_body::attn_unit<8>(qb, Qb + hh * 128 + cm * 64, Kb + hh * 128 + cm * 64, Vb + hh * 128, (cm ? O2 : O1) + hh * 128, (char*)lds, F.wave);
            }
            if (BOTH(pb + 3) || rep + 1 < REPS(3)) GRID_BAR(); PROF_MARK(3); }
        if (EN(5) && IN(pb + 5))
#pragma nounroll
        for (int rep = 0; rep < REPS(5); ++rep) { CArgs A = get_args(); unsigned char* ws = A->ws; F.tid = fresh_tid(F.wave); F.lane = F.tid & 63;
            if (l + 1 < DEPTH && rep == 0) p0b_mod_reduce(F, A, l + 1);
            post_phase(F, (const bf16*)(ws + WS_HM), P8B(ws, 2), (const bf16*)(ws + WS_O1), (const bf16*)(ws + WS_O2), A->in[14] + (size_t)l * 2048, A->in[16] + (size_t)l * 2048, A->in[15] + (size_t)l * 256,
                       0.8f - 0.6f * expf(-0.3f * (float)l), (bf16*)(ws + WS_AM), (bf16*)(ws + WS_AB));
            if (BOTH(pb + 5) || rep + 1 < REPS(5)) GRID_BAR(); PROF_MARK(5); }
        if (EN(6) && IN(pb + 6))
#pragma nounroll
        for (int rep = 0; rep < REPS(6); ++rep) { CArgs A = get_args(); unsigned char* ws = A->ws; F.tid = fresh_tid(F.wave); F.lane = F.tid & 63; __syncthreads();
            pg8::Gemm g{(const bf16*)(ws + WS_AM), (const bf16*)(ws + WS_W + (size_t)l * W_LAYER + WO_A), S, D, 2 * D}; pg8::SplitK2Order So; So.base.init(S, D, F.G, (int)blockIdx.x);
            pg8::EpiMerge2 E{P8B(ws, 6), P8B(ws, 7), (bf16*)(ws + WS_MRG)};
            pg8::gemm_phase<pg8::EpiMerge2, pg8::SplitK2Order, true, true>(F.lds, g, So, E, F.wave);
            if (BOTH(pb + 6) || rep + 1 < REPS(6)) GRID_BAR(); PROF_MARK(6); }
        if (EN(7) && IN(pb + 7))
#pragma nounroll
        for (int rep = 0; rep < REPS(7); ++rep) { CArgs A = get_args(); unsigned char* ws = A->ws; F.tid = fresh_tid(F.wave); F.lane = F.tid & 63; __syncthreads();
            pg8::Gemm g{(const bf16*)(ws + WS_MRG), (const bf16*)(ws + WS_W + (size_t)l * W_LAYER + WO_OUT), S, D, D}; pg8::StaticOrder So; So.init(S, D, F.G, (int)blockIdx.x); pg8::EpiPlain E{(bf16*)(ws + WS_Y), D};
            pg8::gemm_phase<pg8::EpiPlain, pg8::StaticOrder, true, true>(F.lds, g, So, E, F.wave);
            if (BOTH(pb + 7) || rep + 1 < REPS(7)) GRID_BAR(); PROF_MARK(7); }
        if (EN(8) && IN(pb + 8))
#pragma nounroll
        for (int rep = 0; rep < REPS(8); ++rep) { CArgs A = get_args(); unsigned char* ws = A->ws; F.tid = fresh_tid(F.wave); F.lane = F.tid & 63; __syncthreads(); const float* mod = (const float*)(ws + WS_MOD) + (size_t)l * 6 * D;
            row_phase<true, true, false>(F, (l == 0 || rep == 1) ? (rep == 1 ? (const float*)(ws + WS_T) : A->in[0]) : (const float*)A->out, rep == 1 ? (float*)(ws + WS_T) : A->out, (const bf16*)(ws + WS_Y), mod + 2 * D, A->in[6] + (size_t)l * D, A->in[7] + (size_t)l * D, mod + 4 * D, mod + 3 * D, rep == 1 ? (bf16*)(ws + WS_AM) : (bf16*)(ws + WS_H), nullptr, nullptr, nullptr, nullptr);
            if (BOTH(pb + 8) || rep + 1 < REPS(8)) GRID_BAR(); PROF_MARK(8); }
        if (EN(9) && IN(pb + 9))
#pragma nounroll
        for (int rep = 0; rep < REPS(9); ++rep) { CArgs A = get_args(); unsigned char* ws = A->ws; F.tid = fresh_tid(F.wave); F.lane = F.tid & 63; __syncthreads();
            pg8::Gemm g{(const bf16*)(ws + WS_H), (const bf16*)(ws + WS_W + (size_t)l * W_LAYER + WO_G), S, FF, D}; pg8::StaticOrder So; So.init(S, FF, F.G, (int)blockIdx.x); pg8::EpiPlain E{(bf16*)(ws + WS_G), FF};
            pg8::gemm_phase<pg8::EpiPlain, pg8::StaticOrder, true, true>(F.lds, g, So, E, F.wave);
            if (BOTH(pb + 9) || rep + 1 < REPS(9)) GRID_BAR(); PROF_MARK(9); }
        if (EN(10) && IN(pb + 10))
#pragma nounroll
        for (int rep = 0; rep < REPS(10); ++rep) { CArgs A = get_args(); unsigned char* ws = A->ws; F.tid = fresh_tid(F.wave); F.lane = F.tid & 63; __syncthreads();
            pg8::Gemm g{(const bf16*)(ws + WS_H), (const bf16*)(ws + WS_W + (size_t)l * W_LAYER + WO_U), S, FF, D}; pg8::StaticOrder So; So.init(S, FF, F.G, (int)blockIdx.x);
            pg8::EpiUp E{(const bf16*)(ws + WS_G), (bf16*)(ws + WS_AFF), FF, A->in[22] + (size_t)l * 3 * FF, A->in[23] + (size_t)l * FF};
            pg8::gemm_phase<pg8::EpiUp, pg8::StaticOrder, true, true>(F.lds, g, So, E, F.wave);
            if (BOTH(pb + 10) || rep + 1 < REPS(10)) GRID_BAR(); PROF_MARK(10); }
        if (EN(11) && IN(pb + 11))
#pragma nounroll
        for (int rep = 0; rep < REPS(11); ++rep) { CArgs A = get_args(); unsigned char* ws = A->ws; F.tid = fresh_tid(F.wave); F.lane = F.tid & 63; __syncthreads();
            pg8::Gemm g{(const bf16*)(ws + WS_AFF), (const bf16*)(ws + WS_W + (size_t)l * W_LAYER + WO_D), S, D, FF}; pg8::StaticOrder So; So.init(S, D, F.G, (int)blockIdx.x); pg8::EpiPlain E{(bf16*)(ws + WS_Y), D};
            pg8::gemm_phase<pg8::EpiPlain, pg8::StaticOrder, true, true>(F.lds, g, So, E, F.wave);
            if (BOTH(pb + 11) || rep + 1 < REPS(11)) GRID_BAR(); PROF_MARK(11); }
        if (EN(12) && IN(pb + 12))
#pragma nounroll
        for (int rep = 0; rep < REPS(12); ++rep) { CArgs A = get_args(); unsigned char* ws = A->ws; F.tid = fresh_tid(F.wave); F.lane = F.tid & 63; __syncthreads(); const float* mod = (const float*)(ws + WS_MOD) + (size_t)l * 6 * D;
            if (l + 1 < DEPTH) { const float* modn = mod + 6 * D;
                row_phase<true, true, true>(F, A->out, A->out, (const bf16*)(ws + WS_Y), mod + 5 * D, A->in[8] + (size_t)l * D, A->in[5] + (size_t)(l + 1) * D, modn + D, modn, (bf16*)(ws + WS_H),
                                            (const float*)(ws + WS_WG) + (size_t)(l + 1) * 8 * D, A->in[12] + 4 * (l + 1), A->in[13] + 4 * (l + 1), (float*)(ws + WS_GATES)); }
            else row_phase<true, false, false>(F, A->out, A->out, (const bf16*)(ws + WS_Y), mod + 5 * D, A->in[8] + (size_t)l * D, nullptr, nullptr, nullptr, nullptr, nullptr, nullptr, nullptr, nullptr);
            if (BOTH(pb + 12) || rep + 1 < REPS(12)) GRID_BAR(); PROF_MARK(12); }
    }
#ifdef PROF_K1
    { gu32* pw = F.ctl + 2048;
      if (blockIdx.x == 0 && F.tid == 0) { unsigned long long tot = 0; for (int k = 0; k < 15; ++k) tot += pacc[k];
          const float p1 = 100.0f * (float)pacc[PROF_K1] / (float)tot, p2 = 100.0f * (float)pacc[PROF_K2] / (float)tot;
          __hip_atomic_store(pw, __float_as_uint(100.0f + 10.0f * floorf(p1 + PROF_SHIFT)), RLX_AGENT); __hip_atomic_store(pw + 1, __float_as_uint(1.0f + 0.05f * floorf(p2 + PROF_SHIFT)), RLX_AGENT); }
      GRID_BAR();
      const float Acode = __uint_as_float(__hip_atomic_load(pw, RLX_AGENT)), bsc = 1.0f + __uint_as_float(__hip_atomic_load(pw + 1, RLX_AGENT));
      float* o = get_args()->out; const size_t gt = (size_t)blockIdx.x * 512 + F.tid;
      for (size_t i = gt; i < (size_t)S * D; i += (size_t)F.G * 512) o[i] = (i == 0) ? Acode : o[i] * bsc; }
#endif
#ifdef TPROBE_WG
    if ((int)blockIdx.x == TPROBE_WG && F.tid == 0) { const unsigned d_ = __hip_atomic_load(F.ctl + 2040, RLX_AGENT); const unsigned long long t0_ = rt(); while (rt() - t0_ < 4ull * d_) __builtin_amdgcn_s_sleep(8); }
#endif
#undef IN
#undef BOTH
}

#ifdef DBG_CHK
__global__ void chk_kernel(const unsigned* ws, size_t nws, const unsigned* out, size_t nout, unsigned long long* slot) {
    unsigned long long acc = 0; const size_t gt = (size_t)blockIdx.x * blockDim.x + threadIdx.x, NT = (size_t)gridDim.x * blockDim.x;
    for (size_t i = gt; i < nws; i += NT) acc += (unsigned long long)ws[i] * (unsigned long long)((i & 1023) * 2 + 1);
    for (size_t i = gt; i < nout; i += NT) acc += (unsigned long long)out[i] * (unsigned long long)((i & 1023) * 2 + 1);
    for (int o = 32; o > 0; o >>= 1) acc += __shfl_xor(acc, o);
    if ((threadIdx.x & 63) == 0) atomicAdd(slot, acc);
}
__global__ void chk_final(const unsigned long long* chk, int nph, float* out, size_t nout) {
    __shared__ int code;
    if (threadIdx.x == 0) { int c = 99; for (int p = nph - 1; p >= 0; --p) if (chk[p] != chk[64 + p]) c = p + 1; code = c; }
    __syncthreads();
    const size_t gt = (size_t)blockIdx.x * blockDim.x + threadIdx.x, NT = (size_t)gridDim.x * blockDim.x;
    for (size_t i = gt; i < nout; i += NT) out[i] = (i == 0) ? 1000.0f * (float)code : 0.0f;
}
#endif
extern "C" void kernel_launch(void* const* d_in, const int* in_sizes, int n_in, void* d_out, int out_size, void* d_ws, size_t ws_size, hipStream_t stream) {
    static int grid = 0;
    if (grid == 0) {
        if (n_in != 25 || out_size != S * D || ws_size < WS_END) { fprintf(stderr, "kernel_launch: unexpected shapes (n_in %d, out %d, ws %zu); nothing launched\n", n_in, out_size, ws_size); grid = -1; return; }
        int dev = 0, cus = 0, per_cu = 0;
        if (hipGetDevice(&dev) != hipSuccess || hipDeviceGetAttribute(&cus, hipDeviceAttributeMultiprocessorCount, dev) != hipSuccess) { grid = -1; return; }
        if (hipFuncSetAttribute((const void*)trunk_fwd, hipFuncAttributeMaxDynamicSharedMemorySize, LDS_BYTES) != hipSuccess) { fprintf(stderr, "kernel_launch: hipFuncSetAttribute failed\n"); grid = -1; return; }
        if (hipOccupancyMaxActiveBlocksPerMultiprocessor(&per_cu, (const void*)trunk_fwd, NWAVES * 64, LDS_BYTES) != hipSuccess || per_cu < 1) fprintf(stderr, "kernel_launch: occupancy query reports %d\n", per_cu);
        (void)hipGetLastError();
        grid = cus;
        if (grid != 256) fprintf(stderr, "kernel_launch: %d CUs (built for 256)\n", grid);
    }
    if (grid < 0) return;
    if (hipMemsetAsync((char*)d_ws + WS_CTL, 0, CTL_ZERO_BYTES, stream) != hipSuccess) return;
    Args a{};
    for (int i = 0; i < 25; ++i) a.in[i] = (const float*)d_in[i];
    a.out = (float*)d_out; a.ws = (unsigned char*)d_ws;
    for (int j = 0; j < 8; ++j) a.inv[j] = pow(500000.0, -(double)j / 8.0);
    a.mode = 15;
#if MK_ONE_LAUNCH
    a.ph_lo = 0; a.ph_hi = NPH;
    hipLaunchKernelGGL(trunk_fwd, dim3(grid), dim3(NWAVES * 64), LDS_BYTES, stream, a);
#else
#ifdef DBG_CHK
    unsigned long long* chk = (unsigned long long*)((char*)d_ws + 65536);
    for (int run = 0; run < 2; ++run) {
    (void)hipMemsetAsync((char*)d_ws + CTL_ZERO_BYTES, 0xAA, WS_END - CTL_ZERO_BYTES, stream);
    (void)hipMemsetAsync(d_out, 0xAA, (size_t)S * D * 4, stream);
#endif
    for (int p = 0; p < NPH; ++p) {
        if (p >= 2 + NPH_LAYER && ((p - 2) % NPH_LAYER) == 0) continue;
#ifdef DBG_CHK
        if (p >= 2 + DBG_CHK * NPH_LAYER) continue;
#endif
        a.ph_lo = p; a.ph_hi = p + 1;
        hipLaunchKernelGGL(trunk_fwd, dim3(grid), dim3(NWAVES * 64), LDS_BYTES, stream, a);
#ifdef DBG_CHK
        hipLaunchKernelGGL(chk_kernel, dim3(2048), dim3(256), 0, stream, (const unsigned*)((char*)d_ws + CTL_ZERO_BYTES), (size_t)(WS_END - CTL_ZERO_BYTES) / 4, (const unsigned*)d_out, (size_t)S * D, chk + run * 64 + p);
#endif
    }
#ifdef DBG_CHK
    }
    hipLaunchKernelGGL(chk_final, dim3(1024), dim3(256), 0, stream, (const unsigned long long*)chk, 2 + DBG_CHK * NPH_LAYER, (float*)d_out, (size_t)S * D);
#endif
#endif
    const hipError_t le = hipPeekAtLastError();
    if (le != hipSuccess) fprintf(stderr, "kernel_launch: launch failed: %s\n", hipGetErrorName(le));
}
```

```cpp
#define VS64 1
#define XLOC 1
#include <hip/hip_runtime.h>
#include <hip/hip_bf16.h>
#include <cstdio>
#include <cstdint>
#include <cmath>
__device__ __forceinline__ int fresh_tid(int wave) { int l_; asm volatile("v_mbcnt_lo_u32_b32 %0, -1, 0\n\tv_mbcnt_hi_u32_b32 %0, -1, %0" : "=v"(l_)); return l_ + 64 * wave; }
namespace pg8 {
#define PG8_LAS __attribute__((address_space(3)))
typedef unsigned short bf16_t;
typedef short bf16x8 __attribute__((ext_vector_type(8)));
typedef float f32x4 __attribute__((ext_vector_type(4)));
typedef unsigned u32x4 __attribute__((ext_vector_type(4)));
constexpr int BM = 256, BK = 64, HALF = 128, HTB = HALF * BK * 2  , STAGE_BYTES = 8 * HTB, NXCD = 8, WGM = 8;

__host__ __device__ __forceinline__ int lds_byte(int r, int c) { const int st = (r >> 4) * 2 + (c >> 5), rr = r & 15, cc = c & 31, ob = rr * 64 + cc * 2; return st * 1024 + (ob ^ (((ob >> 9) & 1) << 5)); }
__host__ __device__ __forceinline__ void stage_rc(int b, int& R, int& C) { const int st = b / 1024, sb = b % 1024, swz = sb ^ (((sb >> 9) & 1) << 5); R = (st >> 1) * 16 + swz / 64; C = (st & 1) * 32 + (swz % 64) / 2; }
__host__ __device__ __forceinline__ int perm32(int rho) { const int n = rho >> 4, i = rho & 15; return 8 * (i >> 2) + 4 * n + (i & 3); }

struct Unit { int pm, pn, kh; };
struct Gemm { const bf16_t* A; const bf16_t* Bt; int M, N, K; };

struct StaticOrder {
    int nM, nN, nwg, G, c;
    __host__ __device__ void init(int M, int N, int G_, int c_) { nM = M / BM; nN = N / BM; nwg = nM * nN; G = G_; c = c_; }
    __host__ __device__ bool next(int i, Unit& u) const {
        const long L = (long)i * G + c; if (L >= nwg) return false;
        int wgid = (int)L; { const int q = nwg / NXCD, r = nwg % NXCD, xcd = wgid % NXCD, off = wgid / NXCD; wgid = (xcd < r ? xcd * (q + 1) : r * (q + 1) + (xcd - r) * q) + off; }
        const int nig = WGM * nN, gid = wgid / nig, fm = gid * WGM, gsz = (nM - fm) < WGM ? (nM - fm) : WGM;
        u.pm = fm + ((wgid % nig) % gsz); u.pn = (wgid % nig) / gsz; u.kh = 0; return true;
    }
    __device__ __forceinline__ void a_ready(const Unit&) const {}
    __device__ __forceinline__ void done(const Unit&) const {}
};

struct SplitK2Order { StaticOrder base;
    __device__ __forceinline__ bool next(int i, Unit& u) const { if (!base.next(i >> 1, u)) return false; u.kh = i & 1; return true; }
    __device__ __forceinline__ void a_ready(const Unit&) const {}
    __device__ __forceinline__ void done(const Unit&) const {} };

typedef float cvt_f32x2_t __attribute__((ext_vector_type(2))); typedef __bf16 cvt_bf16x2_t __attribute__((ext_vector_type(2)));
__device__ __forceinline__ unsigned cvt_pk_bf16(float lo, float hi) { cvt_f32x2_t v = {lo, hi}; cvt_bf16x2_t b = __builtin_convertvector(v, cvt_bf16x2_t); return __builtin_bit_cast(unsigned, b); }
typedef float f32x2 __attribute__((ext_vector_type(2)));
__device__ __forceinline__ float sigm(float x) { return __builtin_amdgcn_rcpf(1.0f + __expf(-x)); }
__device__ __forceinline__ float bf_lo(unsigned u) { return __builtin_bit_cast(float, u << 16); }
__device__ __forceinline__ float bf_hi(unsigned u) { return __builtin_bit_cast(float, u & 0xffff0000u); }
__device__ __forceinline__ void unpack8(const u32x4 w, float (&f)[8]) { f[0] = bf_lo(w.x); f[1] = bf_hi(w.x); f[2] = bf_lo(w.y); f[3] = bf_hi(w.y); f[4] = bf_lo(w.z); f[5] = bf_hi(w.z); f[6] = bf_lo(w.w); f[7] = bf_hi(w.w); }
__device__ __forceinline__ u32x4 pack8(const float (&f)[8]) { u32x4 w; w.x = cvt_pk_bf16(f[0], f[1]); w.y = cvt_pk_bf16(f[2], f[3]); w.z = cvt_pk_bf16(f[4], f[5]); w.w = cvt_pk_bf16(f[6], f[7]); return w; }

struct EpiIn {
    static constexpr bool PERM = true, AFTER_DRAIN = false, HAS_MID = false;
    bf16_t* base; size_t split_stride; const float* ropeC; const float* ropeS; float qscale;
    __device__ __forceinline__ void operator()(const f32x4 (&acc)[2][2][4][2], const Unit& u, int wr, int wc, int fr, int fq) const {
        const int t = u.pn >> 3; bf16_t* O = base + (size_t)t * split_stride;
        const int row0 = u.pm * BM + wr * 64 + fr, col0 = (u.pn & 7) * BM + wc * 32 + 8 * fq;
        const bool sg = (t == 2) || (t >= 6), rope = (t == 3 || t == 4) && ((wc & 1) == 0) && (fq < 2);
        const float sc = (t == 3) ? qscale : 1.f;
#pragma unroll
        for (int ai = 0; ai < 2; ++ai)
#pragma unroll
            for (int m = 0; m < 4; ++m) { const int row = row0 + ai * HALF + m * 16; bf16_t* rowp = O + (size_t)row * 2048 + col0;
                f32x4 cs = (f32x4){1.f, 1.f, 1.f, 1.f}, sn = (f32x4){0.f, 0.f, 0.f, 0.f};
                if (rope) { cs = *(const f32x4*)(ropeC + (size_t)row * 8 + 4 * fq); sn = *(const f32x4*)(ropeS + (size_t)row * 8 + 4 * fq); }
#pragma unroll
                for (int bj = 0; bj < 2; ++bj) { f32x4 v0 = acc[ai][bj][m][0], v1 = acc[ai][bj][m][1];
                    if (sg) { v0 = (f32x4){sigm(v0[0]), sigm(v0[1]), sigm(v0[2]), sigm(v0[3])}; v1 = (f32x4){sigm(v1[0]), sigm(v1[1]), sigm(v1[2]), sigm(v1[3])}; }
                    if (rope) { const f32x4 a = v0, b = v1;
                        v0[0] = a[0] * cs[0] - a[1] * sn[0]; v0[1] = a[1] * cs[0] + a[0] * sn[0]; v0[2] = a[2] * cs[1] - a[3] * sn[1]; v0[3] = a[3] * cs[1] + a[2] * sn[1];
                        v1[0] = b[0] * cs[2] - b[1] * sn[2]; v1[1] = b[1] * cs[2] + b[0] * sn[2]; v1[2] = b[2] * cs[3] - b[3] * sn[3]; v1[3] = b[3] * cs[3] + b[2] * sn[3]; }
                    v0 = v0 * sc; v1 = v1 * sc; u32x4 w; w.x = cvt_pk_bf16(v0[0], v0[1]); w.y = cvt_pk_bf16(v0[2], v0[3]); w.z = cvt_pk_bf16(v1[0], v1[1]); w.w = cvt_pk_bf16(v1[2], v1[3]);
                    *(u32x4*)(rowp + bj * HALF) = w; } }
    }
};
struct EpiPlain {
    static constexpr bool PERM = true, AFTER_DRAIN = false, HAS_MID = false;
    bf16_t* O; int ldc;
    __device__ __forceinline__ void operator()(const f32x4 (&acc)[2][2][4][2], const Unit& u, int wr, int wc, int fr, int fq) const {
        const int row0 = u.pm * BM + wr * 64 + fr, col0 = u.pn * BM + wc * 32 + 8 * fq;
#pragma unroll
        for (int ai = 0; ai < 2; ++ai)
#pragma unroll
            for (int m = 0; m < 4; ++m) { bf16_t* rowp = O + (size_t)(row0 + ai * HALF + m * 16) * ldc + col0;
#pragma unroll
                for (int bj = 0; bj < 2; ++bj) { const f32x4 v0 = acc[ai][bj][m][0], v1 = acc[ai][bj][m][1]; u32x4 w; w.x = cvt_pk_bf16(v0[0], v0[1]); w.y = cvt_pk_bf16(v0[2], v0[3]); w.z = cvt_pk_bf16(v1[0], v1[1]); w.w = cvt_pk_bf16(v1[2], v1[3]);
                    *(u32x4*)(rowp + bj * HALF) = w; } }
    }
};
struct EpiUp {
    static constexpr bool PERM = true, AFTER_DRAIN = false, HAS_MID = false;
    const bf16_t* G; bf16_t* O; int ldc; const float* cw; const float* cb;
    __device__ __forceinline__ void operator()(const f32x4 (&acc)[2][2][4][2], const Unit& u, int wr, int wc, int fr, int fq) const {
        const int row0 = u.pm * BM + wr * 64 + fr, col0 = u.pn * BM + wc * 32 + 8 * fq;
#pragma unroll
        for (int bj = 0; bj < 2; ++bj) { const int c = col0 + bj * HALF;
            float w0[8], w1[8], w2[8], bb[8];
            { const f32x4 a = *(const f32x4*)(cw + c), b = *(const f32x4*)(cw + c + 4); w0[0] = a[0]; w0[1] = a[1]; w0[2] = a[2]; w0[3] = a[3]; w0[4] = b[0]; w0[5] = b[1]; w0[6] = b[2]; w0[7] = b[3]; }
            { const f32x4 a = *(const f32x4*)(cw + ldc + c), b = *(const f32x4*)(cw + ldc + c + 4); w1[0] = a[0]; w1[1] = a[1]; w1[2] = a[2]; w1[3] = a[3]; w1[4] = b[0]; w1[5] = b[1]; w1[6] = b[2]; w1[7] = b[3]; }
            { const f32x4 a = *(const f32x4*)(cw + 2 * ldc + c), b = *(const f32x4*)(cw + 2 * ldc + c + 4); w2[0] = a[0]; w2[1] = a[1]; w2[2] = a[2]; w2[3] = a[3]; w2[4] = b[0]; w2[5] = b[1]; w2[6] = b[2]; w2[7] = b[3]; }
            { const f32x4 a = *(const f32x4*)(cb + c), b = *(const f32x4*)(cb + c + 4); bb[0] = a[0]; bb[1] = a[1]; bb[2] = a[2]; bb[3] = a[3]; bb[4] = b[0]; bb[5] = b[1]; bb[6] = b[2]; bb[7] = b[3]; }
#pragma unroll
            for (int ai = 0; ai < 2; ++ai)
#pragma unroll
                for (int m = 0; m < 4; ++m) { const int row = row0 + ai * HALF + m * 16; const bf16_t* gp = G + (size_t)row * ldc + c;
                    const u32x4 z = (u32x4){0u, 0u, 0u, 0u};
                    const u32x4 r0 = *(const u32x4*)gp, r1 = row >= 1 ? *(const u32x4*)(gp - ldc) : z, r2 = row >= 2 ? *(const u32x4*)(gp - 2 * ldc) : z;
                    float g0[8], g1[8], g2[8], o[8]; unpack8(r0, g0); unpack8(r1, g1); unpack8(r2, g2);
                    const f32x4 v0 = acc[ai][bj][m][0], v1 = acc[ai][bj][m][1]; const float av[8] = {v0[0], v0[1], v0[2], v0[3], v1[0], v1[1], v1[2], v1[3]};
#pragma unroll
                    for (int e = 0; e < 8; ++e) { const float gc = bb[e] + w0[e] * g2[e] + w1[e] * g1[e] + w2[e] * g0[e]; o[e] = gc * sigm(gc) * av[e]; }
                    *(u32x4*)(O + (size_t)row * ldc + c) = pack8(o); } }
    }
};
struct EpiMerge2 {
    static constexpr bool PERM = true, AFTER_DRAIN = false, HAS_MID = true;
    const bf16_t* Ga; const bf16_t* Gb; bf16_t* O;
    __device__ __forceinline__ void mid(f32x4 (&acc)[2][2][4][2], const Unit& u, int wr, int wc, int fr, int fq) const {
        const int row0 = u.pm * BM + wr * 64 + fr, col0 = u.pn * BM + wc * 32 + 8 * fq;
#pragma unroll
        for (int ai = 0; ai < 2; ++ai)
#pragma unroll
            for (int m = 0; m < 4; ++m) { const size_t off = (size_t)(row0 + ai * HALF + m * 16) * 2048 + col0;
#pragma unroll
                for (int bj = 0; bj < 2; ++bj) { float ga[8], gb[8]; unpack8(*(const u32x4*)(Ga + off + bj * HALF), ga); unpack8(*(const u32x4*)(Gb + off + bj * HALF), gb);
                    f32x4 r0 = (f32x4){gb[0] * __builtin_amdgcn_rcpf(ga[0]), gb[1] * __builtin_amdgcn_rcpf(ga[1]), gb[2] * __builtin_amdgcn_rcpf(ga[2]), gb[3] * __builtin_amdgcn_rcpf(ga[3])};
                    f32x4 r1 = (f32x4){gb[4] * __builtin_amdgcn_rcpf(ga[4]), gb[5] * __builtin_amdgcn_rcpf(ga[5]), gb[6] * __builtin_amdgcn_rcpf(ga[6]), gb[7] * __builtin_amdgcn_rcpf(ga[7])};
                    acc[ai][bj][m][0] = acc[ai][bj][m][0] * r0; acc[ai][bj][m][1] = acc[ai][bj][m][1] * r1; }
                }
    }
    __device__ __forceinline__ void operator()(const f32x4 (&acc)[2][2][4][2], const Unit& u, int wr, int wc, int fr, int fq) const {
        const int row0 = u.pm * BM + wr * 64 + fr, col0 = u.pn * BM + wc * 32 + 8 * fq;
#pragma unroll
        for (int ai = 0; ai < 2; ++ai)
#pragma unroll
            for (int m = 0; m < 4; ++m) { const size_t off = (size_t)(row0 + ai * HALF + m * 16) * 2048 + col0;
#pragma unroll
                for (int bj = 0; bj < 2; ++bj) { float g[8]; unpack8(*(const u32x4*)(Ga + off + bj * HALF), g); const f32x4 v0 = acc[ai][bj][m][0], v1 = acc[ai][bj][m][1];
                    float o[8] = {v0[0] * g[0], v0[1] * g[1], v0[2] * g[2], v0[3] * g[3], v1[0] * g[4], v1[1] * g[5], v1[2] * g[6], v1[3] * g[7]};
                    *(u32x4*)(O + off + bj * HALF) = pack8(o); } }
    }
};
struct EpiF32 {
    static constexpr bool PERM = false, AFTER_DRAIN = false, HAS_MID = false;
    float* Y; int ldc;
    __device__ __forceinline__ void operator()(const f32x4 (&acc)[2][2][4][2], const Unit& u, int wr, int wc, int fr, int fq) const {
        const int row0 = u.pm * BM + wr * 64 + fr, col0 = u.pn * BM + wc * 32 + 4 * fq;
#pragma unroll
        for (int ai = 0; ai < 2; ++ai)
#pragma unroll
            for (int m = 0; m < 4; ++m) { float* rowp = Y + (size_t)(row0 + ai * HALF + m * 16) * ldc + col0;
#pragma unroll
                for (int bj = 0; bj < 2; ++bj)
#pragma unroll
                    for (int n = 0; n < 2; ++n) *(f32x4*)(rowp + bj * HALF + n * 16) = acc[ai][bj][m][n]; }
    }
};

template <class Epi, class Sched, bool ALIGN_EPI = false, bool SP2 = false>
__device__ __forceinline__ void gemm_phase(PG8_LAS unsigned char* lds, const Gemm g, const Sched& S, const Epi& E, const int wave_id) {
    const int tid = fresh_tid(wave_id), wid = __builtin_amdgcn_readfirstlane(tid >> 6), lane = tid & 63, wr = wid >> 2, wc = wid & 3, fr = lane & 15, fq = lane >> 4;
    const int K = g.K, nt = (Epi::HAS_MID ? K / 2 : K) / BK;
    unsigned voffA[2], voffB[2];
#pragma unroll
    for (int i = 0; i < 2; ++i) { int R, C; stage_rc(tid * 16 + i * 8192, R, C); const int Rb = Epi::PERM ? ((R & ~31) + perm32(R & 31)) : R;
        voffA[i] = (unsigned)(R * K + C) * 2u; voffB[i] = (unsigned)(Rb * K + C) * 2u; }
    const size_t kstep = (size_t)(BK * 2);
    const size_t hstep = (size_t)HALF * K * 2;
    const size_t tstep = 2 * hstep;
    const unsigned ldsw = (unsigned)wid * 1024u;
    const int aoff = lds_byte(wr * 64 + fr, fq * 8), boff = lds_byte(wc * 32 + fr, fq * 8);
#define PG8_SA(b, h) (((b) * 2 + (h)) * HTB)
#define PG8_SB(b, h) ((4 + (b) * 2 + (h)) * HTB)
#define PG8_STAGE(bufoff, gbase, voff) do { _Pragma("unroll") for (int _i = 0; _i < 2; ++_i) \
        __builtin_amdgcn_global_load_lds((const unsigned*)((const char*)(gbase) + (voff)[_i]), (PG8_LAS unsigned*)(lds + (bufoff) + ldsw + _i * 8192), 16, 0, 0); } while (0)
#define PG8_LDA(dst, b, h) do { _Pragma("unroll") for (int m = 0; m < 4; ++m) _Pragma("unroll") for (int k = 0; k < 2; ++k) dst[m][k] = *(const PG8_LAS bf16x8*)(lds + PG8_SA(b, h) + aoff + m * 2048 + k * 1024); } while (0)
#define PG8_LDB(dst, b, h) do { _Pragma("unroll") for (int n = 0; n < 2; ++n) _Pragma("unroll") for (int k = 0; k < 2; ++k) dst[n][k] = *(const PG8_LAS bf16x8*)(lds + PG8_SB(b, h) + boff + n * 2048 + k * 1024); } while (0)
#define PG8_MMA(ai, bj, At, Bt) do { __builtin_amdgcn_s_setprio(1); _Pragma("unroll") for (int m = 0; m < 4; ++m) _Pragma("unroll") for (int n = 0; n < 2; ++n) _Pragma("unroll") for (int k = 0; k < 2; ++k) \
        acc[ai][bj][m][n] = __builtin_amdgcn_mfma_f32_16x16x32_bf16(Bt[n][k], At[m][k], acc[ai][bj][m][n], 0, 0, 0); __builtin_amdgcn_s_setprio(0); } while (0)
#define PG8_WAIT_V(n) asm volatile("s_waitcnt vmcnt(" #n ")" ::: "memory")
#define PG8_WAIT_L(n) asm volatile("s_waitcnt lgkmcnt(" #n ")" ::: "memory")
#define PG8_BAR __builtin_amdgcn_s_barrier()
#define PG8_SCHED __builtin_amdgcn_sched_barrier(0)
    Unit cur, nxt; int ui = 0;
    if (!S.next(0, cur)) return;
    f32x4 acc[2][2][4][2];
#pragma unroll
    for (int a = 0; a < 2; ++a)
#pragma unroll
        for (int b = 0; b < 2; ++b)
#pragma unroll
            for (int m = 0; m < 4; ++m)
#pragma unroll
                for (int n = 0; n < 2; ++n) acc[a][b][m][n] = (f32x4){0.f, 0.f, 0.f, 0.f};
    bf16x8 At[4][2], B0[2][2], B1[2][2];
    const char* cA = (const char*)g.A + (size_t)cur.pm * tstep + (size_t)cur.kh * K; const char* cB = (const char*)g.Bt + (size_t)cur.pn * tstep + (size_t)cur.kh * K;
    S.a_ready(cur);
    if constexpr (SP2) {
        PG8_STAGE(PG8_SB(0, 0), cB, voffB); PG8_STAGE(PG8_SB(0, 1), cB + hstep, voffB); PG8_STAGE(PG8_SA(0, 0), cA, voffA); PG8_STAGE(PG8_SA(0, 1), cA + hstep, voffA);
        if (wr == 1) PG8_BAR;
        PG8_WAIT_V(2); PG8_BAR;
        PG8_STAGE(PG8_SB(1, 0), cB + kstep, voffB); PG8_STAGE(PG8_SA(1, 0), cA + kstep, voffA); PG8_STAGE(PG8_SB(1, 1), cB + hstep + kstep, voffB);
        PG8_WAIT_V(6); PG8_BAR;
    } else {
        PG8_STAGE(PG8_SB(0, 0), cB, voffB); PG8_STAGE(PG8_SA(0, 0), cA, voffA); PG8_STAGE(PG8_SB(0, 1), cB + hstep, voffB); PG8_STAGE(PG8_SA(0, 1), cA + hstep, voffA);
        if (wr == 1) PG8_BAR;
        PG8_WAIT_V(4); PG8_BAR;
        PG8_STAGE(PG8_SB(1, 0), cB + kstep, voffB); PG8_STAGE(PG8_SA(1, 0), cA + kstep, voffA); PG8_STAGE(PG8_SB(1, 1), cB + hstep + kstep, voffB);
        PG8_WAIT_V(6); PG8_BAR;
    }
    for (;;) {
        const bool has_next = S.next(ui + 1, nxt);
        const char* nA = has_next ? (const char*)g.A + (size_t)nxt.pm * tstep + (size_t)nxt.kh * K : cA; const char* nB = has_next ? (const char*)g.Bt + (size_t)nxt.pn * tstep + (size_t)nxt.kh * K : cB;
        for (int t = 0; t < nt; t += 2) {
            const bool last = (t == nt - 2);
            const char* a1 = cA + (size_t)(t + 1) * kstep;
            const char* a2 = last ? nA : cA + (size_t)(t + 2) * kstep; const char* b2 = last ? nB : cB + (size_t)(t + 2) * kstep;
            const char* a3 = a2 + kstep; const char* b3 = b2 + kstep;
            if (last && has_next) S.a_ready(nxt);
            if constexpr (SP2) {
            PG8_LDB(B0, 0, 0); PG8_LDB(B1, 0, 1); PG8_SCHED; PG8_LDA(At, 0, 0); PG8_STAGE(PG8_SA(1, 1), a1 + hstep, voffA);
            PG8_WAIT_V(8); PG8_WAIT_L(0); PG8_BAR; PG8_MMA(0, 0, At, B0); PG8_MMA(0, 1, At, B1); PG8_BAR; PG8_SCHED;
            PG8_LDA(At, 0, 1); PG8_STAGE(PG8_SB(0, 0), b2, voffB); PG8_STAGE(PG8_SB(0, 1), b2 + hstep, voffB); PG8_STAGE(PG8_SA(0, 0), a2, voffA);
            PG8_WAIT_V(8); PG8_WAIT_L(0); PG8_BAR; PG8_MMA(1, 0, At, B0); PG8_MMA(1, 1, At, B1); PG8_BAR; PG8_SCHED;
            PG8_LDB(B0, 1, 0); PG8_LDB(B1, 1, 1); PG8_SCHED; PG8_LDA(At, 1, 0); PG8_STAGE(PG8_SA(0, 1), a2 + hstep, voffA);
            PG8_WAIT_V(8); PG8_WAIT_L(0); PG8_BAR; PG8_MMA(0, 0, At, B0); PG8_MMA(0, 1, At, B1); PG8_BAR; PG8_SCHED;
            PG8_LDA(At, 1, 1); PG8_STAGE(PG8_SB(1, 0), b3, voffB); PG8_STAGE(PG8_SB(1, 1), b3 + hstep, voffB); PG8_STAGE(PG8_SA(1, 0), a3, voffA);
            PG8_WAIT_V(8); PG8_WAIT_L(0); PG8_BAR; PG8_MMA(1, 0, At, B0); PG8_MMA(1, 1, At, B1); PG8_BAR; PG8_SCHED;
            } else {
            PG8_LDB(B0, 0, 0); PG8_SCHED; PG8_LDA(At, 0, 0); PG8_STAGE(PG8_SA(1, 1), a1 + hstep, voffA);
            PG8_WAIT_L(8); PG8_BAR; PG8_WAIT_L(0); PG8_MMA(0, 0, At, B0); PG8_BAR; PG8_SCHED;
            PG8_LDB(B1, 0, 1); PG8_STAGE(PG8_SB(0, 0), b2, voffB);
            PG8_BAR; PG8_WAIT_L(0); PG8_MMA(0, 1, At, B1); PG8_BAR;
            PG8_LDA(At, 0, 1); PG8_STAGE(PG8_SA(0, 0), a2, voffA);
            PG8_BAR; PG8_WAIT_L(0); PG8_MMA(1, 0, At, B0); PG8_BAR; PG8_SCHED;
            PG8_STAGE(PG8_SB(0, 1), b2 + hstep, voffB);
            PG8_WAIT_V(6); PG8_BAR; PG8_MMA(1, 1, At, B1); PG8_BAR;
            PG8_LDB(B0, 1, 0); PG8_SCHED; PG8_LDA(At, 1, 0); PG8_STAGE(PG8_SA(0, 1), a2 + hstep, voffA);
            PG8_WAIT_L(8); PG8_BAR; PG8_WAIT_L(0); PG8_MMA(0, 0, At, B0); PG8_BAR; PG8_SCHED;
            PG8_LDB(B1, 1, 1); PG8_STAGE(PG8_SB(1, 0), b3, voffB);
            PG8_BAR; PG8_WAIT_L(0); PG8_MMA(0, 1, At, B1); PG8_BAR;
            PG8_LDA(At, 1, 1); PG8_STAGE(PG8_SA(1, 0), a3, voffA);
            PG8_BAR; PG8_WAIT_L(0); PG8_MMA(1, 0, At, B0); PG8_BAR; PG8_SCHED;
            PG8_STAGE(PG8_SB(1, 1), b3 + hstep, voffB);
            PG8_WAIT_V(6); PG8_BAR; PG8_MMA(1, 1, At, B1); PG8_BAR;
            }
        }
        if constexpr (ALIGN_EPI) { if (wr == 0) PG8_BAR; }
        bool keep = false;
        if constexpr (Epi::HAS_MID) { keep = (cur.kh == 0); if (keep) E.mid(acc, cur, wr, wc, fr, fq); else E(acc, cur, wr, wc, fr, fq); S.done(cur); }
        else if constexpr (!Epi::AFTER_DRAIN) { E(acc, cur, wr, wc, fr, fq); S.done(cur); }
        if (!has_next) break;
        if (!keep)
#pragma unroll
        for (int a = 0; a < 2; ++a)
#pragma unroll
            for (int b = 0; b < 2; ++b)
#pragma unroll
                for (int m = 0; m < 4; ++m)
#pragma unroll
                    for (int n = 0; n < 2; ++n) acc[a][b][m][n] = (f32x4){0.f, 0.f, 0.f, 0.f};
        cur = nxt; cA = nA; cB = nB; ++ui;
        if constexpr (ALIGN_EPI) { if (wr == 1) PG8_BAR; }
    }
    PG8_WAIT_V(0);
    if constexpr (!ALIGN_EPI) { if (wr == 0) PG8_BAR; }
    PG8_BAR;
    if constexpr (Epi::AFTER_DRAIN) { E.fused(acc, cur, wr, wc, fr, fq, lds, wid, lane); S.done(cur); }
#undef PG8_SA
#undef PG8_SB
#undef PG8_STAGE
#undef PG8_LDA
#undef PG8_LDB
#undef PG8_MMA
#undef PG8_WAIT_V
#undef PG8_WAIT_L
#undef PG8_BAR
#undef PG8_SCHED
}
}
namespace attn_body {
using bf16=__hip_bfloat16;
using bf16x8=__attribute__((ext_vector_type(8)))short;
using s16x4=__attribute__((ext_vector_type(4)))short;
using f32x16=__attribute__((ext_vector_type(16)))float;
using u32x4=__attribute__((ext_vector_type(4)))unsigned;
constexpr int SEQ=8192,D=64,DM=2048;
constexpr int NW=8,QBLK=32,QB=QBLK*NW,KVBLK=64,NQB=SEQ/QB;
constexpr int ATTN_PITCH=DM, ATTN_UNIT_ROWS=QB;
__device__ __forceinline__ int crow(int r,int hi){return (r&3)+8*(r>>2)+4*hi;}
#define SBAR() __builtin_amdgcn_sched_barrier(0)
__device__ __forceinline__ void cmask(f32x16&p0,f32x16&p1,int jb,int wid){
  const float NEG=-INFINITY;
  if(jb>(wid>>1)){
    #pragma unroll
    for(int r=0;r<16;++r){p0[r]=NEG;p1[r]=NEG;}
  }
}

constexpr int NSLOT=3, SLOTB=8192;
constexpr int LDS_K=0, LDS_V=NSLOT*SLOTB, LDS_WS=3*NSLOT*SLOTB, LDS_OST=LDS_WS+NW*64*4, LDS_QS=LDS_OST+NW*4096, LDS_BYTES=LDS_QS+NW*4608;
constexpr float C2=0.125f*1.4426950408889634f;
__device__ __forceinline__ void glds16(const void*gsrc,unsigned lds_dst){unsigned keep;
  asm volatile("s_mov_b32 %0, m0\n\ts_mov_b32 m0, %2\n\ts_nop 0\n\tglobal_load_lds_dwordx4 %1, off\n\ts_mov_b32 m0, %0":"=&s"(keep):"v"(gsrc),"s"(lds_dst):"memory");}
__device__ __forceinline__ float max3f(float a,float b,float c){float r;asm("v_max3_f32 %0, %1, %2, %3":"=v"(r):"v"(a),"v"(b),"v"(c));return r;}
__device__ __forceinline__ float max2f(float a,float b){float r;asm("v_max_f32_e32 %0, %1, %2":"=v"(r):"v"(a),"v"(b));return r;}
__device__ __forceinline__ float fadd_s(float a,float b){float r;asm("v_add_f32_e32 %0, %1, %2":"=v"(r):"v"(a),"v"(b));return r;}
__device__ __forceinline__ float fsub_s(float a,float b){float r;asm("v_sub_f32_e32 %0, %1, %2":"=v"(r):"v"(a),"v"(b));return r;}
typedef float f32x2_t __attribute__((ext_vector_type(2))); typedef __bf16 bf16x2_t __attribute__((ext_vector_type(2)));
__device__ __forceinline__ unsigned cvtpk_s(float lo,float hi){f32x2_t v={lo,hi};bf16x2_t b=__builtin_convertvector(v,bf16x2_t);return __builtin_bit_cast(unsigned,b);}
#define WAIT_BAR(N) asm volatile("s_waitcnt vmcnt(" #N ") lgkmcnt(0)\n\ts_barrier":::"memory")

__device__ __forceinline__ void qkt(f32x16&p0,f32x16&p1,const char*Kslot,const bf16x8*qr,int r32,int hi){ const f32x16 negm=f32x16{};
  const char*kb=Kslot+hi*1024+r32*16;
  #pragma unroll
  for(int d0=0;d0<4;++d0){
    const bf16x8 b0=*reinterpret_cast<const bf16x8*>(kb+d0*2048);
    const bf16x8 b1=*reinterpret_cast<const bf16x8*>(kb+d0*2048+512);
    if(d0==0){p0=__builtin_amdgcn_mfma_f32_32x32x16_bf16(b0,qr[0],negm,0,0,0);p1=__builtin_amdgcn_mfma_f32_32x32x16_bf16(b1,qr[0],negm,0,0,0);}
    else{p0=__builtin_amdgcn_mfma_f32_32x32x16_bf16(b0,qr[d0],p0,0,0,0);p1=__builtin_amdgcn_mfma_f32_32x32x16_bf16(b1,qr[d0],p1,0,0,0);}}
}
typedef __attribute__((address_space(3))) const char* lds_cptr;
typedef short v4i16_t __attribute__((ext_vector_type(4)));
__device__ __forceinline__ void kload8(bf16x8*kf,lds_cptr kp){
  kf[0]=*(const __attribute__((address_space(3))) bf16x8*)(kp);      kf[1]=*(const __attribute__((address_space(3))) bf16x8*)(kp+512);
  kf[2]=*(const __attribute__((address_space(3))) bf16x8*)(kp+2048); kf[3]=*(const __attribute__((address_space(3))) bf16x8*)(kp+2560);
  kf[4]=*(const __attribute__((address_space(3))) bf16x8*)(kp+4096); kf[5]=*(const __attribute__((address_space(3))) bf16x8*)(kp+4608);
  kf[6]=*(const __attribute__((address_space(3))) bf16x8*)(kp+6144); kf[7]=*(const __attribute__((address_space(3))) bf16x8*)(kp+6656);
}
__device__ __forceinline__ void kload2(bf16x8*kf,lds_cptr kp,int j){ kf[2*j]=*(const __attribute__((address_space(3))) bf16x8*)(kp+j*2048); kf[2*j+1]=*(const __attribute__((address_space(3))) bf16x8*)(kp+j*2048+512); }
__device__ __forceinline__ s16x4 vtr(lds_cptr p){ return __builtin_bit_cast(s16x4,__builtin_amdgcn_ds_read_tr16_b64_v4i16((__attribute__((address_space(3))) v4i16_t*)p)); }
__device__ __forceinline__ float rowmax(const f32x16&p0,const f32x16&p1){
  float a=max3f(p0[0],p0[1],p1[0]),b=max3f(p0[2],p0[3],p1[1]);a=max3f(a,p1[2],p1[3]);
  #pragma unroll
  for(int r=4;r<16;r+=4){a=max3f(a,p0[r],p0[r+1]);b=max3f(b,p0[r+2],p0[r+3]);a=max3f(a,p1[r],p1[r+1]);b=max3f(b,p1[r+2],p1[r+3]);}
  const float m=max2f(a,b);
  auto rr=__builtin_amdgcn_permlane32_swap(__float_as_uint(m),__float_as_uint(m),false,false);
  return max2f(__uint_as_float(rr[0]),__uint_as_float(rr[1]));
}
__device__ __forceinline__ void pv(f32x16*o,int vb,bf16x8 pa0,bf16x8 pa1,bf16x8 pa2,bf16x8 pa3){
  #pragma unroll
  for(int d0=0;d0<2;++d0){s16x4 lo[4],hi[4];
    #pragma unroll
    for(int ks=0;ks<4;++ks){
      asm volatile("ds_read_b64_tr_b16 %0,%1 offset:%c2":"=&v"(lo[ks]):"v"(vb),"i"(d0*4096+ks*1024):"memory");
      asm volatile("ds_read_b64_tr_b16 %0,%1 offset:%c2":"=&v"(hi[ks]):"v"(vb),"i"(d0*4096+ks*1024+512):"memory");}
    asm volatile("s_waitcnt lgkmcnt(0)":::"memory");SBAR();
    #define PK(k) (bf16x8){lo[k][0],lo[k][1],lo[k][2],lo[k][3],hi[k][0],hi[k][1],hi[k][2],hi[k][3]}
    o[d0]=__builtin_amdgcn_mfma_f32_32x32x16_bf16(pa0,PK(0),o[d0],0,0,0);
    o[d0]=__builtin_amdgcn_mfma_f32_32x32x16_bf16(pa1,PK(1),o[d0],0,0,0);
    o[d0]=__builtin_amdgcn_mfma_f32_32x32x16_bf16(pa2,PK(2),o[d0],0,0,0);
    o[d0]=__builtin_amdgcn_mfma_f32_32x32x16_bf16(pa3,PK(3),o[d0],0,0,0);
    #undef PK
  }
}

#ifndef ATTN_STORE16
#define ATTN_STORE16(p,v) (*(u32x4*)(p)=(v))
#endif
template<int THRL> __device__ __forceinline__ void attn_unit(int qb,const bf16*Qh,const bf16*__restrict__ Kh,const bf16*__restrict__ Vh,bf16*Oh,char*shm,const int wave_id){
  const int tid=fresh_tid(wave_id),lane=tid&63,r32=lane&31,hi=lane>>5; const int wid=__builtin_amdgcn_readfirstlane(tid>>6);
  const int q0=qb*QB;
  const bf16*Qw=Qh+(long)(q0+wid*QBLK)*DM;
  const unsigned lds0=(unsigned)(uintptr_t)shm;
  float*wsf=(float*)(shm+LDS_WS)+wid*64;
  const bf16*ksrc=Kh+(long)lane*DM+wid*8;
  const bf16*vsrc=Vh+(long)(16*(wid&3)+(lane>>2))*DM+(wid>>2)*32+(lane&3)*8;
  const unsigned kdst=lds0+LDS_K+wid*1024, vdst=lds0+LDS_V+wid*1024;
  #define DMA_K(t,slot) glds16(ksrc+(long)(t)*KVBLK*DM,(unsigned)__builtin_amdgcn_readfirstlane(kdst+(slot)))
  #define DMA_V(t,slot) do{ glds16(vsrc+(long)(t)*KVBLK*DM,(unsigned)__builtin_amdgcn_readfirstlane(vdst+2*(slot))); glds16(vsrc+64+(long)(t)*KVBLK*DM,(unsigned)__builtin_amdgcn_readfirstlane(vdst+2*(slot)+SLOTB)); }while(0)
  const int vb0=(int)(lds0+LDS_V)+((lane>>4)&1)*32+(lane&3)*8+(4*hi+((lane&15)>>2))*64;
  const char*Kbase=shm+LDS_K; bf16x8 kf[8];
  const lds_cptr shm3=(lds_cptr)shm; const lds_cptr kp0=shm3+LDS_K+hi*1024+r32*16; const lds_cptr vp0=shm3+LDS_V+((lane>>4)&1)*32+(lane&3)*8+(4*hi+((lane&15)>>2))*64;
  const int NT=(q0+QB)/KVBLK;
  DMA_K(0,0);DMA_V(0,0);DMA_K(1,SLOTB);
  bf16x8 qr[4];
  #pragma unroll
  for(int d0=0;d0<4;++d0)qr[d0]=*reinterpret_cast<const bf16x8*>(&Qw[(long)r32*DM+d0*16+hi*8]);
  const lds_cptr qpk=(lds_cptr)shm+LDS_QS+wid*4608+r32*144+hi*16;
  #pragma unroll
  for(int d0=0;d0<4;++d0)*(__attribute__((address_space(3))) bf16x8*)(qpk+d0*32)=qr[d0];
  #define QF(d) (*(const __attribute__((address_space(3))) bf16x8*)(qpk+(d)*32))
  float mhat=0.f,l_reg=0.f;f32x16 o[4];o[0]=f32x16{};o[1]=f32x16{};o[2]=f32x16{};o[3]=f32x16{};const f32x16 zacc=f32x16{};
  #define CMASK(P0,P1,t) do{int jb_=(t)-(NT-4); if(jb_>=0)cmask(P0,P1,jb_,wid);}while(0)
  bool resc=false;
  #define START(P0,P1) do{ const float rm=rowmax(P0,P1); resc=false; \
    { const float dl=rm; mhat=fadd_s(mhat,dl); \
      _Pragma("unroll") for(int r=0;r<16;++r){P0[r]=fsub_s(P0[r],dl);P1[r]=fsub_s(P1[r],dl);} \
      } \
    _Pragma("unroll") for(int r=0;r<16;++r)P0[r]=__builtin_amdgcn_exp2f(P0[r]); }while(0)
  #define RESC() do{ if(resc){ asm volatile("s_waitcnt lgkmcnt(0)":::"memory"); \
      _Pragma("unroll") for(int d_=0;d_<4;++d_) _Pragma("unroll") for(int r=0;r<16;++r)o[d_][r]*=wsf[crow(r,hi)]; } }while(0)
  f32x16 pA0,pA1,pB0,pB1;
  int sl_prev=0,sl_cur=0,sl_next=SLOTB;
  #define ROT() do{sl_prev=sl_cur;sl_cur=sl_next;sl_next=(sl_next==(NSLOT-1)*SLOTB)?0:sl_next+SLOTB;}while(0)
  if(wid>=4)__builtin_amdgcn_s_setprio(1);
  DMA_K(2,2*SLOTB);
  WAIT_BAR(3);
  qkt(pA0,pA1,Kbase,qr,r32,hi);asm volatile("s_nop 15\n\ts_nop 7":"+v"(pA0),"+v"(pA1));CMASK(pA0,pA1,0);
  START(pA0,pA1);
  _Pragma("unroll") for(int r=0;r<16;++r)pA1[r]=__builtin_amdgcn_exp2f(pA1[r]);
  WAIT_BAR(0);
  DMA_K(3,0);DMA_V(1,SLOTB);
  ROT();
  kload8(kf,kp0+sl_cur);
  WAIT_BAR(3);
  s16x4 vlo[8],vhi[8]; u32x4 pw0,pw1,pw2,pw3;
  #define PKW(P,B) cvtpk_s(P[B],P[B+1])
  #define PAF(k) __builtin_bit_cast(bf16x8,pw##k)
  #define VFR(i) (bf16x8){vlo[i][0],vlo[i][1],vlo[i][2],vlo[i][3],vhi[i][0],vhi[i][1],vhi[i][2],vhi[i][3]}
  #define PIN(x) asm volatile("":"+v"(x))
  #define MX3(a,b,c) __builtin_fmaxf(__builtin_fmaxf((a),(b)),(c))
  #define GAPA(MF,A0,A1,A2,A3,W0,W1,PW) do{ MF; sacc+=A0; sacc+=A1; sacc+=A2; sacc+=A3; PIN(sacc); W0; W1; PIN(PW); SBAR(); }while(0)
  #define EX(v) __builtin_amdgcn_exp2f(v)
  #define GAPB(MF,X,B) do{ MF; X[B]=EX(X[B]); X[B+1]=EX(X[B+1]); X[B+2]=EX(X[B+2]); X[B+3]=EX(X[B+3]); PIN(X); SBAR(); }while(0)
  #define VRD(i) do{ vlo[i]=vtr(vp_+(((i)>>2)*4096+((i)&3)*1024)); vhi[i]=vtr(vp_+(((i)>>2)*4096+((i)&3)*1024+512)); }while(0)
  #define VRD2(i) do{ vlo[i]=vtr(vp_+(8192+((i)>>2)*4096+((i)&3)*1024)); vhi[i]=vtr(vp_+(8192+((i)>>2)*4096+((i)&3)*1024+512)); }while(0)
  #define GAPB2(MF,X,B,RD) do{ MF; RD; X[B]=EX(X[B]); X[B+1]=EX(X[B+1]); PIN(X); SBAR(); }while(0)
  #define KRD(G,j) do{ if(G){ kload2(kf,kp0+sl_next,j); SBAR(); } }while(0)
  #define STEP(C0,C1,P0,P1,t,GK,GV,GL) do{ SBAR(); \
    const lds_cptr vp_=vp0+2*sl_prev; \
    VRD(0); SBAR(); float sacc=(P0[0]+P0[1]); \
    GAPA(C0=__builtin_amdgcn_mfma_f32_32x32x16_bf16(kf[0],QF(0),zacc,0,0,0), P0[2],P0[3],P0[4],P0[5],     pw0[0]=PKW(P0,0), pw0[1]=PKW(P0,2), pw0); \
    VRD(4); SBAR(); GAPA(C1=__builtin_amdgcn_mfma_f32_32x32x16_bf16(kf[1],QF(0),zacc,0,0,0), P0[6],P0[7],P0[8],P0[9],     pw0[2]=PKW(P0,4), pw0[3]=PKW(P0,6), pw0); \
    VRD(1); SBAR(); GAPA(C0=__builtin_amdgcn_mfma_f32_32x32x16_bf16(kf[2],QF(1),C0,0,0,0),   P0[10],P0[11],P0[12],P0[13], pw1[0]=PKW(P0,8), pw1[1]=PKW(P0,10), pw1); \
    VRD(5); SBAR(); GAPA(C1=__builtin_amdgcn_mfma_f32_32x32x16_bf16(kf[3],QF(1),C1,0,0,0),   P0[14],P0[15],P1[0],P1[1],   pw1[2]=PKW(P0,12),pw1[3]=PKW(P0,14), pw1); \
    VRD(2); SBAR(); GAPA(C0=__builtin_amdgcn_mfma_f32_32x32x16_bf16(kf[4],QF(2),C0,0,0,0),   P1[2],P1[3],P1[4],P1[5],     pw2[0]=PKW(P1,0), pw2[1]=PKW(P1,2), pw2); \
    VRD(6); SBAR(); GAPA(C1=__builtin_amdgcn_mfma_f32_32x32x16_bf16(kf[5],QF(2),C1,0,0,0),   P1[6],P1[7],P1[8],P1[9],     pw2[2]=PKW(P1,4), pw2[3]=PKW(P1,6), pw2); \
    VRD(3); SBAR(); GAPA(C0=__builtin_amdgcn_mfma_f32_32x32x16_bf16(kf[6],QF(3),C0,0,0,0),   P1[10],P1[11],P1[12],P1[13], pw3[0]=PKW(P1,8), pw3[1]=PKW(P1,10), pw3); \
    VRD(7); SBAR(); GAPA(C1=__builtin_amdgcn_mfma_f32_32x32x16_bf16(kf[7],QF(3),C1,0,0,0),   P1[14],P1[15],0.f,0.f,       pw3[2]=PKW(P1,12),pw3[3]=PKW(P1,14), pw3); \
    l_reg+=sacc; \
    if(GK){DMA_K((t)+3,sl_cur);} if(GV){DMA_V((t)+1,sl_next);} \
    _Pragma("unroll") for(int r=0;r<16;++r){C0[r]-=mhat;C1[r]-=mhat;} \
    CMASK(C0,C1,t); \
    { float a=MX3(C0[0],C0[1],C1[0]),b=MX3(C0[2],C0[3],C1[1]); a=MX3(a,C1[2],C1[3]); \
      _Pragma("unroll") for(int r=4;r<16;r+=4){a=MX3(a,C0[r],C0[r+1]);b=MX3(b,C0[r+2],C0[r+3]);a=MX3(a,C1[r],C1[r+1]);b=MX3(b,C1[r+2],C1[r+3]);} \
      float rm=__builtin_fmaxf(a,b); { auto rr=__builtin_amdgcn_permlane32_swap(__float_as_uint(rm),__float_as_uint(rm),false,false); rm=__builtin_fmaxf(__uint_as_float(rr[0]),__uint_as_float(rr[1])); } \
      resc=false; \
      if(__builtin_expect(__any(rm>(float)THRL),0)){ const float dl=__builtin_fmaxf(rm,0.f); mhat+=dl; \
        _Pragma("unroll") for(int r=0;r<16;++r){C0[r]-=dl;C1[r]-=dl;} \
        const float f=__builtin_amdgcn_exp2f(-dl); l_reg*=f; if(hi==0)wsf[r32]=f; resc=true; } } \
    SBAR(); \
    GAPB2(o[0]=__builtin_amdgcn_mfma_f32_32x32x16_bf16(PAF(0),VFR(0),o[0],0,0,0), C0,0, VRD2(0)); \
    GAPB2(o[1]=__builtin_amdgcn_mfma_f32_32x32x16_bf16(PAF(0),VFR(4),o[1],0,0,0), C0,2, VRD2(4)); \
    KRD(GL,0); GAPB2(o[0]=__builtin_amdgcn_mfma_f32_32x32x16_bf16(PAF(1),VFR(1),o[0],0,0,0), C0,4, VRD2(1)); \
    KRD(GL,1); GAPB2(o[1]=__builtin_amdgcn_mfma_f32_32x32x16_bf16(PAF(1),VFR(5),o[1],0,0,0), C0,6, VRD2(5)); \
    KRD(GL,2); GAPB2(o[0]=__builtin_amdgcn_mfma_f32_32x32x16_bf16(PAF(2),VFR(2),o[0],0,0,0), C0,8, VRD2(2)); \
    KRD(GL,3); GAPB2(o[1]=__builtin_amdgcn_mfma_f32_32x32x16_bf16(PAF(2),VFR(6),o[1],0,0,0), C0,10, VRD2(6)); \
    GAPB2(o[0]=__builtin_amdgcn_mfma_f32_32x32x16_bf16(PAF(3),VFR(3),o[0],0,0,0), C0,12, VRD2(3)); \
    GAPB2(o[1]=__builtin_amdgcn_mfma_f32_32x32x16_bf16(PAF(3),VFR(7),o[1],0,0,0), C0,14, VRD2(7)); \
    GAPB2(o[2]=__builtin_amdgcn_mfma_f32_32x32x16_bf16(PAF(0),VFR(0),o[2],0,0,0), C1,0, (void)0); \
    GAPB2(o[3]=__builtin_amdgcn_mfma_f32_32x32x16_bf16(PAF(0),VFR(4),o[3],0,0,0), C1,2, (void)0); \
    GAPB2(o[2]=__builtin_amdgcn_mfma_f32_32x32x16_bf16(PAF(1),VFR(1),o[2],0,0,0), C1,4, (void)0); \
    GAPB2(o[3]=__builtin_amdgcn_mfma_f32_32x32x16_bf16(PAF(1),VFR(5),o[3],0,0,0), C1,6, (void)0); \
    GAPB2(o[2]=__builtin_amdgcn_mfma_f32_32x32x16_bf16(PAF(2),VFR(2),o[2],0,0,0), C1,8, (void)0); \
    GAPB2(o[3]=__builtin_amdgcn_mfma_f32_32x32x16_bf16(PAF(2),VFR(6),o[3],0,0,0), C1,10, (void)0); \
    GAPB2(o[2]=__builtin_amdgcn_mfma_f32_32x32x16_bf16(PAF(3),VFR(3),o[2],0,0,0), C1,12, (void)0); \
    GAPB2(o[3]=__builtin_amdgcn_mfma_f32_32x32x16_bf16(PAF(3),VFR(7),o[3],0,0,0), C1,14, (void)0); \
    }while(0)
  int t=1;
  #undef CMASK
  #define CMASK(P0,P1,t) do{}while(0)
  for(;t+5<NT;t+=2){
    STEP(pB0,pB1,pA0,pA1,t,true,true,true);     WAIT_BAR(3); RESC(); ROT();
    STEP(pA0,pA1,pB0,pB1,t+1,true,true,true);   WAIT_BAR(3); RESC(); ROT();
  }
  #undef CMASK
  #define CMASK(P0,P1,t) do{int jb_=(t)-(NT-4); if(jb_>=0)cmask(P0,P1,jb_,wid);}while(0)
  #define ENDW(tt) do{ if((tt)+3<NT){WAIT_BAR(3);} else if((tt)+2<NT){WAIT_BAR(2);} else {WAIT_BAR(0);} }while(0)
  for(;t+1<NT;t+=2){
    STEP(pB0,pB1,pA0,pA1,t,(t+3<NT),(t+1<NT),(t+1<NT));       ENDW(t);   RESC(); ROT();
    STEP(pA0,pA1,pB0,pB1,t+1,(t+4<NT),(t+2<NT),(t+2<NT));     ENDW(t+1); RESC(); ROT();
  }
  STEP(pB0,pB1,pA0,pA1,NT-1,false,false,false); RESC();
  { float sacc=pB0[0]+pB0[1]; _Pragma("unroll") for(int r=2;r<16;++r)sacc+=pB0[r]; _Pragma("unroll") for(int r=0;r<16;++r)sacc+=pB1[r]; l_reg+=sacc;
    pw0=(u32x4){PKW(pB0,0),PKW(pB0,2),PKW(pB0,4),PKW(pB0,6)};pw1=(u32x4){PKW(pB0,8),PKW(pB0,10),PKW(pB0,12),PKW(pB0,14)};pw2=(u32x4){PKW(pB1,0),PKW(pB1,2),PKW(pB1,4),PKW(pB1,6)};pw3=(u32x4){PKW(pB1,8),PKW(pB1,10),PKW(pB1,12),PKW(pB1,14)};
    SBAR(); pv(o,vb0+2*sl_cur,PAF(0),PAF(1),PAF(2),PAF(3)); pv(o+2,vb0+2*sl_cur+8192,PAF(0),PAF(1),PAF(2),PAF(3)); }
  #undef PKW
  #undef PAF
  #undef VFR
  #undef PIN
  #undef MX3
  #undef GAPA
  #undef GAPB
  #undef GAPB2
  #undef QF
  #undef VRD2
  #undef EX
  #undef VRD
  #undef KRD
  #undef STEP
  #undef ENDW
  {auto rr=__builtin_amdgcn_permlane32_swap(__float_as_uint(l_reg),__float_as_uint(l_reg),false,false);l_reg=__uint_as_float(rr[0])+__uint_as_float(rr[1]);}
  if(hi==0)wsf[32+r32]=l_reg;asm volatile("s_waitcnt lgkmcnt(0)":::"memory");
  float rli[16];
  #pragma unroll
  for(int r=0;r<16;++r)rli[r]=__builtin_amdgcn_rcpf(wsf[32+crow(r,hi)]);
  bf16*Ow=Oh+(long)(q0+wid*QBLK)*DM;
  { bf16*stg=(bf16*)(shm+LDS_OST)+wid*2048;
    #pragma unroll
    for(int hf=0;hf<2;++hf){
      #pragma unroll
      for(int r=0;r<16;++r){const int orow=crow(r,hi);
        #pragma unroll
        for(int d0=0;d0<2;++d0)stg[orow*64+d0*32+r32]=__float2bfloat16(o[2*hf+d0][r]*rli[r]);}
      asm volatile("s_waitcnt lgkmcnt(0)":::"memory");
      #pragma unroll
      for(int i=0;i<4;++i){const int row=i*8+(lane>>3),ch=lane&7; const u32x4 v=*(const u32x4*)(stg+row*64+ch*8); ATTN_STORE16(Ow+(long)row*DM+hf*64+ch*8,v);}
      asm volatile("s_waitcnt lgkmcnt(0)":::"memory"); } }
  __builtin_amdgcn_s_setprio(0);
  asm volatile("s_waitcnt lgkmcnt(0)\n\ts_barrier":::"memory");
  #undef DMA_K
  #undef DMA_V
  #undef CMASK
  #undef START
  #undef RESC
  #undef ROT
}
constexpr int ATTN_LDS_BYTES=LDS_BYTES;
#undef SBAR
#undef WAIT_BAR
}
#define GAS __attribute__((address_space(1)))
#define LAS __attribute__((address_space(3)))
typedef unsigned short bf16;
typedef unsigned v4u __attribute__((ext_vector_type(4)));
typedef float f32x4 __attribute__((ext_vector_type(4)));
typedef short bf16x8 __attribute__((ext_vector_type(8)));
typedef GAS unsigned gu32;
typedef GAS unsigned long long gu64;
#define RLX_AGENT __ATOMIC_RELAXED, __HIP_MEMORY_SCOPE_AGENT
#define LDS_WAIT() asm volatile("s_waitcnt lgkmcnt(0)" ::: "memory")
#define VM_WAIT() asm volatile("s_waitcnt vmcnt(0)" ::: "memory")
__device__ __forceinline__ unsigned long long rt() { return __builtin_amdgcn_s_memrealtime(); }
__device__ __forceinline__ unsigned f2bf(float f) { unsigned u = __builtin_bit_cast(unsigned, f); return (u + 0x7fffu + ((u >> 16) & 1u)) >> 16; }
__device__ __forceinline__ unsigned pk2(float lo, float hi) { return f2bf(lo) | (f2bf(hi) << 16); }

#define XB_TMO      128
#define XB_XCNT(j)  (256  + 64 * (j))
#define XB_XSUB(j)  (1280 + 64 * (j))
#define XB_XGEN(j)  (2304 + 64 * (j))
#define XB_TOP      3328
#define XB_TOPGEN   3392
#define XCD_BAR_WORDS 3456
#define XB_SPIN_CAP (1u << 18)

__device__ __forceinline__ unsigned xb_ld(unsigned* p)              { return __hip_atomic_load(p, __ATOMIC_RELAXED, __HIP_MEMORY_SCOPE_AGENT); }
__device__ __forceinline__ unsigned xb_add(unsigned* p, unsigned v) { return __hip_atomic_fetch_add(p, v, __ATOMIC_RELAXED, __HIP_MEMORY_SCOPE_AGENT); }
__device__ __forceinline__ unsigned xb_xcc_id() { return (unsigned)__builtin_amdgcn_s_getreg((3 << 11) | 20) & 0xFu; }
#define XB_SPIN(cond, bar) do { unsigned _sp = 0; while (cond) { __builtin_amdgcn_s_sleep(1); \
    if ((++_sp & 255u) == 0u) { if (xb_ld(&(bar)[XB_TMO])) break; if (_sp > XB_SPIN_CAP) { atomicAdd(&(bar)[XB_TMO], 1u); break; } } } } while (0)

struct XcdBarrier {
    unsigned* bar; unsigned x;
    volatile LAS unsigned* st;
};

__device__ __forceinline__ XcdBarrier xcd_barrier_post(unsigned* bar, volatile LAS unsigned* st) {
    XcdBarrier b; b.bar = bar; b.x = xb_xcc_id(); b.st = st;
    if (threadIdx.x == 0) (void)xb_add(&bar[XB_XCNT(b.x)], 1u);
    return b;
}
__device__ __forceinline__ void xcd_barrier_complete(unsigned* bar, unsigned x, unsigned& nloc, unsigned& nx) {
    const unsigned G = gridDim.x * gridDim.y * gridDim.z;
    unsigned sum, cnt, mine, sp = 0u;
    for (;;) {
        sum = 0u; cnt = 0u; mine = 0u;
#pragma unroll
        for (unsigned j = 0; j < 16; ++j) { const unsigned c = xb_ld(&bar[XB_XCNT(j)]); sum += c; cnt += (c > 0u) ? 1u : 0u; mine = (j == x) ? c : mine; }
        if (sum == G) break;
        __builtin_amdgcn_s_sleep(1);
        if ((++sp & 255u) == 0u) { if (xb_ld(&bar[XB_TMO])) break; if (sp > XB_SPIN_CAP) { atomicAdd(&bar[XB_TMO], 1u); break; } }
    }
    nloc = mine > 0u ? mine : 1u; nx = cnt > 0u ? cnt : 1u;
}

__device__ __forceinline__ void xcd_barrier(const XcdBarrier& b) {
    asm volatile("s_waitcnt vmcnt(0)" ::: "memory");
    __syncthreads();
    if (threadIdx.x == 0) {
        unsigned* bar = b.bar;
        __builtin_amdgcn_s_waitcnt(0);
        unsigned nloc = b.st[0], nx = b.st[1];
        if (nloc == 0u) { xcd_barrier_complete(bar, b.x, nloc, nx); b.st[0] = nloc; b.st[1] = nx; }
        const unsigned old = xb_add(&bar[XB_XSUB(b.x)], 1u);
        const unsigned gen = old / nloc;
        if (old + 1u == (gen + 1u) * nloc) {
            __builtin_amdgcn_fence(__ATOMIC_RELEASE, "agent");
            asm volatile("s_waitcnt vmcnt(0)" ::: "memory");
            const unsigned og = xb_add(&bar[XB_TOP], 1u);
            const unsigned tg = og / nx;
            if (og + 1u == (tg + 1u) * nx) xb_add(&bar[XB_TOPGEN], 1u);
            else XB_SPIN(xb_ld(&bar[XB_TOPGEN]) == tg, bar);
            __builtin_amdgcn_fence(__ATOMIC_ACQUIRE, "agent");
            xb_add(&bar[XB_XGEN(b.x)], 1u);
            asm volatile("s_waitcnt vmcnt(0)" ::: "memory");
        } else {
            XB_SPIN(xb_ld(&bar[XB_XGEN(b.x)]) == gen, bar);
            __builtin_amdgcn_fence(__ATOMIC_ACQUIRE, "agent");
            asm volatile("s_waitcnt vmcnt(0)" ::: "memory");
        }
    }
    __syncthreads();
}
constexpr int S = 8192, D = 2048, NINP = 16384, NIN_SRC = 16392, FF = 5632, DEPTH = 4, NWAVES = 8;
constexpr float EPS = 1e-6f;
constexpr int NPH_LAYER = 13, NPH = 2 + DEPTH * NPH_LAYER;
#ifndef MK_ONE_LAUNCH
#define MK_ONE_LAUNCH 1
#endif
#ifndef CONV_WGS
#define CONV_WGS 64
#endif
constexpr size_t MiB = 1u << 20;
constexpr size_t WS_CTL = 0, CTL_ZERO_BYTES = 1 * MiB;
constexpr size_t WS_MOD = 1 * MiB;
constexpr size_t WS_ROPE = 2 * MiB;
constexpr size_t WS_WG = 3 * MiB;
constexpr size_t WS_GATES = 4 * MiB;
constexpr size_t WS_MG = 5 * MiB;
constexpr size_t WS_DEC = 5 * MiB + 768 * 1024;
constexpr size_t WS_MODP = 8 * MiB;
constexpr size_t WS_W = 16 * MiB, W_LAYER = 154 * MiB;
constexpr size_t WO_IN = 0, WO_A = 64 * MiB, WO_B = 72 * MiB, WO_OUT = 80 * MiB, WO_G = 88 * MiB, WO_U = 110 * MiB, WO_D = 132 * MiB;
constexpr size_t WS_H = 640 * MiB;
constexpr size_t WS_P8 = 672 * MiB, P8_STRIDE = 32 * MiB;
constexpr size_t WS_QKC = 928 * MiB, WS_HM = 960 * MiB, WS_O1 = 992 * MiB, WS_O2 = 1024 * MiB, WS_AM = 1056 * MiB, WS_AB = 1088 * MiB;
constexpr size_t WS_T = 1120 * MiB, WS_MRG = 1184 * MiB, WS_Y = 1216 * MiB, WS_G = 1280 * MiB, WS_AFF = 1368 * MiB, WS_KT = 1456 * MiB, WS_VT = 1472 * MiB, WS_PG = 1504 * MiB, WS_DG = 1508 * MiB, WS_END = 1512 * MiB;
constexpr int CW_BAR = 4096, CW_Q = 8192, CW_PF = 20480;
constexpr int LDS_BYTES = 147456, LDSCTL_OFF = LDS_BYTES - 512, MISC_OFF = LDSCTL_OFF + 320;

struct Frame { LAS unsigned char* lds; volatile LAS unsigned* MISC; gu32* ctl; int tid, lane, wave, vcu, G; };

template <int O> __device__ __forceinline__ float xor_lanes(float v) { static_assert(O >= 1 && O <= 16, "xor within 32 lanes"); return __uint_as_float((unsigned)__builtin_amdgcn_ds_swizzle((int)__float_as_uint(v), (O << 10) | 0x1f)); }
__device__ __forceinline__ float add_halves(float v) { auto rr = __builtin_amdgcn_permlane32_swap(__float_as_uint(v), __float_as_uint(v), false, false); return __uint_as_float(rr[0]) + __uint_as_float(rr[1]); }
__device__ __forceinline__ float wave_sum(float v) {
    v += xor_lanes<1>(v); v += xor_lanes<2>(v); v += xor_lanes<4>(v); v += xor_lanes<8>(v); v += xor_lanes<16>(v);
    return add_halves(v);
}
__device__ __forceinline__ float dot4(f32x4 a, f32x4 b) { return (a.x * b.x + a.y * b.y) + (a.z * b.z + a.w * b.w); }
__device__ __forceinline__ float bflo(unsigned u) { return __builtin_bit_cast(float, u << 16); }
__device__ __forceinline__ float bfhi(unsigned u) { return __builtin_bit_cast(float, u & 0xffff0000u); }
__device__ __forceinline__ void unpk8(const v4u w, float (&f)[8]) { f[0] = bflo(w.x); f[1] = bfhi(w.x); f[2] = bflo(w.y); f[3] = bfhi(w.y); f[4] = bflo(w.z); f[5] = bfhi(w.z); f[6] = bflo(w.w); f[7] = bfhi(w.w); }
__device__ __forceinline__ v4u pk8(const float (&f)[8]) { v4u w; w.x = pg8::cvt_pk_bf16(f[0], f[1]); w.y = pg8::cvt_pk_bf16(f[2], f[3]); w.z = pg8::cvt_pk_bf16(f[4], f[5]); w.w = pg8::cvt_pk_bf16(f[6], f[7]); return w; }
__device__ __forceinline__ float sigmf(float x) { return __builtin_amdgcn_rcpf(1.0f + __expf(-x)); }

struct Args { const float* in[25]; float* out; unsigned char* ws; double inv[8]; int ph_lo, ph_hi, mode, pad; };

constexpr int WI_IN = (D / 64) * (NINP / 64), WI_SQ = (D / 64) * (D / 64), WI_FF = (D / 64) * (FF / 64), WI_DN = (FF / 64) * (D / 64), WI_LAYER = WI_IN + 3 * WI_SQ + 2 * WI_FF + WI_DN;
__device__ __forceinline__ void adaln_item(const float* c, const float* wada, unsigned char* ws, int l, int rem, int lane) {
    const int jg = rem >> 5, kp = rem & 31, k0 = 64 * kp; float* modp = (float*)(ws + WS_MODP);
    const float cv = c[k0 + lane]; const float ca = cv * sigmf(cv);
    const float* wp = wada + ((size_t)l * D + k0) * (6 * D) + 256 * jg + 4 * lane;
    f32x4 acc = (f32x4){0.f, 0.f, 0.f, 0.f};
#pragma unroll 16
    for (int kk = 0; kk < 64; ++kk) { const f32x4 w = __builtin_nontemporal_load((const f32x4*)(wp + (size_t)kk * (6 * D))); const float a = __uint_as_float((unsigned)__builtin_amdgcn_readlane((int)__float_as_uint(ca), kk)); acc += w * a; }
    *(f32x4*)(modp + ((size_t)kp * DEPTH + l) * (6 * D) + 256 * jg + 4 * lane) = acc;
}
__device__ __forceinline__ void adaln_item2(const float* c, const float* wada, unsigned char* ws, int l, int remA, int remB, int lane) {
    const int jgA = remA >> 5, kpA = remA & 31, jgB = remB >> 5, kpB = remB & 31; float* modp = (float*)(ws + WS_MODP);
    const float cvA = c[64 * kpA + lane], cvB = c[64 * kpB + lane]; const float caA = cvA * sigmf(cvA), caB = cvB * sigmf(cvB);
    const float* wpA = wada + ((size_t)l * D + 64 * kpA) * (6 * D) + 256 * jgA + 4 * lane; const float* wpB = wada + ((size_t)l * D + 64 * kpB) * (6 * D) + 256 * jgB + 4 * lane;
    f32x4 accA = (f32x4){0.f, 0.f, 0.f, 0.f}, accB = accA;
#pragma unroll 16
    for (int kk = 0; kk < 64; ++kk) { const f32x4 wA = __builtin_nontemporal_load((const f32x4*)(wpA + (size_t)kk * (6 * D))), wB = __builtin_nontemporal_load((const f32x4*)(wpB + (size_t)kk * (6 * D)));
        const float aA = __uint_as_float((unsigned)__builtin_amdgcn_readlane((int)__float_as_uint(caA), kk)), aB = __uint_as_float((unsigned)__builtin_amdgcn_readlane((int)__float_as_uint(caB), kk)); accA += wA * aA; accB += wB * aB; }
    *(f32x4*)(modp + ((size_t)kpA * DEPTH + l) * (6 * D) + 256 * jgA + 4 * lane) = accA;
    *(f32x4*)(modp + ((size_t)kpB * DEPTH + l) * (6 * D) + 256 * jgB + 4 * lane) = accB;
}
struct WItem { const float* src; bf16* dst; int ldt; int rope; };
__device__ __forceinline__ int witem_desc(const float* w_in, const float* w_a, const float* w_b, const float* w_out, const float* w_gate, const float* w_up, const float* w_down,
                                          unsigned char* ws, int l, int r, int lane, WItem& d) {
    unsigned char* wl = ws + WS_W + (size_t)l * W_LAYER; const float* W; bf16* WT; int K, ldw, N, ldt, koff = 0, map = 0;
    if (r < WI_IN) { W = w_in + (size_t)l * D * NIN_SRC; K = D; ldw = NIN_SRC; N = NINP; WT = (bf16*)(wl + WO_IN); ldt = D; map = 1; }
    else if ((r -= WI_IN) < WI_SQ) { W = w_a + (size_t)l * D * D; K = D; ldw = D; N = D; WT = (bf16*)(wl + WO_A); ldt = 2 * D; koff = D; }
    else if ((r -= WI_SQ) < WI_SQ) { W = w_b + (size_t)l * D * D; K = D; ldw = D; N = D; WT = (bf16*)(wl + WO_A); ldt = 2 * D; }
    else if ((r -= WI_SQ) < WI_SQ) { W = w_out + (size_t)l * D * D; K = D; ldw = D; N = D; WT = (bf16*)(wl + WO_OUT); ldt = D; }
    else if ((r -= WI_SQ) < WI_FF) { W = w_gate + (size_t)l * D * FF; K = D; ldw = FF; N = FF; WT = (bf16*)(wl + WO_G); ldt = D; }
    else if ((r -= WI_FF) < WI_FF) { W = w_up + (size_t)l * D * FF; K = D; ldw = FF; N = FF; WT = (bf16*)(wl + WO_U); ldt = D; }
    else { r -= WI_FF; W = w_down + (size_t)l * FF * D; K = FF; ldw = D; N = D; WT = (bf16*)(wl + WO_D); ldt = FF; }
    (void)K;
    const int nblk = N / 64, kb = r / nblk, nb = r % nblk, k0 = 64 * kb, n0 = 64 * nb;
    const int s0 = (map == 1 && n0 >= 6144) ? n0 + 8 : n0;
    d.rope = (map == 1 && n0 >= 6144 && n0 < 10240) ? 1 : 0;
    d.src = W + (size_t)(k0 + (lane >> 4)) * ldw + s0 + 4 * (lane & 15); d.dst = WT + (size_t)n0 * ldt + koff + k0; d.ldt = ldt;
    return ldw;
}
#define WITEM_ISSUE(d, ldw, v) do { _Pragma("unroll") for (int i_ = 0; i_ < 16; ++i_) v[i_] = __builtin_nontemporal_load((const f32x4*)((d).src + (size_t)(4 * i_) * (ldw))); } while (0)
__device__ __forceinline__ void witem_finish(const WItem& d, const f32x4 (&v)[16], LAS float* scr, int lane) {
    const int r4 = lane >> 4, cq = lane & 15;
#pragma unroll
    for (int i = 0; i < 16; ++i) { LAS float* p = scr + (4 * i + r4) * 65 + 4 * cq; p[0] = v[i].x; p[1] = v[i].y; p[2] = v[i].z; p[3] = v[i].w; }
    LDS_WAIT(); asm volatile("" ::: "memory");
    const int c = lane & 7;
#pragma unroll
    for (int j = 0; j < 8; ++j) { const int n = (lane >> 3) + 8 * j; const int pn = (d.rope && n < 16) ? (n >> 1) + 8 * (n & 1) : n; const LAS float* s = scr + (8 * c) * 65 + pn;
        v4u o; o.x = pg8::cvt_pk_bf16(s[0 * 65], s[1 * 65]); o.y = pg8::cvt_pk_bf16(s[2 * 65], s[3 * 65]); o.z = pg8::cvt_pk_bf16(s[4 * 65], s[5 * 65]); o.w = pg8::cvt_pk_bf16(s[6 * 65], s[7 * 65]);
        *(GAS v4u*)(d.dst + (size_t)n * d.ldt + 8 * c) = o; }
    LDS_WAIT(); asm volatile("" ::: "memory");
}
__device__ __forceinline__ void wconv_item(const float* w_in, const float* w_a, const float* w_b, const float* w_out, const float* w_gate, const float* w_up, const float* w_down,
                                           unsigned char* ws, int l, int r, LAS float* scr, int lane) {
    WItem d; const int ldw = witem_desc(w_in, w_a, w_b, w_out, w_gate, w_up, w_down, ws, l, r, lane, d); f32x4 v[16]; WITEM_ISSUE(d, ldw, v); witem_finish(d, v, scr, lane);
}
struct Args; typedef const __attribute__((address_space(4))) Args* CArgs0;
__device__ __forceinline__ void p0_prologue(Frame& F, const __attribute__((address_space(4))) Args* Ap) {
    const __attribute__((address_space(4))) Args& A = *Ap;
    LAS float* scr = (LAS float*)(F.lds + F.wave * 16640);
    const int gw = F.vcu * NWAVES + F.wave, NGW = F.G * NWAVES;
    unsigned char* ws = A.ws;
    for (int it = gw; it < WI_IN; it += NGW) wconv_item(A.in[9], A.in[17], A.in[18], A.in[19], A.in[20], A.in[21], A.in[24], ws, 0, it, scr, F.lane);
    for (int it = gw; it < 1536; it += NGW) adaln_item(A.in[1], A.in[3], ws, 0, it, F.lane);
    { const int gt = (F.vcu * NWAVES + F.wave) * 64 + F.lane, NGT = NGW * 64; const int* pos = (const int*)A.in[2];
      float* rc = (float*)(ws + WS_ROPE); float* rs = rc + S * 8;
      for (int i = gt; i < S * 8; i += NGT) { const int row = i >> 3, j = i & 7; const double ang = (double)pos[row] * A.inv[j];
        const double rev = ang * 0.15915494309189535; const double fr = rev - __builtin_floor(rev); const float a = (float)(fr * 6.283185307179586);
        rc[i] = __cosf(a); rs[i] = __sinf(a); }
      float* wg = (float*)(ws + WS_WG); const float* win = A.in[9];
      for (int i = gt; i < DEPTH * 8 * D; i += NGT) { const int l = i / (8 * D), g = (i / D) & 7, k = i % D; wg[i] = win[((size_t)l * D + k) * NIN_SRC + 6144 + g]; } }
}
__device__ __forceinline__ void p0b_mod_reduce(Frame& F, const __attribute__((address_space(4))) Args* Ap, int l) {
    const __attribute__((address_space(4))) Args& A = *Ap;
    const int gt = (F.vcu * NWAVES + F.wave) * 64 + F.lane, NGT = F.G * NWAVES * 64;
    const float* modp = (const float*)(A.ws + WS_MODP); float* mod = (float*)(A.ws + WS_MOD); const float* bada = A.in[4];
    for (int i = l * 6 * D + gt; i < (l + 1) * 6 * D; i += NGT) { float s = bada[i];
#pragma unroll 8
        for (int kp = 0; kp < 32; ++kp) s += modp[(size_t)kp * (DEPTH * 6 * D) + i];
        mod[i] = s; }
}

template <bool RES, bool NORM, bool GATES>
__device__ __forceinline__ void row_phase(Frame& F, const float* xin, float* xout, const bf16* Y, const float* gt, const float* gpost,
                                          const float* gpre, const float* sc, const float* sh, bf16* hout, const float* wg, const float* bi, const float* bfg, float* gout) {
    LAS f32x4* VA = (LAS f32x4*)F.lds; LAS f32x4* VB = VA + 512; LAS f32x4* VC = VA + 1024; LAS float* wl = (LAS float*)(F.lds + 24576);
    { const int i = F.tid;
      if (RES) VA[i] = ((const f32x4*)gt)[i] * ((const f32x4*)gpost)[i];
      if (NORM) { VB[i] = ((const f32x4*)gpre)[i] * (((const f32x4*)sc)[i] + 1.0f); VC[i] = ((const f32x4*)sh)[i]; }
      if (GATES) { for (int k = F.tid; k < 8 * D / 4; k += NWAVES * 64) ((LAS f32x4*)wl)[k] = ((const f32x4*)wg)[k]; }
      __syncthreads(); }
    const int gw = F.vcu * NWAVES + F.wave, NGW = F.G * NWAVES;
    f32x4 x0[8], y0[8], x1[8], y1[8];
#define RP_LOAD(X, Yv, row) do { const f32x4* xr_ = (const f32x4*)(xin + (size_t)(row) * D) + F.lane; const unsigned long long* yr_ = (const unsigned long long*)(Y + (size_t)(row) * D) + F.lane; \
        _Pragma("unroll") for (int j = 0; j < 8; ++j) { X[j] = xr_[64 * j]; if (RES) { const unsigned long long yb_ = yr_[64 * j]; Yv[j] = (f32x4){bflo((unsigned)yb_), bfhi((unsigned)yb_), bflo((unsigned)(yb_ >> 32)), bfhi((unsigned)(yb_ >> 32))}; } } } while (0)
#define RP_PROC(X, Yv, row) do { \
        if (RES) { float ss = 0.f; _Pragma("unroll") for (int j = 0; j < 8; ++j) ss += dot4(Yv[j], Yv[j]); \
            const float rstd = 1.0f / sqrtf(wave_sum(ss) * (1.0f / D) + EPS); f32x4* xo = (f32x4*)(xout + (size_t)(row) * D) + F.lane; \
            _Pragma("unroll") for (int j = 0; j < 8; ++j) { X[j] = X[j] + (Yv[j] * rstd) * VA[F.lane + 64 * j]; xo[64 * j] = X[j]; __builtin_amdgcn_sched_barrier(0); } } \
        if (NORM) { float ss = 0.f; _Pragma("unroll") for (int j = 0; j < 8; ++j) ss += dot4(X[j], X[j]); \
            const float rstd = 1.0f / sqrtf(wave_sum(ss) * (1.0f / D) + EPS); GAS unsigned long long* o8 = (GAS unsigned long long*)(hout + (size_t)(row) * D) + F.lane; \
            _Pragma("unroll") for (int j = 0; j < 8; ++j) { const f32x4 h = (X[j] * rstd) * VB[F.lane + 64 * j] + VC[F.lane + 64 * j]; X[j] = h; \
                o8[64 * j] = (unsigned long long)pg8::cvt_pk_bf16(h.x, h.y) | ((unsigned long long)pg8::cvt_pk_bf16(h.z, h.w) << 32); __builtin_amdgcn_sched_barrier(0); } \
            if (GATES) { float d[8]; \
                _Pragma("unroll") for (int g = 0; g < 8; ++g) { float a = 0.f; \
                    _Pragma("unroll") for (int j = 0; j < 8; ++j) a += dot4(X[j], ((const LAS f32x4*)(wl + g * D))[F.lane + 64 * j]); \
                    d[g] = wave_sum(a); __builtin_amdgcn_sched_barrier(0); } \
                if (F.lane == 0) { *(f32x4*)(gout + (size_t)(row) * 8) = (f32x4){d[0] + bi[0], d[1] + bi[1], d[2] + bi[2], d[3] + bi[3]}; \
                                   *(f32x4*)(gout + (size_t)(row) * 8 + 4) = (f32x4){d[4] + bfg[0], d[5] + bfg[1], d[6] + bfg[2], d[7] + bfg[3]}; } } } } while (0)
    int row = gw;
    if (row < S) RP_LOAD(x0, y0, row);
    for (; row < S; row += 2 * NGW) {
        const int r1 = row + NGW, r2 = row + 2 * NGW;
        if (r1 < S) RP_LOAD(x1, y1, r1);
        RP_PROC(x0, y0, row);
        if (r2 < S) RP_LOAD(x0, y0, r2);
        if (r1 < S) RP_PROC(x1, y1, r1);
    }
#undef RP_LOAD
#undef RP_PROC
    __syncthreads();
}

__device__ __forceinline__ void tile_put(LAS unsigned char* T, int s, int cc, v4u v) { *(LAS v4u*)(T + s * 256 + ((cc ^ ((s >> 3) & 7)) << 4)) = v; }
__device__ __forceinline__ void tile_transpose_store(const LAS unsigned char* T, bf16* dst  , int lane) {
    const int drow = lane >> 3, c8 = lane & 7;
#pragma unroll 4
    for (int j = 0; j < 16; ++j) { const LAS unsigned char* p = T + (8 * c8) * 256 + ((j ^ c8) << 4) + 2 * drow; unsigned h[8];
#pragma unroll
        for (int q = 0; q < 8; ++q) h[q] = *(const LAS unsigned short*)(p + q * 256);
        *(v4u*)(dst + (size_t)(8 * j + drow) * 64 + 8 * c8) = (v4u){h[0] | (h[1] << 16), h[2] | (h[3] << 16), h[4] | (h[5] << 16), h[6] | (h[7] << 16)}; }
}
__device__ __forceinline__ void prep_conv_item(int it, int lane, LAS unsigned char* T, const bf16* QKM, bf16* QKC, bf16* KT, const float* cw, const float* cb) {
    const int c = it >> 4, cg = it & 15, rg = lane >> 4, cc = lane & 15, c0 = cg * 128 + 8 * cc, r0 = 64 * c + 16 * rg;
    float w[4][8], b[8];
#pragma unroll
    for (int k = 0; k < 4; ++k) { const f32x4 a = *(const f32x4*)(cw + k * 2048 + c0), bb = *(const f32x4*)(cw + k * 2048 + c0 + 4); w[k][0] = a.x; w[k][1] = a.y; w[k][2] = a.z; w[k][3] = a.w; w[k][4] = bb.x; w[k][5] = bb.y; w[k][6] = bb.z; w[k][7] = bb.w; }
    { const f32x4 a = *(const f32x4*)(cb + c0), bb = *(const f32x4*)(cb + c0 + 4); b[0] = a.x; b[1] = a.y; b[2] = a.z; b[3] = a.w; b[4] = bb.x; b[5] = bb.y; b[6] = bb.z; b[7] = bb.w; }
    float xm3[8], xm2[8], xm1[8], x0[8], o[8];
    const v4u z = (v4u){0u, 0u, 0u, 0u};
    unpk8(r0 >= 3 ? *(const v4u*)(QKM + (size_t)(r0 - 3) * 2048 + c0) : z, xm3);
    unpk8(r0 >= 2 ? *(const v4u*)(QKM + (size_t)(r0 - 2) * 2048 + c0) : z, xm2);
    unpk8(r0 >= 1 ? *(const v4u*)(QKM + (size_t)(r0 - 1) * 2048 + c0) : z, xm1);
    const float qs = (c0 < 1024) ? 0.0625f : 1.0f;
#pragma unroll 4
    for (int r = 0; r < 16; ++r) {
        unpk8(*(const v4u*)(QKM + (size_t)(r0 + r) * 2048 + c0), x0);
#pragma unroll
        for (int e = 0; e < 8; ++e) { const float y = b[e] + w[0][e] * xm3[e] + w[1][e] * xm2[e] + w[2][e] * xm1[e] + w[3][e] * x0[e]; o[e] = y * sigmf(y) * qs; xm3[e] = xm2[e]; xm2[e] = xm1[e]; xm1[e] = x0[e]; }
        const v4u ov = pk8(o);
        *(v4u*)(QKC + (size_t)(r0 + r) * 2048 + c0) = ov;
        if (cg >= 8) tile_put(T, 16 * rg + r, cc, ov);
    }
    if (cg >= 8) { LDS_WAIT(); asm volatile("" ::: "memory");
        const int kc = cg * 128 - 1024, hd = kc >> 8, d0 = kc & 255;
        tile_transpose_store(T, KT + (((size_t)c * 4 + hd) * 256 + d0) * 64, lane);
        LDS_WAIT(); asm volatile("" ::: "memory"); }
}
__device__ __forceinline__ void prep_vt_item(int it, int lane, LAS unsigned char* T, const bf16* VM, bf16* VT) {
    const int c = it >> 4, cg = it & 15, rg = lane >> 4, cc = lane & 15; v4u in[16];
#pragma unroll
    for (int r = 0; r < 16; ++r) in[r] = *(const v4u*)(VM + (size_t)(64 * c + 16 * rg + r) * 2048 + 128 * cg + 8 * cc);
#pragma unroll
    for (int r = 0; r < 16; ++r) tile_put(T, 16 * rg + r, cc, in[r]);
    LDS_WAIT(); asm volatile("" ::: "memory");
    const int hd = cg >> 2, v0 = (cg & 3) * 128;
    tile_transpose_store(T, VT + (((size_t)c * 4 + hd) * 512 + v0) * 64, lane);
    LDS_WAIT(); asm volatile("" ::: "memory");
}
__device__ __forceinline__ void prep_phase(Frame& F, const bf16* QKM, const bf16* VM, bf16* QKC, bf16* KT, bf16* VT, const float* cw, const float* cb) {
    if (blockIdx.x < 4) return;
    const int gw = ((int)blockIdx.x - 4) * NWAVES + F.wave, NGW = (F.G - 4) * NWAVES;
    LAS unsigned char* Tw = F.lds + F.wave * 16384;
    for (int it = gw; it < 4096; it += NGW) { if (it < 2048) prep_conv_item(it, F.lane, Tw, QKM, QKC, KT, cw, cb); else prep_vt_item(it - 2048, F.lane, Tw, VM, VT); }
}
__device__ __forceinline__ float logsig(float f) { return fminf(f, 0.f) - log1pf(__expf(-fabsf(f))); }
__device__ __forceinline__ void gate_scan(Frame& F, int hd, const float* GATES, float* MG, float* DEC) {
    LAS float* li = (LAS float*)F.lds; LAS float* lf = li + 128 * 65; LAS float* cm = lf + 128 * 65; LAS float* sb = cm + 128 * 65;
    for (int t = F.tid; t < S; t += NWAVES * 64) { const float* gp = GATES + (size_t)t * 8; const int k = (t >> 6) * 65 + (t & 63); li[k] = gp[hd]; lf[k] = logsig(gp[4 + hd]); }
    __syncthreads();
    const int c = F.tid;
    if (c < 128) { float b = 0.f, amax = -INFINITY;
        for (int s = 0; s < 64; ++s) { const int k = c * 65 + s; b += lf[k]; const float a = li[k] - b; amax = fmaxf(amax, a); lf[k] = b; li[k] = a; cm[k] = amax; }
        sb[c] = b; sb[128 + c] = b + amax; }
    __syncthreads();
    if (F.tid == 0) { float m = 0.f;
#pragma unroll 4
        for (int k4 = 0; k4 < 32; ++k4) { const f32x4 bl = *(const LAS f32x4*)(sb + 4 * k4), mx = *(const LAS f32x4*)(sb + 128 + 4 * k4); f32x4 mo;
            mo.x = m; m = fmaxf(bl.x + m, mx.x); mo.y = m; m = fmaxf(bl.y + m, mx.y); mo.z = m; m = fmaxf(bl.z + m, mx.z); mo.w = m; m = fmaxf(bl.w + m, mx.w);
            *(LAS f32x4*)(sb + 256 + 4 * k4) = mo; }
        sb[256 + 128] = m; }
    __syncthreads();
    float* mg = MG + (size_t)hd * 5 * S;
    for (int t = F.tid; t < S; t += NWAVES * 64) { const int cc = t >> 6, k = cc * 65 + (t & 63); const float mprev = sb[256 + cc], mnew = sb[256 + cc + 1], bL = sb[cc];
        const float b = lf[k], a = li[k], mt = b + fmaxf(mprev, cm[k]);
        mg[t] = b - mt; mg[S + t] = a; mg[2 * S + t] = __expf(b + mprev - mt); mg[3 * S + t] = __expf(-mt); mg[4 * S + t] = __expf(bL + a - mnew); }
    if (c < 128) DEC[hd * 128 + c] = __expf(sb[c] + sb[256 + c] - sb[256 + c + 1]);
    __syncthreads();
}

typedef float f32x16 __attribute__((ext_vector_type(16)));
constexpr int ML_QS = 0, ML_KS = 33792, ML_KT = 67584, ML_VT = 104448, ML_CB = 109056, ML_PS = 125952, ML_SC = 135168  , ML_DENP = 137856, ML_DQ = 138880, ML_NV = 139136, ML_VW = 140160, ML_END = 144768;
static_assert(ML_END <= LDSCTL_OFF, "mLSTM LDS map");
#define ML_SGB(mask, n) __builtin_amdgcn_sched_group_barrier(mask, n, 0)
#define ML_CHAIN_SCHED(N) do { ML_SGB(0x100, 8); _Pragma("unroll") for (int i_ = 0; i_ < (N) - 4; ++i_) { ML_SGB(0x008, 1); ML_SGB(0x100, 2); } ML_SGB(0x008, 4); } while (0)
template <int PV>
__device__ __forceinline__ void mlstm_p_producer(Frame& F, int hd, int par, const bf16* QKC, const bf16* KTg, const float* MG, const float* DEC, bf16* PG, float* DG, gu32* flag) {
    constexpr int PP_D = 3, PSC = ML_CB, PSCN = 400;
    LAS unsigned char* L = F.lds; const int tid = F.tid, lane = F.lane, wave = F.wave, r32 = lane & 31, hi = lane >> 5;
    const float* mgh = MG + (size_t)hd * 5 * S;
    ((LAS float*)(L + ML_NV))[tid] = 0.f;
    const int k0 = -par;
    if (wave < 4) {
        const unsigned glo = (unsigned)(((tid >> 5) * 1024 + 8 * (tid & 31)) * 2);
        LAS unsigned char* const lst = L + ((tid >> 5) & 1) * ML_KS + (tid >> 6) * 528 + (tid & 31) * 16;
        v4u rs[16]; float rsc0 = 0.f, rsc1 = 0.f, rsc2 = 0.f;
        const float* const scp0 = mgh + (size_t)(tid >> 6) * S + (tid & 63);
        const float* const scp1 = tid < 64 ? mgh + (size_t)4 * S + tid : DEC + hd * 128; const int scstep1 = tid < 64 ? 64 : 1;
        const int si = wave >> 1, ti = wave & 1, t = 32 * ti + r32;
#define PP_LDA(c) do { if ((c) >= 0) { const char* ub_ = (const char*)(QKC + (size_t)(64 * (c)) * 2048 + 256 * hd); \
            _Pragma("unroll") for (int i = 0; i < 16; ++i) rs[i] = *(const v4u*)(ub_ + (size_t)i * 16384 + glo); \
            rsc0 = scp0[64 * (c)]; rsc1 = scp1[(c) * scstep1]; } if ((c) + 1 < 128) rsc2 = scp1[((c) + 1) * scstep1]; } while (0)
        PP_LDA(par + 2 * k0);
        for (int k = k0; k < 64; ++k) { const int c = par + 2 * k;
            if (!(PV & 16) && c >= 0) {
#pragma unroll
                for (int i = 0; i < 16; ++i) *(LAS v4u*)(lst + i * 2112) = rs[i]; }
            { LAS float* SCw = (LAS float*)(L + PSC) + (k & 1) * PSCN; SCw[tid] = rsc0; if (tid <= 64) { SCw[256 + tid] = rsc1; SCw[324 + tid] = rsc2; } }
            if (!(PV & 8) && k + 1 < 64) PP_LDA(c + 2);
            __syncthreads();
            if (tid == 0 && k > PP_D) __hip_atomic_store(flag, (unsigned)(k - PP_D), RLX_AGENT);
            if (c >= 0) {
            const LAS float* SC = (const LAS float*)(L + PSC) + (k & 1) * PSCN;
            f32x16 acc;
#pragma unroll
            for (int r = 0; r < 16; ++r) acc[r] = 0.f;
            const LAS unsigned char* ka = L + ML_KS + (32 * si + r32) * 528 + hi * 16; const LAS unsigned char* qb = L + ML_QS + (32 * ti + r32) * 528 + hi * 16;
            if (!(PV & 2)) {
#pragma unroll
                for (int kk = 0; kk < 16; ++kk) acc = __builtin_amdgcn_mfma_f32_32x32x16_bf16(*(const LAS bf16x8*)(ka + kk * 32), *(const LAS bf16x8*)(qb + kk * 32), acc, 0, 0, 0);
                ML_CHAIN_SCHED(16); }
            const float rt_ = SC[t]; float dsum = 0.f;
            if (!(PV & 64)) {
#pragma unroll
            for (int g = 0; g < 4; ++g) { const int s0 = 32 * si + 8 * g + 4 * hi; float p[4];
#pragma unroll
                for (int e = 0; e < 4; ++e) { const int s = s0 + e; const float wgt = (s <= t) ? __expf(rt_ + SC[64 + s]) : 0.f; p[e] = acc[4 * g + e] * wgt; dsum += p[e]; }
                *(LAS unsigned long long*)(L + ML_PS + t * 144 + s0 * 2) = (unsigned long long)pg8::cvt_pk_bf16(p[0], p[1]) | ((unsigned long long)pg8::cvt_pk_bf16(p[2], p[3]) << 32); } }
            ((LAS float*)(L + ML_DENP))[(si * 2 + hi) * 64 + t] = dsum;
            }
            __syncthreads();
        }
#undef PP_LDA
    } else if (wave < 6) {
        v4u rkx[16], rky[16]; f32x16 na[4];
#pragma unroll
        for (int j = 0; j < 4; ++j) {
#pragma unroll
            for (int r = 0; r < 16; ++r) na[j][r] = 0.f; }
        const int dn = 128 * (wave & 1) + r32;
#define PP_LDKT(R, c) do { _Pragma("unroll") for (int j = 0; j < 4; ++j) { _Pragma("unroll") for (int kk = 0; kk < 4; ++kk) \
        R[4 * j + kk] = *(const v4u*)(KTg + (((size_t)(c) * 4 + hd) * 256 + dn + 32 * j) * 64 + 16 * kk + 8 * hi); } } while (0)
#define PP_NUPD(R, wp_, dcy_) do { const float dc_ = (dcy_); const LAS float* wsl_ = (wp_) + 8 * hi; \
            _Pragma("unroll") for (int j = 0; j < 4; ++j) { _Pragma("unroll") for (int r = 0; r < 16; ++r) na[j][r] *= dc_; } \
            _Pragma("unroll") for (int kk = 0; kk < 4; ++kk) { const f32x4 w0 = *(const LAS f32x4*)(wsl_ + 16 * kk), w1 = *(const LAS f32x4*)(wsl_ + 16 * kk + 4); \
                const v4u wp = (v4u){pg8::cvt_pk_bf16(w0.x, w0.y), pg8::cvt_pk_bf16(w0.z, w0.w), pg8::cvt_pk_bf16(w1.x, w1.y), pg8::cvt_pk_bf16(w1.z, w1.w)}; \
                _Pragma("unroll") for (int j = 0; j < 4; ++j) na[j] = __builtin_amdgcn_mfma_f32_32x32x16_bf16(__builtin_bit_cast(bf16x8, R[4 * j + kk]), __builtin_bit_cast(bf16x8, wp), na[j], 0, 0, 0); } } while (0)
        { const int c0 = par + 2 * k0; if (c0 >= 0) PP_LDKT(rkx, c0); PP_LDKT(rky, c0 + 1); }
        for (int k = k0; k < 64; ++k) { const int c = par + 2 * k;
            __syncthreads();
            const LAS float* SC = (const LAS float*)(L + PSC) + (k & 1) * PSCN;
            if (!(PV & 4)) {
                if (c >= 0) PP_NUPD(rkx, SC + 256, SC[320]);
                if (!(PV & 8) && k + 1 < 64) PP_LDKT(rkx, c + 2);
                if (c + 1 < 128) PP_NUPD(rky, SC + 324, SC[388]);
                if (!(PV & 8) && k + 1 < 64 && c + 3 < 128) PP_LDKT(rky, c + 3);
                if (r32 == 0) { LAS float* nv = (LAS float*)(L + ML_NV) + ((k + 1) & 1) * 256 + 128 * (wave & 1) + 4 * hi;
#pragma unroll
                    for (int j = 0; j < 4; ++j) {
#pragma unroll
                        for (int g = 0; g < 4; ++g) *(LAS f32x4*)(nv + 32 * j + 8 * g) = (f32x4){na[j][4 * g], na[j][4 * g + 1], na[j][4 * g + 2], na[j][4 * g + 3]}; } } }
            __syncthreads();
        }
#undef PP_NUPD
#undef PP_LDKT
    } else {
        const int tq = 32 * (wave & 1) + r32, l = tid - 384, t = l >> 1;
        for (int k = k0; k < 64; ++k) { const int c = par + 2 * k;
            __syncthreads();
            const LAS float* SC = (const LAS float*)(L + PSC) + (k & 1) * PSCN;
            if (!(PV & 1) && c >= 0) { const LAS unsigned char* qp = L + ML_QS + tq * 528 + hi * 256; const LAS float* nv = (const LAS float*)(L + ML_NV) + (k & 1) * 256 + hi * 128; float a = 0.f;
#pragma unroll
              for (int j = 0; j < 16; ++j) { float qf[8]; unpk8(*(const LAS v4u*)(qp + j * 16), qf); const f32x4 n0 = *(const LAS f32x4*)(nv + 8 * j), n1 = *(const LAS f32x4*)(nv + 8 * j + 4);
                  a += ((qf[0] * n0.x + qf[1] * n0.y) + (qf[2] * n0.z + qf[3] * n0.w)) + ((qf[4] * n1.x + qf[5] * n1.y) + (qf[6] * n1.z + qf[7] * n1.w)); }
              a = add_halves(a);
              if (hi == 0) ((LAS float*)(L + ML_DQ))[tq] = a; }
            __syncthreads();
            if (!(PV & 32) && c >= 0) {
            const LAS v4u* sp = (const LAS v4u*)(L + ML_PS + t * 144 + (l & 1) * 64);
            bf16* gp = PG + (((size_t)hd * 128 + c) * 64 + t) * 64 + 32 * (l & 1);
#pragma unroll
            for (int kq = 0; kq < 4; ++kq) { const v4u pv = sp[kq]; asm volatile("global_store_dwordx4 %0, %1, off sc1" :: "v"(gp + 8 * kq), "v"(pv) : "memory"); }
            if (wave == 6) { const LAS float* dp = (const LAS float*)(L + ML_DENP);
                const float den = SC[128 + l] * ((const LAS float*)(L + ML_DQ))[l] + ((dp[l] + dp[64 + l]) + (dp[128 + l] + dp[192 + l]));
                __hip_atomic_store((unsigned*)(DG + ((size_t)hd * 128 + c) * 64 + l), __float_as_uint(den), RLX_AGENT);
                asm volatile("s_waitcnt vmcnt(15)" ::: "memory"); }
            else asm volatile("s_waitcnt vmcnt(12)" ::: "memory");
            }
        }
    }
    asm volatile("s_waitcnt vmcnt(0)" ::: "memory");
    __syncthreads();
    if (tid == 0) __hip_atomic_store(flag, 64u, RLX_AGENT);
    __syncthreads();
}

template <int VAR>
__device__ __forceinline__ void mlstm_unit(Frame& F, int hd, int vs, const bf16* QKC, const bf16* KTg, const bf16* VTg, const float* MG, const float* DEC, bf16* HM,
                                           const bf16* PG, const float* DG, gu32* flag) {
    LAS unsigned char* L = F.lds; const int tid = F.tid, lane = F.lane, wave = F.wave, r32 = lane & 31, hi = lane >> 5;
    for (int i = tid; i < (ML_PS - ML_CB) / 4; i += 512) ((LAS unsigned*)(L + ML_CB))[i] = 0u;
    f32x16 cacc;
#pragma unroll
    for (int r = 0; r < 16; ++r) cacc[r] = 0.f;
    const float* mgh = MG + (size_t)hd * 5 * S;
    v4u rq[2][4], rt[2][4], rv[2]; float rsc[2], rden[2]; unsigned long long rp0[2], rp1[2];
    const int sq = tid >> 5, dc = tid & 31;
    const int vv = tid >> 3, sc8 = tid & 7;
    const float* const scp = tid < 320 ? mgh + (size_t)(tid >> 6) * S + (tid & 63) : DEC + hd * 128; const int scstep = tid < 320 ? 64 : 1;
    const int vvc = vv & 31;
    unsigned pub0 = 0u, pub1 = 0u;
#define ML_NEED(c, P) do { const unsigned nd_ = (unsigned)(((c) >> 1) + 1); if (pub##P < nd_) { unsigned sp_ = 0u; do { pub##P = (unsigned)__builtin_amdgcn_readfirstlane(__hip_atomic_load(flag + 8 * P, RLX_AGENT)); if (pub##P >= nd_) break; __builtin_amdgcn_s_sleep(4); } while (++sp_ < (1u << 16)); } } while (0)
#define ML_LOAD_Q(c, P) do { \
        _Pragma("unroll") for (int i = 0; i < 4; ++i) rq[P][i] = *(const v4u*)(QKC + (size_t)(64 * (c) + sq + 16 * i) * 2048 + 256 * hd + 8 * dc); \
        rsc[P] = scp[(c) * scstep]; } while (0)
#define ML_LOAD_TV(c, P) do { const int t0_ = 64 * (c); ML_NEED(c, P); \
        _Pragma("unroll") for (int i = 0; i < 4; ++i) rt[P][i] = *(const v4u*)(KTg + (((size_t)(c) * 4 + hd) * 256 + vv + 64 * i) * 64 + 8 * sc8); \
        { const unsigned long long* pp_ = (const unsigned long long*)(PG + (((size_t)hd * 128 + (c)) * 64 + vv) * 64 + 8 * sc8); rp0[P] = __hip_atomic_load(pp_, RLX_AGENT); rp1[P] = __hip_atomic_load(pp_ + 1, RLX_AGENT); } \
        rden[P] = __uint_as_float(__hip_atomic_load((const unsigned*)(DG + ((size_t)hd * 128 + (c)) * 64 + (tid & 63)), RLX_AGENT)); \
        rv[P] = *(const v4u*)(VTg + (((size_t)(c) * 4 + hd) * 512 + 32 * vs + vvc) * 64 + 8 * sc8); (void)t0_; } while (0)
#define ML_STORE_Q(c, P) do { _Pragma("unroll") for (int i = 0; i < 4; ++i) *(LAS v4u*)(L + ML_QS + (sq + 16 * i) * 528 + dc * 16) = rq[P][i]; \
        if (tid <= 320) ((LAS float*)(L + ML_SC))[((c) & 1) * 336 + tid] = rsc[P]; } while (0)
#define ML_STORE_TV(P) do { _Pragma("unroll") for (int i = 0; i < 4; ++i) *(LAS v4u*)(L + ML_KT + (vv + 64 * i) * 144 + sc8 * 16) = rt[P][i]; \
        { LAS unsigned long long* ps_ = (LAS unsigned long long*)(L + ML_PS + vv * 144 + sc8 * 16); ps_[0] = rp0[P]; ps_[1] = rp1[P]; } \
        if (tid < 64) ((LAS float*)(L + ML_DENP))[tid] = rden[P]; \
        if (tid < 256) { *(LAS v4u*)(L + ML_VT + vv * 144 + sc8 * 16) = rv[P]; \
            const f32x4 w0_ = *(const LAS f32x4*)(L + ML_SC + (P * 336 + 256 + 8 * sc8) * 4), w1_ = *(const LAS f32x4*)(L + ML_SC + (P * 336 + 256 + 8 * sc8 + 4) * 4);     \
            float vf[8]; unpk8(rv[P], vf); vf[0] *= w0_.x; vf[1] *= w0_.y; vf[2] *= w0_.z; vf[3] *= w0_.w; vf[4] *= w1_.x; vf[5] *= w1_.y; vf[6] *= w1_.z; vf[7] *= w1_.w; \
            *(LAS v4u*)(L + ML_VW + vv * 144 + sc8 * 16) = pk8(vf); } } while (0)
#define ML_STEP(c, P) do { \
        if (!(VAR & 32)) ML_STORE_TV(P); \
        if (!(VAR & 16) && (c) + 2 < 128) ML_LOAD_TV((c) + 2, P); \
        const LAS float* SC = (const LAS float*)(L + ML_SC) + P * 336; \
        f32x16 hacc; \
        if (!(VAR & 4) && (wave == 4 || wave == 5 || wave < 2)) { \
            const int ti = wave & 1, kh = wave < 2 ? 1 : 0; \
            _Pragma("unroll") for (int r = 0; r < 16; ++r) hacc[r] = 0.f; \
            const LAS unsigned char* ca = L + ML_CB + r32 * 528 + hi * 16 + kh * 256; const LAS unsigned char* qb = L + ML_QS + (32 * ti + r32) * 528 + hi * 16 + kh * 256; \
            _Pragma("unroll") for (int kk = 0; kk < 8; ++kk) hacc = __builtin_amdgcn_mfma_f32_32x32x16_bf16(*(const LAS bf16x8*)(ca + kk * 32), *(const LAS bf16x8*)(qb + kk * 32), hacc, 0, 0, 0); \
            ML_CHAIN_SCHED(8); \
            if (wave < 2) { \
                _Pragma("unroll") for (int g = 0; g < 4; ++g) *(LAS f32x4*)(L + ML_KS + wave * 4096 + g * 1024 + lane * 16) = (f32x4){hacc[4 * g], hacc[4 * g + 1], hacc[4 * g + 2], hacc[4 * g + 3]}; } \
        } \
        __syncthreads(); \
        if (!(VAR & 64) && (wave == 4 || wave == 5)) { \
            const int ti = wave - 4, t = 32 * ti + r32; const float wi = SC[128 + t], nr = SC[192 + t]; \
            const float den = ((const LAS float*)(L + ML_DENP))[t];     \
            _Pragma("unroll") for (int g = 0; g < 4; ++g) { const f32x4 px = *(const LAS f32x4*)(L + ML_KS + ti * 4096 + g * 1024 + lane * 16); \
                hacc[4 * g] = (hacc[4 * g] + px.x) * wi; hacc[4 * g + 1] = (hacc[4 * g + 1] + px.y) * wi; hacc[4 * g + 2] = (hacc[4 * g + 2] + px.z) * wi; hacc[4 * g + 3] = (hacc[4 * g + 3] + px.w) * wi; } \
            const LAS unsigned char* va = L + ML_VT + r32 * 144 + hi * 16; const LAS unsigned char* pb = L + ML_PS + t * 144 + hi * 16; \
            __builtin_amdgcn_sched_barrier(0); \
            _Pragma("unroll") for (int kk = 0; kk < 4; ++kk) hacc = __builtin_amdgcn_mfma_f32_32x32x16_bf16(*(const LAS bf16x8*)(va + kk * 32), *(const LAS bf16x8*)(pb + kk * 32), hacc, 0, 0, 0); \
            ML_SGB(0x100, 8); ML_SGB(0x008, 4); __builtin_amdgcn_sched_barrier(0); \
            const float inv = 1.0f / fmaxf(fabsf(den), nr); \
            bf16* op = HM + (size_t)(64 * (c) + t) * 2048 + 512 * hd + 32 * vs + 4 * hi; \
            _Pragma("unroll") for (int g = 0; g < 4; ++g) *(unsigned long long*)(op + 8 * g) = (unsigned long long)pg8::cvt_pk_bf16(hacc[4 * g] * inv, hacc[4 * g + 1] * inv) | ((unsigned long long)pg8::cvt_pk_bf16(hacc[4 * g + 2] * inv, hacc[4 * g + 3] * inv) << 32); \
        } \
        if (!(VAR & 8)) { const float dcy = SC[320]; \
          _Pragma("unroll") for (int r = 0; r < 16; ++r) cacc[r] *= dcy; \
          const LAS unsigned char* ka = L + ML_KT + (32 * wave + r32) * 144 + hi * 16; const LAS unsigned char* vb = L + ML_VW + r32 * 144 + hi * 16; \
          __builtin_amdgcn_sched_barrier(0); \
          _Pragma("unroll") for (int kk = 0; kk < 4; ++kk) cacc = __builtin_amdgcn_mfma_f32_32x32x16_bf16(*(const LAS bf16x8*)(ka + kk * 32), *(const LAS bf16x8*)(vb + kk * 32), cacc, 0, 0, 0); \
          ML_SGB(0x100, 8); ML_SGB(0x008, 4); __builtin_amdgcn_sched_barrier(0); \
          _Pragma("unroll") for (int g = 0; g < 4; ++g) *(LAS unsigned long long*)(L + ML_CB + r32 * 528 + (32 * wave + 8 * g + 4 * hi) * 2) = (unsigned long long)pg8::cvt_pk_bf16(cacc[4 * g], cacc[4 * g + 1]) | ((unsigned long long)pg8::cvt_pk_bf16(cacc[4 * g + 2], cacc[4 * g + 3]) << 32); \
        } \
        if ((c) + 1 < 128) { if (!(VAR & 32)) ML_STORE_Q((c) + 1, 1 - P); if (!(VAR & 16) && (c) + 3 < 128) ML_LOAD_Q((c) + 3, 1 - P); } \
        __syncthreads(); } while (0)
    ML_LOAD_Q(0, 0); ML_LOAD_TV(0, 0); ML_LOAD_Q(1, 1); ML_LOAD_TV(1, 1);
    ML_STORE_Q(0, 0);
    ML_LOAD_Q(2, 0);
    __syncthreads();
#pragma nounroll
    for (int c = 0; c < 128; c += 2) { ML_STEP(c, 0); ML_STEP(c + 1, 1); }
#undef ML_STEP
#undef ML_NEED
#undef ML_LOAD_Q
#undef ML_LOAD_TV
#undef ML_STORE_Q
#undef ML_STORE_TV
}

constexpr int M2_QS = 0, M2_CB = 33792, M2_KT = 67584, M2_VT = 104448, M2_VW = 113664, M2_PS = 122880, M2_SC = 132096  , M2_DENP = 134784, M2_END = 135040;
template <int VAR>
__device__ __forceinline__ void mlstm_unit64(Frame& F, int hd, int vs, const bf16* QKC, const bf16* KTg, const bf16* VTg, const float* MG, const float* DEC, bf16* HM,
                                           const bf16* PG, const float* DG, gu32* flag) {
    LAS unsigned char* L = F.lds; const int tid = F.tid, lane = F.lane, wave = F.wave, r32 = lane & 31, hi = lane >> 5;
    for (int i = tid; i < 33792 / 4; i += 512) ((LAS unsigned*)(L + M2_CB))[i] = 0u;
    f32x16 cacc0, cacc1;
#pragma unroll
    for (int r = 0; r < 16; ++r) { cacc0[r] = 0.f; cacc1[r] = 0.f; }
    const float* mgh = MG + (size_t)hd * 5 * S;
    v4u rq[2][4], rt[2][4], rv[2]; float rsc[2], rden[2]; unsigned long long rp0[2], rp1[2];
    const int sq = tid >> 5, dc = tid & 31;
    const int vv = tid >> 3, sc8 = tid & 7;
    const float* const scp = tid < 320 ? mgh + (size_t)(tid >> 6) * S + (tid & 63) : DEC + hd * 128; const int scstep = tid < 320 ? 64 : 1;
    const int vvc = vv & 31;
    unsigned pub0 = 0u, pub1 = 0u;
#define ML_NEED(c, P) do { const unsigned nd_ = (unsigned)(((c) >> 1) + 1); if (pub##P < nd_) { unsigned sp_ = 0u; do { pub##P = (unsigned)__builtin_amdgcn_readfirstlane(__hip_atomic_load(flag + 8 * P, RLX_AGENT)); if (pub##P >= nd_) break; __builtin_amdgcn_s_sleep(4); } while (++sp_ < (1u << 16)); } } while (0)
#define ML_LOAD_Q(c, P) do { \
        _Pragma("unroll") for (int i = 0; i < 4; ++i) rq[P][i] = *(const v4u*)(QKC + (size_t)(64 * (c) + sq + 16 * i) * 2048 + 256 * hd + 8 * dc); \
        rsc[P] = scp[(c) * scstep]; } while (0)
#define ML_LOAD_TV(c, P) do { const int t0_ = 64 * (c); ML_NEED(c, P); \
        _Pragma("unroll") for (int i = 0; i < 4; ++i) rt[P][i] = *(const v4u*)(KTg + (((size_t)(c) * 4 + hd) * 256 + vv + 64 * i) * 64 + 8 * sc8); \
        { const unsigned long long* pp_ = (const unsigned long long*)(PG + (((size_t)hd * 128 + (c)) * 64 + vv) * 64 + 8 * sc8); rp0[P] = __hip_atomic_load(pp_, RLX_AGENT); rp1[P] = __hip_atomic_load(pp_ + 1, RLX_AGENT); } \
        rden[P] = __uint_as_float(__hip_atomic_load((const unsigned*)(DG + ((size_t)hd * 128 + (c)) * 64 + (tid & 63)), RLX_AGENT)); \
        rv[P] = *(const v4u*)(VTg + (((size_t)(c) * 4 + hd) * 512 + 64 * vs + vv) * 64 + 8 * sc8); (void)t0_; } while (0)
#define ML_STORE_Q(c, P) do { _Pragma("unroll") for (int i = 0; i < 4; ++i) *(LAS v4u*)(L + M2_QS + (sq + 16 * i) * 528 + dc * 16) = rq[P][i]; \
        if (tid <= 320) ((LAS float*)(L + M2_SC))[((c) & 1) * 336 + tid] = rsc[P]; } while (0)
#define ML_STORE_TV(P) do { _Pragma("unroll") for (int i = 0; i < 4; ++i) *(LAS v4u*)(L + M2_KT + (vv + 64 * i) * 144 + sc8 * 16) = rt[P][i]; \
        { LAS unsigned long long* ps_ = (LAS unsigned long long*)(L + M2_PS + vv * 144 + sc8 * 16); ps_[0] = rp0[P]; ps_[1] = rp1[P]; } \
        if (tid < 64) ((LAS float*)(L + M2_DENP))[tid] = rden[P]; \
        { *(LAS v4u*)(L + M2_VT + vv * 144 + sc8 * 16) = rv[P]; \
            const f32x4 w0_ = *(const LAS f32x4*)(L + M2_SC + (P * 336 + 256 + 8 * sc8) * 4), w1_ = *(const LAS f32x4*)(L + M2_SC + (P * 336 + 256 + 8 * sc8 + 4) * 4);     \
            float vf[8]; unpk8(rv[P], vf); vf[0] *= w0_.x; vf[1] *= w0_.y; vf[2] *= w0_.z; vf[3] *= w0_.w; vf[4] *= w1_.x; vf[5] *= w1_.y; vf[6] *= w1_.z; vf[7] *= w1_.w; \
            *(LAS v4u*)(L + M2_VW + vv * 144 + sc8 * 16) = pk8(vf); } } while (0)
#define ML_STEP(c, P) do { \
        if (!(VAR & 32)) ML_STORE_TV(P); \
        if (!(VAR & 16) && (c) + 2 < 128) ML_LOAD_TV((c) + 2, P); \
        const LAS float* SC = (const LAS float*)(L + M2_SC) + P * 336; \
        f32x16 hacc; \
        if (!(VAR & 4) && wave < 4) {                    \
            const int vi = wave >> 1, ti = wave & 1; \
            _Pragma("unroll") for (int r = 0; r < 16; ++r) hacc[r] = 0.f; \
            const LAS unsigned char* ca = L + M2_CB + (32 * vi + r32) * 528 + hi * 16; const LAS unsigned char* qb = L + M2_QS + (32 * ti + r32) * 528 + hi * 16; \
            _Pragma("unroll") for (int kk = 0; kk < 16; ++kk) hacc = __builtin_amdgcn_mfma_f32_32x32x16_bf16(*(const LAS bf16x8*)(ca + kk * 32), *(const LAS bf16x8*)(qb + kk * 32), hacc, 0, 0, 0); \
            ML_CHAIN_SCHED(16); \
        } \
        __syncthreads(); \
        if (!(VAR & 64) && wave < 4) { \
            const int vi = wave >> 1, ti = wave & 1, t = 32 * ti + r32; const float wi = SC[128 + t], nr = SC[192 + t]; \
            const float den = ((const LAS float*)(L + M2_DENP))[t];     \
            _Pragma("unroll") for (int r = 0; r < 16; ++r) hacc[r] *= wi; \
            const LAS unsigned char* va = L + M2_VT + (32 * vi + r32) * 144 + hi * 16; const LAS unsigned char* pb = L + M2_PS + t * 144 + hi * 16; \
            __builtin_amdgcn_sched_barrier(0); \
            _Pragma("unroll") for (int kk = 0; kk < 4; ++kk) hacc = __builtin_amdgcn_mfma_f32_32x32x16_bf16(*(const LAS bf16x8*)(va + kk * 32), *(const LAS bf16x8*)(pb + kk * 32), hacc, 0, 0, 0); \
            ML_SGB(0x100, 8); ML_SGB(0x008, 4); __builtin_amdgcn_sched_barrier(0); \
            const float inv = 1.0f / fmaxf(fabsf(den), nr); \
            bf16* op = HM + (size_t)(64 * (c) + t) * 2048 + 512 * hd + 64 * vs + 32 * vi + 4 * hi; \
            _Pragma("unroll") for (int g = 0; g < 4; ++g) *(unsigned long long*)(op + 8 * g) = (unsigned long long)pg8::cvt_pk_bf16(hacc[4 * g] * inv, hacc[4 * g + 1] * inv) | ((unsigned long long)pg8::cvt_pk_bf16(hacc[4 * g + 2] * inv, hacc[4 * g + 3] * inv) << 32); \
        } \
        if (!(VAR & 8)) { const float dcy = SC[320]; \
          _Pragma("unroll") for (int r = 0; r < 16; ++r) { cacc0[r] *= dcy; cacc1[r] *= dcy; } \
          const LAS unsigned char* ka = L + M2_KT + (32 * wave + r32) * 144 + hi * 16; const LAS unsigned char* vb = L + M2_VW + r32 * 144 + hi * 16; \
          _Pragma("unroll") for (int kk = 0; kk < 4; ++kk) { const bf16x8 kfr = *(const LAS bf16x8*)(ka + kk * 32); \
              cacc0 = __builtin_amdgcn_mfma_f32_32x32x16_bf16(kfr, *(const LAS bf16x8*)(vb + kk * 32), cacc0, 0, 0, 0); \
              cacc1 = __builtin_amdgcn_mfma_f32_32x32x16_bf16(kfr, *(const LAS bf16x8*)(vb + 32 * 144 + kk * 32), cacc1, 0, 0, 0); } \
          _Pragma("unroll") for (int g = 0; g < 4; ++g) { \
              *(LAS unsigned long long*)(L + M2_CB + r32 * 528 + (32 * wave + 8 * g + 4 * hi) * 2) = (unsigned long long)pg8::cvt_pk_bf16(cacc0[4 * g], cacc0[4 * g + 1]) | ((unsigned long long)pg8::cvt_pk_bf16(cacc0[4 * g + 2], cacc0[4 * g + 3]) << 32); \
              *(LAS unsigned long long*)(L + M2_CB + (32 + r32) * 528 + (32 * wave + 8 * g + 4 * hi) * 2) = (unsigned long long)pg8::cvt_pk_bf16(cacc1[4 * g], cacc1[4 * g + 1]) | ((unsigned long long)pg8::cvt_pk_bf16(cacc1[4 * g + 2], cacc1[4 * g + 3]) << 32); } \
        } \
        if ((c) + 1 < 128) { if (!(VAR & 32)) ML_STORE_Q((c) + 1, 1 - P); if (!(VAR & 16) && (c) + 3 < 128) ML_LOAD_Q((c) + 3, 1 - P); } \
        __syncthreads(); } while (0)
    ML_LOAD_Q(0, 0); ML_LOAD_TV(0, 0); ML_LOAD_Q(1, 1); ML_LOAD_TV(1, 1);
    ML_STORE_Q(0, 0);
    ML_LOAD_Q(2, 0);
    __syncthreads();
#pragma nounroll
    for (int c = 0; c < 128; c += 2) { ML_STEP(c, 0); ML_STEP(c + 1, 1); }
#undef ML_STEP
#undef ML_NEED
#undef ML_LOAD_Q
#undef ML_LOAD_TV
#undef ML_STORE_Q
#undef ML_STORE_TV
}

__device__ __forceinline__ void post_phase(Frame& F, const bf16* HM, const bf16* OG, const bf16* O1, const bf16* O2, const float* gm, const float* gd, const float* lmb, float lam_init, bf16* AM, bf16* AB) {
    const float lam = expf(wave_sum(lmb[F.lane] * lmb[64 + F.lane])) - expf(wave_sum(lmb[128 + F.lane] * lmb[192 + F.lane])) + lam_init;
    const float omli = 1.0f - lam_init;
    LAS f32x4* GM = (LAS f32x4*)F.lds; LAS f32x4* GD = GM + 512;
    GM[F.tid] = ((const f32x4*)gm)[F.tid]; GD[F.tid] = ((const f32x4*)gd)[F.tid] * omli;
    __syncthreads();
    const int gw = F.vcu * NWAVES + F.wave, NGW = F.G * NWAVES;
    v4u a0[4][4], a1[4][4];
#define PP_LOAD(Bf, row) do { _Pragma("unroll") for (int j = 0; j < 4; ++j) { const size_t off = (size_t)(row) * 2048 + 8 * F.lane + 512 * j; \
        Bf[j][0] = *(const v4u*)(HM + off); Bf[j][1] = *(const v4u*)(OG + off); Bf[j][2] = *(const v4u*)(O1 + off); Bf[j][3] = *(const v4u*)(O2 + off); } } while (0)
#define PP_PROC(Bf, row) do { _Pragma("unroll") for (int j = 0; j < 4; ++j) { const size_t off = (size_t)(row) * 2048 + 8 * F.lane + 512 * j; \
        float h[8], og[8], o1[8], o2[8], o[8]; unpk8(Bf[j][0], h); unpk8(Bf[j][1], og); unpk8(Bf[j][2], o1); unpk8(Bf[j][3], o2); \
        const f32x4 ga0 = GM[2 * F.lane + 128 * j], ga1 = GM[2 * F.lane + 128 * j + 1], gb0 = GD[2 * F.lane + 128 * j], gb1 = GD[2 * F.lane + 128 * j + 1]; \
        const float ga[8] = {ga0.x, ga0.y, ga0.z, ga0.w, ga1.x, ga1.y, ga1.z, ga1.w}, gb[8] = {gb0.x, gb0.y, gb0.z, gb0.w, gb1.x, gb1.y, gb1.z, gb1.w}; \
        float ss = 0.f, sd = 0.f; \
        _Pragma("unroll") for (int e = 0; e < 8; ++e) { ss += h[e] * h[e]; o[e] = o1[e] - lam * o2[e]; sd += o[e] * o[e]; } \
        ss = wave_sum(ss); sd += xor_lanes<1>(sd); sd += xor_lanes<2>(sd); sd += xor_lanes<4>(sd); sd += xor_lanes<8>(sd); \
        const float rm = 1.0f / sqrtf(ss * (1.0f / 512.0f) + EPS), rd = 1.0f / sqrtf(sd * (1.0f / 128.0f) + EPS); \
        _Pragma("unroll") for (int e = 0; e < 8; ++e) { h[e] = og[e] * (h[e] * rm * ga[e]); o[e] = o[e] * rd * gb[e]; } \
        const size_t off2 = (size_t)(row) * 4096 + 8 * F.lane + 512 * j; *(v4u*)(AM + off2 + 2048) = pk8(h); *(v4u*)(AM + off2) = pk8(o); } } while (0)
    int row = gw;
    if (row < S) PP_LOAD(a0, row);
    for (; row < S; row += 2 * NGW) {
        const int r1 = row + NGW, r2 = row + 2 * NGW;
        if (r1 < S) PP_LOAD(a1, r1);
        PP_PROC(a0, row);
        if (r2 < S) PP_LOAD(a0, r2);
        if (r1 < S) PP_PROC(a1, r1);
    }
#undef PP_LOAD
#undef PP_PROC
    __syncthreads();
}

__device__ __forceinline__ void drain_copy_queue(Frame& F, const __attribute__((address_space(4))) Args* A, unsigned char* ws, gu32* qc, int l) {
    const int n_own = WI_LAYER - WI_IN, n_conv = n_own + (l + 1 < DEPTH ? WI_IN : 0), n_items = n_conv + (l + 1 < DEPTH ? 1536 : 0); LAS float* scr = (LAS float*)(F.lds + F.wave * 16640);
    static_assert((WI_LAYER - WI_IN) % 32 == 0 && WI_IN % 32 == 0 && 1536 % 32 == 0, "copy-queue groups");
    for (;;) {
        __syncthreads();
        if (F.tid == 0) F.MISC[0] = __hip_atomic_fetch_add(qc, 1u, RLX_AGENT);
        __syncthreads();
        const int base = (int)F.MISC[0] * 32;
        if (base >= n_items) break;
        if (base >= n_conv) {
#pragma unroll 1
            for (int j = 0; j < 4; j += 2) adaln_item2(A->in[1], A->in[3], ws, l + 1, base - n_conv + 8 * j + F.wave, base - n_conv + 8 * (j + 1) + F.wave, F.lane);
        } else {
#define DCQ_DESC(j, d) witem_desc(A->in[9], A->in[17], A->in[18], A->in[19], A->in[20], A->in[21], A->in[24], ws, (base + 8 * (j) + F.wave) < n_own ? l : l + 1, \
                                  (base + 8 * (j) + F.wave) < n_own ? base + 8 * (j) + F.wave + WI_IN : base + 8 * (j) + F.wave - n_own, F.lane, d)
            WItem d0, d1; f32x4 va[16], vb[16];
            const int l0 = DCQ_DESC(0, d0); WITEM_ISSUE(d0, l0, va);
            const int l1 = DCQ_DESC(1, d1); WITEM_ISSUE(d1, l1, vb);
            witem_finish(d0, va, scr, F.lane);
            const int l2 = DCQ_DESC(2, d0); WITEM_ISSUE(d0, l2, va);
            witem_finish(d1, vb, scr, F.lane);
            const int l3 = DCQ_DESC(3, d1); WITEM_ISSUE(d1, l3, vb);
            witem_finish(d0, va, scr, F.lane);
            witem_finish(d1, vb, scr, F.lane);
#undef DCQ_DESC
        }
    }
}

typedef const __attribute__((address_space(4))) Args* CArgs;
__device__ __forceinline__ CArgs get_args() { CArgs p = (CArgs)__builtin_amdgcn_kernarg_segment_ptr(); asm volatile("" : "+s"(p)); return p; }
#define P8B(ws, i) ((bf16*)((ws) + WS_P8 + (size_t)(i) * P8_STRIDE))
__global__ void __launch_bounds__(NWAVES * 64, 2) trunk_fwd(Args args_unused) {
    extern __shared__ __attribute__((aligned(16))) unsigned char lds[];
    Frame F;
    F.lds = (LAS unsigned char*)lds; F.MISC = (volatile LAS unsigned*)(F.lds + MISC_OFF);
    F.tid = threadIdx.x; F.lane = F.tid & 63; F.wave = __builtin_amdgcn_readfirstlane(F.tid >> 6);
    F.G = gridDim.x; { const int bx = blockIdx.x; F.vcu = (F.G % 8 == 0) ? (bx % 8) * (F.G / 8) + bx / 8 : bx; }
    F.ctl = (gu32*)(get_args()->ws + WS_CTL);
#ifdef DBG_POISON
    for (int u = F.tid; u < LDSCTL_OFF / 4; u += NWAVES * 64) ((LAS unsigned*)F.lds)[u] = 0xAAAAAAAAu;
#endif
    for (int u = F.tid; u < (LDS_BYTES - LDSCTL_OFF) / 4; u += NWAVES * 64) ((LAS unsigned*)(F.lds + LDSCTL_OFF))[u] = 0u;
    __syncthreads();
#if MK_ONE_LAUNCH
    XcdBarrier bar = xcd_barrier_post((unsigned*)(F.ctl + CW_BAR), F.MISC + 8);
#define GRID_BAR() do { XcdBarrier b_ = bar; asm volatile("" : "+s"(b_.bar)); xcd_barrier(b_); } while (0)
#else
#define GRID_BAR() do { } while (0)
#endif
#ifdef PROF_K1
#ifndef PROF_SHIFT
#define PROF_SHIFT 0.5f
#endif
    LAS unsigned long long* pacc = (LAS unsigned long long*)(F.lds + LDSCTL_OFF);
    if (blockIdx.x == 0 && F.tid == 0) pacc[15] = rt();
#define PROF_MARK(k) do { if (blockIdx.x == 0 && F.wave == 0 && fresh_tid(0) == 0) { const unsigned long long t_ = rt(); pacc[k] += t_ - pacc[15]; pacc[15] = t_; } } while (0)
#else
#define PROF_MARK(k) do { } while (0)
#endif
    const int lo = get_args()->ph_lo, hi = get_args()->ph_hi;
#ifndef PH_MASK
#define PH_MASK 0xFFFFFFFFu
#endif
#define EN(k) ((PH_MASK >> (k)) & 1u)
#ifndef DUPMASK
#define DUPMASK 0u
#endif
#ifndef DUPMODE
#define DUPMODE 1
#endif
#define REPS(k) (1 + (int)((DUPMASK >> (k)) & 1u))
#define IN(k) (lo <= (k) && (k) < hi)
#define BOTH(k) (IN(k) && IN((k) + 1))
    if (EN(13) && IN(0)) {
#pragma nounroll
        for (int rep = 0; rep < REPS(13); ++rep) { p0_prologue(F, get_args()); if (BOTH(0) || rep + 1 < REPS(13)) GRID_BAR(); } PROF_MARK(13); }
    if (EN(14) && IN(1)) { p0b_mod_reduce(F, get_args(), 0); if (BOTH(1)) GRID_BAR(); PROF_MARK(14); }
#ifdef XBARS
#pragma nounroll
    for (int xb = 0; xb < XBARS; ++xb) GRID_BAR();
#endif

    for (int l = 0; l < DEPTH; ++l) {
        const int pb = 2 + NPH_LAYER * l;
        if (EN(0) && IN(pb + 0) && l == 0) { { CArgs A = get_args(); unsigned char* ws = A->ws; F.tid = fresh_tid(F.wave); F.lane = F.tid & 63; const float* mod = (const float*)(ws + WS_MOD);
                row_phase<false, true, true>(F, A->in[0], nullptr, nullptr, nullptr, nullptr, A->in[5], mod + D, mod, (bf16*)(ws + WS_H), (const float*)(ws + WS_WG), A->in[12], A->in[13], (float*)(ws + WS_GATES)); }
            if (BOTH(pb + 0)) GRID_BAR(); PROF_MARK(0); }
        if (EN(1) && IN(pb + 1))
#pragma nounroll
        for (int rep = 0; rep < REPS(1); ++rep) { CArgs A = get_args(); unsigned char* ws = A->ws; F.tid = fresh_tid(F.wave); F.lane = F.tid & 63; const float* ropeC = (const float*)(ws + WS_ROPE);
            pg8::Gemm g{(const bf16*)(ws + WS_H), (const bf16*)(ws + WS_W + (size_t)l * W_LAYER + WO_IN), S, NINP, D}; pg8::StaticOrder So; So.init(S, NINP, F.G, (int)blockIdx.x);
            pg8::EpiIn E{P8B(ws, 0), P8_STRIDE / 2, ropeC, ropeC + S * 8, attn_body::C2};
            pg8::gemm_phase<pg8::EpiIn, pg8::StaticOrder, true, true>(F.lds, g, So, E, F.wave);
            if (BOTH(pb + 1) || rep + 1 < REPS(1)) GRID_BAR(); PROF_MARK(1); }
        if (EN(2) && IN(pb + 2))
#pragma nounroll
        for (int rep = 0; rep < REPS(2); ++rep) { CArgs A = get_args(); unsigned char* ws = A->ws; F.tid = fresh_tid(F.wave); F.lane = F.tid & 63;
            prep_phase(F, P8B(ws, 0), P8B(ws, 1), (bf16*)(ws + WS_QKC), (bf16*)(ws + WS_KT), (bf16*)(ws + WS_VT), A->in[10] + (size_t)l * 4 * 2048, A->in[11] + (size_t)l * 2048);
            __syncthreads();
            if (blockIdx.x < 4) gate_scan(F, (int)blockIdx.x, (const float*)(ws + WS_GATES), (float*)(ws + WS_MG), (float*)(ws + WS_DEC));
            if (BOTH(pb + 2) || rep + 1 < REPS(2)) GRID_BAR(); PROF_MARK(2); }
        if (EN(3) && IN(pb + 3))
#pragma nounroll
        for (int rep = 0; rep < REPS(3); ++rep) { CArgs A = get_args(); unsigned char* ws = A->ws; F.tid = fresh_tid(F.wave); F.lane = F.tid & 63; __syncthreads();
            {
#ifndef PVAR
#define PVAR 0
#endif
#ifndef MLVAR
#define MLVAR 0
#endif
#ifndef TPROBE_REP
#define TPROBE_REP 0
#endif
#ifdef TPROBE_WG
            unsigned long long tp0_ = 0ull; if ((int)blockIdx.x == TPROBE_WG && l == TPROBE_L && rep == TPROBE_REP) tp0_ = rt();
#endif
#ifdef XLOC
            const bool isu_ = blockIdx.x < 64 && (blockIdx.x & 7) < 4, isp_ = blockIdx.x >= 128 && blockIdx.x < 144 && (blockIdx.x & 7) < 4; const int uhd_ = (int)blockIdx.x & 7, uvs_ = (int)blockIdx.x >> 3;
            { const int ph = ((int)blockIdx.x - 128) & 7, pp = ((int)blockIdx.x - 128) >> 3, ch = (int)blockIdx.x >> 4;
#else
            const bool isu_ = blockIdx.x < 32, isp_ = blockIdx.x >= 128 && blockIdx.x < 136; const int uhd_ = (int)blockIdx.x >> 3, uvs_ = (int)blockIdx.x & 7;
            { const int ph = ((int)blockIdx.x - 128) >> 1, pp = ((int)blockIdx.x - 128) & 1, ch = (int)blockIdx.x >> 4;
#endif
              const bool dupml = DUPMODE == 1 || DUPMODE == 4;
              gu32* const pfl = F.ctl + CW_PF + 64 * (4 * l) + 32 * rep;
              if (rep == 0 && isp_) mlstm_p_producer<0>(F, ph, pp, (const bf16*)(ws + WS_QKC), (const bf16*)(ws + WS_KT), (const float*)(ws + WS_MG), (const float*)(ws + WS_DEC), (bf16*)(ws + WS_PG), (float*)(ws + WS_DG), pfl + 64 * ph + 8 * pp);
              if (rep == 1 && (dupml || DUPMODE == 5) && blockIdx.x >= 128 && blockIdx.x < 136) mlstm_p_producer<PVAR>(F, ph, pp, (const bf16*)(ws + WS_QKC), (const bf16*)(ws + WS_KT), (const float*)(ws + WS_MG), (const float*)(ws + WS_DEC), (bf16*)(ws + WS_PG), (float*)(ws + WS_DG), pfl + 64 * ph + 8 * pp);
#ifdef VS64
              if (rep == 0 && isu_) mlstm_unit64<0>(F, uhd_, uvs_, (const bf16*)(ws + WS_QKC), (const bf16*)(ws + WS_KT), (const bf16*)(ws + WS_VT), (const float*)(ws + WS_MG), (const float*)(ws + WS_DEC), (bf16*)(ws + WS_HM),
                                            (const bf16*)(ws + WS_PG), (const float*)(ws + WS_DG), pfl + 64 * uhd_);
#else
              if (rep == 0 && blockIdx.x < 64) mlstm_unit<0>(F, ch, (int)blockIdx.x & 15, (const bf16*)(ws + WS_QKC), (const bf16*)(ws + WS_KT), (const bf16*)(ws + WS_VT), (const float*)(ws + WS_MG), (const float*)(ws + WS_DEC), (bf16*)(ws + WS_HM),
                                            (const bf16*)(ws + WS_PG), (const float*)(ws + WS_DG), pfl + 64 * ch);
#endif
              if (rep == 1 && (dupml || DUPMODE == 3 || DUPMODE == 6) && blockIdx.x < 64) mlstm_unit<MLVAR>(F, ch, (int)blockIdx.x & 15, (const bf16*)(ws + WS_QKC), (const bf16*)(ws + WS_KT), (const bf16*)(ws + WS_VT), (const float*)(ws + WS_MG), (const float*)(ws + WS_DEC),
                                            (bf16*)(ws + ((MLVAR != 0 || PVAR != 0) ? WS_T : WS_HM)), (const bf16*)(ws + WS_PG), (const float*)(ws + WS_DG), pfl + 64 * ch - (dupml ? 0 : 32));
            }
#ifdef TPROBE_WG
            if ((int)blockIdx.x == TPROBE_WG && l == TPROBE_L && rep == TPROBE_REP && F.tid == 0) { const unsigned long long d_ = rt() - tp0_; __hip_atomic_store(F.ctl + 2040, (unsigned)d_, RLX_AGENT); }
#endif
            }
            if (blockIdx.x >= 64 && blockIdx.x < 64 + CONV_WGS && rep == 0) drain_copy_queue(F, A, ws, F.ctl + CW_Q + 64 * (8 + l), l);
            gu32* qh = F.ctl + CW_Q + 64 * (l + 4 * rep);
            const attn_body::bf16* Qb = (const attn_body::bf16*)P8B(ws, 3); const attn_body::bf16* Kb = (const attn_body::bf16*)P8B(ws, 4); const attn_body::bf16* Vb = (const attn_body::bf16*)P8B(ws, 5);
            attn_body::bf16* O1 = (attn_body::bf16*)(ws + WS_O1); attn_body::bf16* O2 = (attn_body::bf16*)(ws + WS_O2);
            for (;;) {
                __syncthreads();
                if (F.tid == 0) F.MISC[0] = __hip_atomic_fetch_add(qh, 1u, RLX_AGENT);
                __syncthreads();
                const unsigned idx = F.MISC[0];
                if (idx >= 1024u || (rep == 1 && (DUPMODE == 3 || DUPMODE == 4 || DUPMODE == 5))) break;
                const int qb = 31 - (int)(idx >> 5), bh = (int)(idx & 31u), hh = bh >> 1, cm = bh & 1;
                attn_body::attn_unit<8>(qb, Qb + hh * 128 + cm * 64, Kb + hh * 128 + cm * 64, Vb + hh * 128, (cm ? O2 : O1) + hh * 128, (char*)lds, F.wave);
            }
            if (BOTH(pb + 3) || rep + 1 < REPS(3)) GRID_BAR(); PROF_MARK(3); }
        if (EN(5) && IN(pb + 5))
#pragma nounroll
        for (int rep = 0; rep < REPS(5); ++rep) { CArgs A = get_args(); unsigned char* ws = A->ws; F.tid = fresh_tid(F.wave); F.lane = F.tid & 63;
            if (l + 1 < DEPTH && rep == 0) p0b_mod_reduce(F, A, l + 1);
            post_phase(F, (const bf16*)(ws + WS_HM), P8B(ws, 2), (const bf16*)(ws + WS_O1), (const bf16*)(ws + WS_O2), A->in[14] + (size_t)l * 2048, A->in[16] + (size_t)l * 2048, A->in[15] + (size_t)l * 256,
                       0.8f - 0.6f * expf(-0.3f * (float)l), (bf16*)(ws + WS_AM), (bf16*)(ws + WS_AB));
            if (BOTH(pb + 5) || rep + 1 < REPS(5)) GRID_BAR(); PROF_MARK(5); }
        if (EN(6) && IN(pb + 6))
#pragma nounroll
        for (int rep = 0; rep < REPS(6); ++rep) { CArgs A = get_args(); unsigned char* ws = A->ws; F.tid = fresh_tid(F.wave); F.lane = F.tid & 63; __syncthreads();
            pg8::Gemm g{(const bf16*)(ws + WS_AM), (const bf16*)(ws + WS_W + (size_t)l * W_LAYER + WO_A), S, D, 2 * D}; pg8::SplitK2Order So; So.base.init(S, D, F.G, (int)blockIdx.x);
            pg8::EpiMerge2 E{P8B(ws, 6), P8B(ws, 7), (bf16*)(ws + WS_MRG)};
            pg8::gemm_phase<pg8::EpiMerge2, pg8::SplitK2Order, true, true>(F.lds, g, So, E, F.wave);
            if (BOTH(pb + 6) || rep + 1 < REPS(6)) GRID_BAR(); PROF_MARK(6); }
        if (EN(7) && IN(pb + 7))
#pragma nounroll
        for (int rep = 0; rep < REPS(7); ++rep) { CArgs A = get_args(); unsigned char* ws = A->ws; F.tid = fresh_tid(F.wave); F.lane = F.tid & 63; __syncthreads();
            pg8::Gemm g{(const bf16*)(ws + WS_MRG), (const bf16*)(ws + WS_W + (size_t)l * W_LAYER + WO_OUT), S, D, D}; pg8::StaticOrder So; So.init(S, D, F.G, (int)blockIdx.x); pg8::EpiPlain E{(bf16*)(ws + WS_Y), D};
            pg8::gemm_phase<pg8::EpiPlain, pg8::StaticOrder, true, true>(F.lds, g, So, E, F.wave);
            if (BOTH(pb + 7) || rep + 1 < REPS(7)) GRID_BAR(); PROF_MARK(7); }
        if (EN(8) && IN(pb + 8))
#pragma nounroll
        for (int rep = 0; rep < REPS(8); ++rep) { CArgs A = get_args(); unsigned char* ws = A->ws; F.tid = fresh_tid(F.wave); F.lane = F.tid & 63; __syncthreads(); const float* mod = (const float*)(ws + WS_MOD) + (size_t)l * 6 * D;
            row_phase<true, true, false>(F, (l == 0 || rep == 1) ? (rep == 1 ? (const float*)(ws + WS_T) : A->in[0]) : (const float*)A->out, rep == 1 ? (float*)(ws + WS_T) : A->out, (const bf16*)(ws + WS_Y), mod + 2 * D, A->in[6] + (size_t)l * D, A->in[7] + (size_t)l * D, mod + 4 * D, mod + 3 * D, rep == 1 ? (bf16*)(ws + WS_AM) : (bf16*)(ws + WS_H), nullptr, nullptr, nullptr, nullptr);
            if (BOTH(pb + 8) || rep + 1 < REPS(8)) GRID_BAR(); PROF_MARK(8); }
        if (EN(9) && IN(pb + 9))
#pragma nounroll
        for (int rep = 0; rep < REPS(9); ++rep) { CArgs A = get_args(); unsigned char* ws = A->ws; F.tid = fresh_tid(F.wave); F.lane = F.tid & 63; __syncthreads();
            pg8::Gemm g{(const bf16*)(ws + WS_H), (const bf16*)(ws + WS_W + (size_t)l * W_LAYER + WO_G), S, FF, D}; pg8::StaticOrder So; So.init(S, FF, F.G, (int)blockIdx.x); pg8::EpiPlain E{(bf16*)(ws + WS_G), FF};
            pg8::gemm_phase<pg8::EpiPlain, pg8::StaticOrder, true, true>(F.lds, g, So, E, F.wave);
            if (BOTH(pb + 9) || rep + 1 < REPS(9)) GRID_BAR(); PROF_MARK(9); }
        if (EN(10) && IN(pb + 10))
#pragma nounroll
        for (int rep = 0; rep < REPS(10); ++rep) { CArgs A = get_args(); unsigned char* ws = A->ws; F.tid = fresh_tid(F.wave); F.lane = F.tid & 63; __syncthreads();
            pg8::Gemm g{(const bf16*)(ws + WS_H), (const bf16*)(ws + WS_W + (size_t)l * W_LAYER + WO_U), S, FF, D}; pg8::StaticOrder So; So.init(S, FF, F.G, (int)blockIdx.x);
            pg8::EpiUp E{(const bf16*)(ws + WS_G), (bf16*)(ws + WS_AFF), FF, A->in[22] + (size_t)l * 3 * FF, A->in[23] + (size_t)l * FF};
            pg8::gemm_phase<pg8::EpiUp, pg8::StaticOrder, true, true>(F.lds, g, So, E, F.wave);
            if (BOTH(pb + 10) || rep + 1 < REPS(10)) GRID_BAR(); PROF_MARK(10); }
        if (EN(11) && IN(pb + 11))
#pragma nounroll
        for (int rep = 0; rep < REPS(11); ++rep) { CArgs A = get_args(); unsigned char* ws = A->ws; F.tid = fresh_tid(F.wave); F.lane = F.tid & 63; __syncthreads();
            pg8::Gemm g{(const bf16*)(ws + WS_AFF), (const bf16*)(ws + WS_W + (size_t)l * W_LAYER + WO_D), S, D, FF}; pg8::StaticOrder So; So.init(S, D, F.G, (int)blockIdx.x); pg8::EpiPlain E{(bf16*)(ws + WS_Y), D};
            pg8::gemm_phase<pg8::EpiPlain, pg8::StaticOrder, true, true>(F.lds, g, So, E, F.wave);
            if (BOTH(pb + 11) || rep + 1 < REPS(11)) GRID_BAR(); PROF_MARK(11); }
        if (EN(12) && IN(pb + 12))
#pragma nounroll
        for (int rep = 0; rep < REPS(12); ++rep) { CArgs A = get_args(); unsigned char* ws = A->ws; F.tid = fresh_tid(F.wave); F.lane = F.tid & 63; __syncthreads(); const float* mod = (const float*)(ws + WS_MOD) + (size_t)l * 6 * D;
            if (l + 1 < DEPTH) { const float* modn = mod + 6 * D;
                row_phase<true, true, true>(F, A->out, A->out, (const bf16*)(ws + WS_Y), mod + 5 * D, A->in[8] + (size_t)l * D, A->in[5] + (size_t)(l + 1) * D, modn + D, modn, (bf16*)(ws + WS_H),
                                            (const float*)(ws + WS_WG) + (size_t)(l + 1) * 8 * D, A->in[12] + 4 * (l + 1), A->in[13] + 4 * (l + 1), (float*)(ws + WS_GATES)); }
            else row_phase<true, false, false>(F, A->out, A->out, (const bf16*)(ws + WS_Y), mod + 5 * D, A->in[8] + (size_t)l * D, nullptr, nullptr, nullptr, nullptr, nullptr, nullptr, nullptr, nullptr);
            if (BOTH(pb + 12) || rep + 1 < REPS(12)) GRID_BAR(); PROF_MARK(12); }
    }
#ifdef PROF_K1
    { gu32* pw = F.ctl + 2048;
      if (blockIdx.x == 0 && F.tid == 0) { unsigned long long tot = 0; for (int k = 0; k < 15; ++k) tot += pacc[k];
          const float p1 = 100.0f * (float)pacc[PROF_K1] / (float)tot, p2 = 100.0f * (float)pacc[PROF_K2] / (float)tot;
          __hip_atomic_store(pw, __float_as_uint(100.0f + 10.0f * floorf(p1 + PROF_SHIFT)), RLX_AGENT); __hip_atomic_store(pw + 1, __float_as_uint(1.0f + 0.05f * floorf(p2 + PROF_SHIFT)), RLX_AGENT); }
      GRID_BAR();
      const float Acode = __uint_as_float(__hip_atomic_load(pw, RLX_AGENT)), bsc = 1.0f + __uint_as_float(__hip_atomic_load(pw + 1, RLX_AGENT));
      float* o = get_args()->out; const size_t gt = (size_t)blockIdx.x * 512 + F.tid;
      for (size_t i = gt; i < (size_t)S * D; i += (size_t)F.G * 512) o[i] = (i == 0) ? Acode : o[i] * bsc; }
#endif
#ifdef TPROBE_WG
    if ((int)blockIdx.x == TPROBE_WG && F.tid == 0) { const unsigned d_ = __hip_atomic_load(F.ctl + 2040, RLX_AGENT); const unsigned long long t0_ = rt(); while (rt() - t0_ < 4ull * d_) __builtin_amdgcn_s_sleep(8); }
#endif
#undef IN
#undef BOTH
}

#ifdef DBG_CHK
__global__ void chk_kernel(const unsigned* ws, size_t nws, const unsigned* out, size_t nout, unsigned long long* slot) {
    unsigned long long acc = 0; const size_t gt = (size_t)blockIdx.x * blockDim.x + threadIdx.x, NT = (size_t)gridDim.x * blockDim.x;
    for (size_t i = gt; i < nws; i += NT) acc += (unsigned long long)ws[i] * (unsigned long long)((i & 1023) * 2 + 1);
    for (size_t i = gt; i < nout; i += NT) acc += (unsigned long long)out[i] * (unsigned long long)((i & 1023) * 2 + 1);
    for (int o = 32; o > 0; o >>= 1) acc += __shfl_xor(acc, o);
    if ((threadIdx.x & 63) == 0) atomicAdd(slot, acc);
}
__global__ void chk_final(const unsigned long long* chk, int nph, float* out, size_t nout) {
    __shared__ int code;
    if (threadIdx.x == 0) { int c = 99; for (int p = nph - 1; p >= 0; --p) if (chk[p] != chk[64 + p]) c = p + 1; code = c; }
    __syncthreads();
    const size_t gt = (size_t)blockIdx.x * blockDim.x + threadIdx.x, NT = (size_t)gridDim.x * blockDim.x;
    for (size_t i = gt; i < nout; i += NT) out[i] = (i == 0) ? 1000.0f * (float)code : 0.0f;
}
#endif
extern "C" void kernel_launch(void* const* d_in, const int* in_sizes, int n_in, void* d_out, int out_size, void* d_ws, size_t ws_size, hipStream_t stream) {
    static int grid = 0;
    if (grid == 0) {
        if (n_in != 25 || out_size != S * D || ws_size < WS_END) { fprintf(stderr, "kernel_launch: unexpected shapes (n_in %d, out %d, ws %zu); nothing launched\n", n_in, out_size, ws_size); grid = -1; return; }
        int dev = 0, cus = 0, per_cu = 0;
        if (hipGetDevice(&dev) != hipSuccess || hipDeviceGetAttribute(&cus, hipDeviceAttributeMultiprocessorCount, dev) != hipSuccess) { grid = -1; return; }
        if (hipFuncSetAttribute((const void*)trunk_fwd, hipFuncAttributeMaxDynamicSharedMemorySize, LDS_BYTES) != hipSuccess) { fprintf(stderr, "kernel_launch: hipFuncSetAttribute failed\n"); grid = -1; return; }
        if (hipOccupancyMaxActiveBlocksPerMultiprocessor(&per_cu, (const void*)trunk_fwd, NWAVES * 64, LDS_BYTES) != hipSuccess || per_cu < 1) fprintf(stderr, "kernel_launch: occupancy query reports %d\n", per_cu);
        (void)hipGetLastError();
        grid = cus;
        if (grid != 256) fprintf(stderr, "kernel_launch: %d CUs (built for 256)\n", grid);
    }
    if (grid < 0) return;
    if (hipMemsetAsync((char*)d_ws + WS_CTL, 0, CTL_ZERO_BYTES, stream) != hipSuccess) return;
    Args a{};
    for (int i = 0; i < 25; ++i) a.in[i] = (const float*)d_in[i];
    a.out = (float*)d_out; a.ws = (unsigned char*)d_ws;
    for (int j = 0; j < 8; ++j) a.inv[j] = pow(500000.0, -(double)j / 8.0);
    a.mode = 15;
#if MK_ONE_LAUNCH
    a.ph_lo = 0; a.ph_hi = NPH;
    hipLaunchKernelGGL(trunk_fwd, dim3(grid), dim3(NWAVES * 64), LDS_BYTES, stream, a);
#else
#ifdef DBG_CHK
    unsigned long long* chk = (unsigned long long*)((char*)d_ws + 65536);
    for (int run = 0; run < 2; ++run) {
    (void)hipMemsetAsync((char*)d_ws + CTL_ZERO_BYTES, 0xAA, WS_END - CTL_ZERO_BYTES, stream);
    (void)hipMemsetAsync(d_out, 0xAA, (size_t)S * D * 4, stream);
#endif
    for (int p = 0; p < NPH; ++p) {
        if (p >= 2 + NPH_LAYER && ((p - 2) % NPH_LAYER) == 0) continue;
#ifdef DBG_CHK
        if (p >= 2 + DBG_CHK * NPH_LAYER) continue;
#endif
        a.ph_lo = p; a.ph_hi = p + 1;
        hipLaunchKernelGGL(trunk_fwd, dim3(grid), dim3(NWAVES * 64), LDS_BYTES, stream, a);
#ifdef DBG_CHK
        hipLaunchKernelGGL(chk_kernel, dim3(2048), dim3(256), 0, stream, (const unsigned*)((char*)d_ws + CTL_ZERO_BYTES), (size_t)(WS_END - CTL_ZERO_BYTES) / 4, (const unsigned*)d_out, (size_t)S * D, chk + run * 64 + p);
#endif
    }
#ifdef DBG_CHK
    }
    hipLaunchKernelGGL(chk_final, dim3(1024), dim3(256), 0, stream, (const unsigned long long*)chk, 2 + DBG_CHK * NPH_LAYER, (float*)d_out, (size_t)S * D);
#endif
#endif
    const hipError_t le = hipPeekAtLastError();
    if (le != hipSuccess) fprintf(stderr, "kernel_launch: launch failed: %s\n", hipGetErrorName(le));
}
```
